# Optimizing an MI355X kernel written in HIP

```python
import jax
import jax.numpy as jnp
from jax import lax
import numpy as np

D_MODEL = 1024
BATCH = 1
SEQ = 16384
DEPTH = 2

PLE_DIM = 256
MIX_WIDTH = D_MODEL
GROUP_WIDTH = MIX_WIDTH // 4
HEAD_DIM = 64
GROUP_HEADS = GROUP_WIDTH // HEAD_DIM

GLA_HEADS = GROUP_HEADS
GLA_DK = HEAD_DIM // 2
GLA_DV = GROUP_WIDTH // GLA_HEADS
GLA_GATE_RANK = 16
GLA_GATE_NORMALIZER = 16.0

HGRN_HEADS = GROUP_HEADS
HGRN_EXPAND = HEAD_DIM
HGRN_DV = GROUP_WIDTH // HGRN_HEADS

SWA_Q_HEADS = GROUP_HEADS
SWA_KV_HEADS = GROUP_HEADS // 2
SWA_HEAD_DIM = GROUP_WIDTH // SWA_Q_HEADS
SWA_WINDOW = 128

RWKV_HEADS = GROUP_HEADS
RWKV_N = GROUP_WIDTH // RWKV_HEADS
RWKV_W_RANK = 16
RWKV_A_RANK = 16
RWKV_V_RANK = 8
RWKV_G_RANK = 32

CHUNK = 16
LN_EPS = 1e-5
RMS_EPS = 1e-6
RWKV_GN_EPS = 64e-5

D_FF = 2816
N_EXPERTS = 8
TOP_K = 2
D_FF_EXPERT = 3584
MOE_ROWS = 128

N_DENSE = (DEPTH + 1) // 2
N_MOE = DEPTH // 2
DEEPNORM_ALPHA = (2.0 * DEPTH) ** 0.25
DEEPNORM_BETA = (8.0 * DEPTH) ** -0.25

RWKV_COLS = 3 * GROUP_WIDTH + RWKV_W_RANK + RWKV_A_RANK + RWKV_G_RANK
IN_SIZES = (
    GLA_HEADS * GLA_DK, GLA_HEADS * GLA_DK, GROUP_WIDTH, GROUP_WIDTH, GLA_GATE_RANK,
    HGRN_HEADS * HGRN_EXPAND, HGRN_HEADS * HGRN_EXPAND, GROUP_WIDTH, GROUP_WIDTH,
    SWA_Q_HEADS * SWA_HEAD_DIM, SWA_KV_HEADS * SWA_HEAD_DIM, SWA_KV_HEADS * SWA_HEAD_DIM,
    RWKV_COLS,
)
P_IN = sum(IN_SIZES)

kernel_name = 'hybrid_gla_hgrn2_swa_rwkv7_moe_deepnorm'


def split_cols(z, sizes):
    out, o = [], 0
    for s in sizes:
        out.append(z[..., o:o + s])
        o += s
    return out


def layer_norm(x, g, b):
    xf = x.astype(jnp.float32)
    mu = jnp.mean(xf, axis=-1, keepdims=True)
    var = jnp.mean(jnp.square(xf - mu), axis=-1, keepdims=True)
    return ((xf - mu) * lax.rsqrt(var + LN_EPS) * g + b).astype(x.dtype)


def rms_norm(x, w):
    xf = x.astype(jnp.float32)
    return xf * lax.rsqrt(jnp.mean(jnp.square(xf), axis=-1, keepdims=True) + RMS_EPS) * w


def token_shift_lerp(z, mu):
    prev = jnp.pad(z, ((0, 0), (1, 0), (0, 0)))[:, :-1]
    return z + (prev - z) * mu


def chunk_gated_linear_attn(q, k, v, log_f):
    bsz, seq, nh, dk = q.shape
    dv = v.shape[-1]
    n = seq // CHUNK
    q, k, log_f = (t.reshape(bsz, n, CHUNK, nh, dk) for t in (q, k, log_f))
    v = v.reshape(bsz, n, CHUNK, nh, dv)
    b = jnp.cumsum(log_f, axis=2)
    causal = jnp.tril(jnp.ones((CHUNK, CHUNK), dtype=bool))[None, None, :, :, None, None]
    rel = jnp.exp(jnp.where(causal, b[:, :, :, None] - b[:, :, None, :], -jnp.inf))
    scores = jnp.einsum('bntshk,bnshk->bnhts', q[:, :, :, None] * rel, k)
    o_intra = jnp.einsum('bnhts,bnshv->bnthv', scores, v)
    b_last = b[:, :, -1]
    kv = jnp.einsum('bnshk,bnshv->nbhkv', k * jnp.exp(b_last[:, :, None] - b), v)
    chunk_decay = jnp.moveaxis(jnp.exp(b_last), 1, 0)

    def step(state, inp):
        decay, update = inp
        return state * decay[..., None] + update, state

    s0 = jnp.zeros((bsz, nh, dk, dv), q.dtype)
    _, s_prev = lax.scan(step, s0, (chunk_decay, kv))
    o_inter = jnp.einsum('bnthk,nbhkv->bnthv', q * jnp.exp(b), s_prev)
    return (o_intra + o_inter).reshape(bsz, seq, nh, dv)


def gla_mixer(q, k, v, g, gk_down, gk_up, gk_bias, norm_w):
    bsz, seq, _ = q.shape
    q = q.reshape(bsz, seq, GLA_HEADS, GLA_DK) * GLA_DK ** -0.5
    k = k.reshape(bsz, seq, GLA_HEADS, GLA_DK)
    v = v.reshape(bsz, seq, GLA_HEADS, GLA_DV)
    log_f = jax.nn.log_sigmoid(gk_down @ gk_up + gk_bias) / GLA_GATE_NORMALIZER
    o = chunk_gated_linear_attn(q, k, v, log_f.reshape(bsz, seq, GLA_HEADS, GLA_DK))
    o = rms_norm(o, norm_w) * jax.nn.silu(g.reshape(bsz, seq, GLA_HEADS, GLA_DV))
    return o.reshape(bsz, seq, GROUP_WIDTH)


def hgrn2_mixer(q, f, i_in, g, lb, norm_w):
    bsz, seq, _ = q.shape
    q = jax.nn.silu(q)
    log_f = jnp.logaddexp(jnp.log(lb), jnp.log1p(-lb) + jax.nn.log_sigmoid(f))
    k = (1.0 - lb) * jax.nn.sigmoid(-f)
    hk = lambda t: t.reshape(bsz, seq, HGRN_HEADS, HGRN_EXPAND)
    o = chunk_gated_linear_attn(hk(q), hk(k), i_in.reshape(bsz, seq, HGRN_HEADS, HGRN_DV), hk(log_f))
    o = rms_norm(o, norm_w) * jax.nn.silu(g.reshape(bsz, seq, HGRN_HEADS, HGRN_DV))
    return o.reshape(bsz, seq, GROUP_WIDTH)


def swa_sink_mixer(q, k, v, sinks):
    bsz, seq, _ = q.shape
    w = SWA_WINDOW
    nb = seq // w
    grp = SWA_Q_HEADS // SWA_KV_HEADS
    q = q.reshape(bsz, nb, w, SWA_KV_HEADS, grp, SWA_HEAD_DIM)
    k = k.reshape(bsz, nb, w, SWA_KV_HEADS, SWA_HEAD_DIM)
    v = v.reshape(bsz, nb, w, SWA_KV_HEADS, SWA_HEAD_DIM)
    shift = lambda t: jnp.concatenate([jnp.zeros_like(t[:, :1]), t[:, :-1]], axis=1)
    kw = jnp.concatenate([shift(k), k], axis=2)
    vw = jnp.concatenate([shift(v), v], axis=2)
    s = jnp.einsum('bnqhgd,bnkhd->bnhgqk', q, kw) * SWA_HEAD_DIM ** -0.5
    q_pos = jnp.arange(nb)[:, None] * w + jnp.arange(w)[None, :]
    k_pos = jnp.arange(nb)[:, None] * w - w + jnp.arange(2 * w)[None, :]
    dist = q_pos[:, :, None] - k_pos[:, None, :]
    mask = (dist >= 0) & (dist < w) & (k_pos[:, None, :] >= 0)
    s = jnp.where(mask[None, :, None, None], s, -jnp.inf).astype(jnp.float32)
    sink = jnp.broadcast_to(sinks.astype(jnp.float32).reshape(1, 1, SWA_KV_HEADS, grp, 1, 1), s.shape[:-1] + (1,))
    prob = jax.nn.softmax(jnp.concatenate([s, sink], axis=-1), axis=-1)[..., :-1]
    o = jnp.einsum('bnhgqk,bnkhd->bnqhgd', prob, vw)
    return o.reshape(bsz, seq, GROUP_WIDTH)


def rwkv7_recurrence(r, log_w, k, v, a, b):
    bsz, seq, nh, n = r.shape
    xs = tuple(jnp.moveaxis(t, 1, 0) for t in (r, jnp.exp(log_w), k, v, a, b))

    def step(state, inp):
        r_t, w_t, k_t, v_t, a_t, b_t = inp
        sa = jnp.einsum('bhvk,bhk->bhv', state, a_t)
        state = state * w_t[:, :, None, :] + sa[..., None] * b_t[:, :, None, :] + v_t[..., None] * k_t[:, :, None, :]
        return state, jnp.einsum('bhvk,bhk->bhv', state, r_t)

    _, y = lax.scan(step, jnp.zeros((bsz, nh, n, n), r.dtype), xs)
    return jnp.moveaxis(y, 0, 1)


def rwkv7_mixer(zr, mu, w0, w_up, a0, a_up, g_up, k_k, k_a, r_k, lnx_w, lnx_b, v_res):
    bsz, seq, _ = zr.shape
    zr = token_shift_lerp(zr, mu)
    r, k, v, wd, ad, gd = split_cols(zr, (GROUP_WIDTH, GROUP_WIDTH, GROUP_WIDTH, RWKV_W_RANK, RWKV_A_RANK, RWKV_G_RANK))
    w = -jax.nn.softplus(-(w0 + jnp.tanh(wd) @ w_up)) - 0.5
    log_decay = -jnp.exp(w)
    a = jax.nn.sigmoid(a0 + ad @ a_up)
    g = jax.nn.sigmoid(gd) @ g_up
    v_layer = v
    if v_res is not None:
        v_first, vd, v0, v_up = v_res
        v = v + (v_first - v) * jax.nn.sigmoid(v0 + vd @ v_up)
    heads = lambda t: t.reshape(bsz, seq, RWKV_HEADS, RWKV_N)
    kk = heads(k * k_k)
    kk = kk / jnp.maximum(jnp.sqrt(jnp.sum(jnp.square(kk), axis=-1, keepdims=True)), 1e-12)
    k = k * (1.0 + (a - 1.0) * k_a)
    r_h, k_h, v_h, a_h = heads(r), heads(k), heads(v), heads(a)
    y = rwkv7_recurrence(r_h, heads(log_decay), k_h, v_h, -kk, kk * a_h)
    mu_y = jnp.mean(y, axis=-1, keepdims=True)
    var_y = jnp.mean(jnp.square(y - mu_y), axis=-1, keepdims=True)
    y = ((y - mu_y) * lax.rsqrt(var_y + RWKV_GN_EPS)).reshape(bsz, seq, GROUP_WIDTH) * lnx_w + lnx_b
    bonus = jnp.sum(r_h * k_h * r_k, axis=-1, keepdims=True) * v_h
    y = y + bonus.reshape(bsz, seq, GROUP_WIDTH)
    return y * g, v_layer


def swiglu(x, w_gate, w_up, w_down):
    return (jax.nn.silu(x @ w_gate) * (x @ w_up)) @ w_down


def moe_swiglu(x, router, w_gate, w_up, w_down):
    bsz, seq, d = x.shape
    n_tok = bsz * seq
    n_assign = n_tok * TOP_K
    xt = x.reshape(n_tok, d)
    logits = jnp.matmul(xt, router).astype(jnp.float32)
    top_logit, top_e = lax.top_k(logits, TOP_K)
    gates = jax.nn.softmax(top_logit, axis=-1)
    e_flat = top_e.reshape(-1)
    tok_flat = jnp.arange(n_assign, dtype=jnp.int32) // TOP_K
    order = jnp.argsort(e_flat)
    e_sorted = e_flat[order]
    counts = jnp.bincount(e_flat, length=N_EXPERTS)
    padded = (counts + MOE_ROWS - 1) // MOE_ROWS * MOE_ROWS
    start = jnp.cumsum(counts) - counts
    pad_end = jnp.cumsum(padded)
    pad_start = pad_end - padded
    dest = pad_start[e_sorted] + jnp.arange(n_assign, dtype=jnp.int32) - start[e_sorted]
    n_blocks = -(-n_assign // MOE_ROWS) + N_EXPERTS
    n_rows = n_blocks * MOE_ROWS
    row_tok = jnp.zeros((n_rows,), jnp.int32).at[dest].set(tok_flat[order])
    row_gate = jnp.zeros((n_rows,), jnp.float32).at[dest].set(gates.reshape(-1)[order])
    block_start = jnp.arange(n_blocks, dtype=jnp.int32) * MOE_ROWS
    block_e = jnp.minimum(jnp.searchsorted(pad_end, block_start, side='right'), N_EXPERTS - 1)
    x_rows = xt[row_tok].reshape(n_blocks, MOE_ROWS, d)

    def expert_block(args):
        xb, e = args
        return (jax.nn.silu(xb @ w_gate[e]) * (xb @ w_up[e])) @ w_down[e]

    y_rows = lax.map(expert_block, (x_rows, block_e)).reshape(n_rows, d)
    y = jnp.zeros((n_tok, d), jnp.float32).at[row_tok].add(y_rows * row_gate[:, None])
    return y.astype(x.dtype).reshape(bsz, seq, d)


def setup_inputs(seed: int = 0) -> dict:
    key = jax.random.key(seed)
    keys = jax.random.split(key, 64)
    counter = [0]
    f32 = jnp.float32

    def nxt():
        kk = keys[counter[0]]
        counter[0] += 1
        return kk

    def nrm(shape, scale):
        return jax.random.normal(nxt(), shape, f32) * scale

    def unif(shape, lo, hi):
        return jax.random.uniform(nxt(), shape, f32, lo, hi)

    L, D, GW = DEPTH, D_MODEL, GROUP_WIDTH
    beta = DEEPNORM_BETA
    return {
        'x': nrm((BATCH, SEQ, D), 1.0),
        'p': nrm((L, BATCH, SEQ, PLE_DIM), 1.0),
        'w_in': nrm((L, D, P_IN), D ** -0.5),
        'w_out': nrm((L, MIX_WIDTH, D), beta * MIX_WIDTH ** -0.5),
        'gla_gk_up': nrm((L, GLA_GATE_RANK, GLA_HEADS * GLA_DK), GLA_GATE_RANK ** -0.5),
        'gla_gk_bias': nrm((L, GLA_HEADS * GLA_DK), 0.1),
        'gla_norm_w': 1.0 + nrm((L, GLA_DV), 0.02),
        'hgrn_lower_bounds': nrm((L, HGRN_HEADS * HGRN_EXPAND), 0.1),
        'hgrn_norm_w': 1.0 + nrm((L, HGRN_DV), 0.02),
        'swa_sinks': nrm((L, SWA_Q_HEADS), 1.0),
        'rwkv_mu': unif((L, RWKV_COLS), 0.0, 1.0),
        'rwkv_w0': unif((L, GW), -6.0, -1.0),
        'rwkv_w_up': nrm((L, RWKV_W_RANK, GW), RWKV_W_RANK ** -0.5),
        'rwkv_a0': nrm((L, GW), 0.1),
        'rwkv_a_up': nrm((L, RWKV_A_RANK, GW), RWKV_A_RANK ** -0.5),
        'rwkv_g_up': nrm((L, RWKV_G_RANK, GW), RWKV_G_RANK ** -0.5),
        'rwkv_k_k': 0.85 + nrm((L, GW), 0.02),
        'rwkv_k_a': 1.0 + nrm((L, GW), 0.02),
        'rwkv_r_k': nrm((L, RWKV_HEADS, RWKV_N), 0.1),
        'rwkv_lnx_w': 1.0 + nrm((L, GW), 0.02),
        'rwkv_lnx_b': nrm((L, GW), 0.02),
        'rwkv_vres_down': nrm((L - 1, D, RWKV_V_RANK), D ** -0.5),
        'rwkv_vres_mu': unif((L - 1, RWKV_V_RANK), 0.0, 1.0),
        'rwkv_v0': nrm((L - 1, GW), 0.1),
        'rwkv_vres_up': nrm((L - 1, RWKV_V_RANK, GW), RWKV_V_RANK ** -0.5),
        'ln1_g': 1.0 + nrm((L, D), 0.02),
        'ln1_b': nrm((L, D), 0.02),
        'ln2_g': 1.0 + nrm((L, D), 0.02),
        'ln2_b': nrm((L, D), 0.02),
        'ffn_w_gate': nrm((N_DENSE, D, D_FF), D ** -0.5),
        'ffn_w_up': nrm((N_DENSE, D, D_FF), D ** -0.5),
        'ffn_w_down': nrm((N_DENSE, D_FF, D), beta * D_FF ** -0.5),
        'moe_router': nrm((N_MOE, D, N_EXPERTS), D ** -0.5),
        'moe_w_gate': nrm((N_MOE, N_EXPERTS, D, D_FF_EXPERT), D ** -0.5),
        'moe_w_up': nrm((N_MOE, N_EXPERTS, D, D_FF_EXPERT), D ** -0.5),
        'moe_w_down': nrm((N_MOE, N_EXPERTS, D_FF_EXPERT, D), beta * D_FF_EXPERT ** -0.5),
        'ple_proj': nrm((L, PLE_DIM, D), beta * PLE_DIM ** -0.5),
        'ple_gate': nrm((L, D, D), D ** -0.5),
    }


def reference(x, p, w_in, w_out, gla_gk_up, gla_gk_bias, gla_norm_w, hgrn_lower_bounds, hgrn_norm_w,
              swa_sinks, rwkv_mu, rwkv_w0, rwkv_w_up, rwkv_a0, rwkv_a_up, rwkv_g_up, rwkv_k_k, rwkv_k_a,
              rwkv_r_k, rwkv_lnx_w, rwkv_lnx_b, rwkv_vres_down, rwkv_vres_mu, rwkv_v0, rwkv_vres_up,
              ln1_g, ln1_b, ln2_g, ln2_b, ffn_w_gate, ffn_w_up, ffn_w_down, moe_router, moe_w_gate,
              moe_w_up, moe_w_down, ple_proj, ple_gate):
    f32 = jnp.float32
    lbs = jnp.cumsum(jax.nn.softmax(hgrn_lower_bounds.astype(f32), axis=0), axis=0)
    lbs = lbs - lbs[0]
    v_first = None
    for i in range(DEPTH):
        w = w_in[i] if i == 0 else jnp.concatenate([w_in[i], rwkv_vres_down[i - 1]], axis=1)
        z = jnp.matmul(x, w).astype(f32)
        (gq, gk, gv, gg, ggk, hq, hf, hi, hg, sq, sk, sv, rz) = split_cols(z, IN_SIZES)
        o_gla = gla_mixer(gq, gk, gv, gg, ggk, gla_gk_up[i], gla_gk_bias[i], gla_norm_w[i])
        o_hgrn = hgrn2_mixer(hq, hf, hi, hg, lbs[i], hgrn_norm_w[i])
        o_swa = swa_sink_mixer(sq, sk, sv, swa_sinks[i])
        if i == 0:
            v_res = None
        else:
            vd = token_shift_lerp(z[..., P_IN:], rwkv_vres_mu[i - 1])
            v_res = (v_first, vd, rwkv_v0[i - 1], rwkv_vres_up[i - 1])
        o_rwkv, v_layer = rwkv7_mixer(rz, rwkv_mu[i], rwkv_w0[i], rwkv_w_up[i], rwkv_a0[i], rwkv_a_up[i],
                                      rwkv_g_up[i], rwkv_k_k[i], rwkv_k_a[i], rwkv_r_k[i], rwkv_lnx_w[i],
                                      rwkv_lnx_b[i], v_res)
        if i == 0:
            v_first = v_layer
        mix = jnp.concatenate([o_gla, o_hgrn, o_swa, o_rwkv], axis=-1).astype(x.dtype)
        x = layer_norm(DEEPNORM_ALPHA * x + mix @ w_out[i], ln1_g[i], ln1_b[i])
        j = i // 2
        if i % 2 == 0:
            f = swiglu(x, ffn_w_gate[j], ffn_w_up[j], ffn_w_down[j])
        else:
            f = moe_swiglu(x, moe_router[j], moe_w_gate[j], moe_w_up[j], moe_w_down[j])
        x = layer_norm(DEEPNORM_ALPHA * x + f, ln2_g[i], ln2_b[i])
        x = x + jax.nn.sigmoid(x @ ple_gate[i]) * (p[i] @ ple_proj[i])
    return x
```

```cpp
#include <hip/hip_runtime.h>
#include <cstdio>
#include <cstdint>

typedef unsigned short bf16_t;
typedef short bf16x8 __attribute__((ext_vector_type(8)));
typedef float f32x4 __attribute__((ext_vector_type(4)));

constexpr int T = 16384, D = 1024, GW = 256;
constexpr int PIN = 3152, ZLD = 3160;
constexpr int DFF = 2816, NE = 8, DFE = 3584;
constexpr int MOE_MAXROWS = 32768 + NE * 64;
constexpr int MOE_MAXBLK = MOE_MAXROWS / 64;
constexpr float LN_EPS = 1e-5f, RMS_EPS = 1e-6f, GN_EPS = 64e-5f;
constexpr float ALPHA = 1.4142135623730951f;
constexpr int Z_GQ = 0, Z_GK = 128, Z_GV = 256, Z_GG = 512, Z_GGK = 768, Z_HQ = 784, Z_HF = 1040, Z_HI = 1296, Z_HG = 1552,
              Z_SQ = 1808, Z_SK = 2064, Z_SV = 2192, Z_RZ = 2320, Z_VD = 3152;

__device__ __forceinline__ unsigned f2bf(float f) { unsigned u = __float_as_uint(f); return (u + 0x7fffu + ((u >> 16) & 1u)) >> 16; }
__device__ __forceinline__ float sigmoidf_(float x) { return 1.f / (1.f + __expf(-x)); }
__device__ __forceinline__ float siluf_(float x) { return x / (1.f + __expf(-x)); }
__device__ __forceinline__ float softplusf_(float x) { return fmaxf(x, 0.f) + log1pf(__expf(-fabsf(x))); }
__device__ __forceinline__ float logsigmoidf_(float x) { return -softplusf_(-x); }
__device__ __forceinline__ float wave_sum(float v) {
#pragma unroll
    for (int o = 1; o < 64; o <<= 1) v += __shfl_xor(v, o);
    return v;
}
__device__ __forceinline__ float wave_max(float v) {
#pragma unroll
    for (int o = 1; o < 64; o <<= 1) v = fmaxf(v, __shfl_xor(v, o));
    return v;
}

struct GemmArgs {
    const void* A; int a_bf16; int lda; const int* rowidx;
    const float* W; const float* W2; int ldw;
    long long w_estride; const int* blk_expert;
    int M, N, K;
    int mode;
    void* out; int ldo; const float* aux1; const float* aux2; int ldaux; float alpha; int pad;
};

__global__ __launch_bounds__(256) void k_gemm(GemmArgs g) {
    __shared__ __attribute__((aligned(16))) bf16_t As[64][40];
    __shared__ __attribute__((aligned(16))) bf16_t Bs[64][40];
    __shared__ __attribute__((aligned(16))) bf16_t Bs2[64][40];
    const int tid = threadIdx.x, lane = tid & 63, wid = tid >> 6, wm = wid >> 1, wn = wid & 1;
    const int m0 = blockIdx.y * 64, n0 = blockIdx.x * 64;
    const float* W = g.W; const float* W2 = g.W2;
    if (g.blk_expert) { const int e = g.blk_expert[blockIdx.y]; if (e < 0) return; W += (size_t)e * g.w_estride; if (W2) W2 += (size_t)e * g.w_estride; }
    const bool dual = (g.mode == 2);
    const int ar = tid >> 2, ak = (tid & 3) * 8;
    long long arow = m0 + ar; if (g.rowidx) arow = g.rowidx[m0 + ar];
    const int bk = tid >> 3, bn = (tid & 7) * 8;
    const bool bvec = (n0 + 64 <= g.N) && ((g.ldw & 3) == 0);
    f32x4 acc[2][2], acc2[2][2];
#pragma unroll
    for (int i = 0; i < 2; ++i)
#pragma unroll
        for (int j = 0; j < 2; ++j) { acc[i][j] = (f32x4){0.f, 0.f, 0.f, 0.f}; acc2[i][j] = (f32x4){0.f, 0.f, 0.f, 0.f}; }
    for (int k0 = 0; k0 < g.K; k0 += 32) {
        {
            unsigned pk[4];
            if (g.a_bf16) {
                const uint4 v = *(const uint4*)((const bf16_t*)g.A + (size_t)arow * g.lda + k0 + ak);
                pk[0] = v.x; pk[1] = v.y; pk[2] = v.z; pk[3] = v.w;
            } else {
                const float* ap = (const float*)g.A + (size_t)arow * g.lda + k0 + ak;
                const float4 v0 = *(const float4*)ap, v1 = *(const float4*)(ap + 4);
                pk[0] = f2bf(v0.x) | (f2bf(v0.y) << 16); pk[1] = f2bf(v0.z) | (f2bf(v0.w) << 16);
                pk[2] = f2bf(v1.x) | (f2bf(v1.y) << 16); pk[3] = f2bf(v1.z) | (f2bf(v1.w) << 16);
            }
            *(uint4*)&As[ar][ak] = make_uint4(pk[0], pk[1], pk[2], pk[3]);
        }
        {
            float v[8], v2[8];
            const float* wp = W + (size_t)(k0 + bk) * g.ldw + n0 + bn;
            if (bvec) {
                const float4 a = *(const float4*)wp, b = *(const float4*)(wp + 4);
                v[0] = a.x; v[1] = a.y; v[2] = a.z; v[3] = a.w; v[4] = b.x; v[5] = b.y; v[6] = b.z; v[7] = b.w;
            } else {
#pragma unroll
                for (int j = 0; j < 8; ++j) v[j] = (n0 + bn + j < g.N) ? wp[j] : 0.f;
            }
#pragma unroll
            for (int j = 0; j < 8; ++j) Bs[bn + j][bk] = (bf16_t)f2bf(v[j]);
            if (dual) {
                const float* wp2 = W2 + (size_t)(k0 + bk) * g.ldw + n0 + bn;
                if (bvec) {
                    const float4 a = *(const float4*)wp2, b = *(const float4*)(wp2 + 4);
                    v2[0] = a.x; v2[1] = a.y; v2[2] = a.z; v2[3] = a.w; v2[4] = b.x; v2[5] = b.y; v2[6] = b.z; v2[7] = b.w;
                } else {
#pragma unroll
                    for (int j = 0; j < 8; ++j) v2[j] = (n0 + bn + j < g.N) ? wp2[j] : 0.f;
                }
#pragma unroll
                for (int j = 0; j < 8; ++j) Bs2[bn + j][bk] = (bf16_t)f2bf(v2[j]);
            }
        }
        __syncthreads();
        bf16x8 af[2], bfr[2], bfr2[2];
#pragma unroll
        for (int i = 0; i < 2; ++i) af[i] = *(const bf16x8*)&As[wm * 32 + i * 16 + (lane & 15)][8 * (lane >> 4)];
#pragma unroll
        for (int j = 0; j < 2; ++j) bfr[j] = *(const bf16x8*)&Bs[wn * 32 + j * 16 + (lane & 15)][8 * (lane >> 4)];
#pragma unroll
        for (int i = 0; i < 2; ++i)
#pragma unroll
            for (int j = 0; j < 2; ++j) acc[i][j] = __builtin_amdgcn_mfma_f32_16x16x32_bf16(af[i], bfr[j], acc[i][j], 0, 0, 0);
        if (dual) {
#pragma unroll
            for (int j = 0; j < 2; ++j) bfr2[j] = *(const bf16x8*)&Bs2[wn * 32 + j * 16 + (lane & 15)][8 * (lane >> 4)];
#pragma unroll
            for (int i = 0; i < 2; ++i)
#pragma unroll
                for (int j = 0; j < 2; ++j) acc2[i][j] = __builtin_amdgcn_mfma_f32_16x16x32_bf16(af[i], bfr2[j], acc2[i][j], 0, 0, 0);
        }
        __syncthreads();
    }
#pragma unroll
    for (int i = 0; i < 2; ++i)
#pragma unroll
        for (int j = 0; j < 2; ++j)
#pragma unroll
            for (int r = 0; r < 4; ++r) {
                const int row = m0 + wm * 32 + i * 16 + 4 * (lane >> 4) + r, col = n0 + wn * 32 + j * 16 + (lane & 15);
                if (col >= g.N) continue;
                const float a = acc[i][j][r];
                if (g.mode == 0) ((float*)g.out)[(size_t)row * g.ldo + col] = a;
                else if (g.mode == 1) ((float*)g.out)[(size_t)row * g.ldo + col] = g.alpha * g.aux1[(size_t)row * g.ldaux + col] + a;
                else if (g.mode == 2) ((bf16_t*)g.out)[(size_t)row * g.ldo + col] = (bf16_t)f2bf(siluf_(a) * acc2[i][j][r]);
                else ((float*)g.out)[(size_t)row * g.ldo + col] = g.aux1[(size_t)row * g.ldaux + col] + sigmoidf_(a) * g.aux2[(size_t)row * g.ldaux + col];
            }
}

__global__ __launch_bounds__(256) void k_ln(const float* in, const float* gam, const float* bet, float* out) {
    const int row = blockIdx.x * 4 + (threadIdx.x >> 6), lane = threadIdx.x & 63;
    const float4* p = (const float4*)(in + (size_t)row * D) + lane;
    float4 v[4]; float s = 0.f;
#pragma unroll
    for (int j = 0; j < 4; ++j) { v[j] = p[64 * j]; s += (v[j].x + v[j].y) + (v[j].z + v[j].w); }
    const float mean = wave_sum(s) * (1.f / D); float q = 0.f;
#pragma unroll
    for (int j = 0; j < 4; ++j) { v[j].x -= mean; v[j].y -= mean; v[j].z -= mean; v[j].w -= mean; q += (v[j].x * v[j].x + v[j].y * v[j].y) + (v[j].z * v[j].z + v[j].w * v[j].w); }
    const float rstd = rsqrtf(wave_sum(q) * (1.f / D) + LN_EPS);
    float4* o = (float4*)(out + (size_t)row * D) + lane;
#pragma unroll
    for (int j = 0; j < 4; ++j) {
        const float4 gg = ((const float4*)gam)[lane + 64 * j], bb = ((const float4*)bet)[lane + 64 * j];
        float4 r; r.x = v[j].x * rstd * gg.x + bb.x; r.y = v[j].y * rstd * gg.y + bb.y; r.z = v[j].z * rstd * gg.z + bb.z; r.w = v[j].w * rstd * gg.w + bb.w;
        o[64 * j] = r;
    }
}

struct PrepArgs {
    const float* z; int layer;
    const float *gk_up, *gk_bias;
    const float *mu, *w0, *w_up, *a0, *a_up, *g_up, *k_k, *k_a;
    const float *vres_mu, *v0, *v_up;
    float* gla_logf;
    float *r, *w, *k, *v, *a, *b, *g;
    float* vfirst;
};
__global__ __launch_bounds__(256) void k_prep(PrepArgs p) {
    __shared__ float lr[72];
    __shared__ float gd[16];
    __shared__ float red[4];
    const int t = blockIdx.x, c = threadIdx.x;
    const float* zt = p.z + (size_t)t * ZLD; const float* zp = zt - ZLD;
    if (c < 16) gd[c] = zt[Z_GGK + c];
    if (c < 72) {
        const int col = (c < 64) ? (Z_RZ + 768 + c) : (Z_VD + c - 64);
        if (c < 64 || p.layer > 0) {
            const float cur = zt[col], prev = t > 0 ? zp[col] : 0.f;
            const float m = (c < 64) ? p.mu[768 + c] : p.vres_mu[c - 64];
            lr[c] = cur + (prev - cur) * m;
        }
    }
    __syncthreads();
    if (c < 128) {
        float s = p.gk_bias[c];
#pragma unroll
        for (int j = 0; j < 16; ++j) s += gd[j] * p.gk_up[j * 128 + c];
        p.gla_logf[(size_t)t * 128 + c] = logsigmoidf_(s) * (1.f / 16.f);
    }
    float rr, kk0, vv;
    {
        const float c0 = zt[Z_RZ + c], p0 = t > 0 ? zp[Z_RZ + c] : 0.f; rr = c0 + (p0 - c0) * p.mu[c];
        const float c1 = zt[Z_RZ + 256 + c], p1 = t > 0 ? zp[Z_RZ + 256 + c] : 0.f; kk0 = c1 + (p1 - c1) * p.mu[256 + c];
        const float c2 = zt[Z_RZ + 512 + c], p2 = t > 0 ? zp[Z_RZ + 512 + c] : 0.f; vv = c2 + (p2 - c2) * p.mu[512 + c];
    }
    float sw = p.w0[c], sa = p.a0[c], sg = 0.f;
#pragma unroll
    for (int j = 0; j < 16; ++j) { sw += tanhf(lr[j]) * p.w_up[j * 256 + c]; sa += lr[16 + j] * p.a_up[j * 256 + c]; }
#pragma unroll
    for (int j = 0; j < 32; ++j) sg += sigmoidf_(lr[32 + j]) * p.g_up[j * 256 + c];
    const float wlog = -softplusf_(-sw) - 0.5f;
    const float decay = __expf(-__expf(wlog));
    const float a = sigmoidf_(sa);
    if (p.layer == 0) p.vfirst[(size_t)t * 256 + c] = vv;
    else {
        float sv = p.v0[c];
#pragma unroll
        for (int j = 0; j < 8; ++j) sv += lr[64 + j] * p.v_up[j * 256 + c];
        vv = vv + (p.vfirst[(size_t)t * 256 + c] - vv) * sigmoidf_(sv);
    }
    float kk = kk0 * p.k_k[c];
    const float ss = wave_sum(kk * kk);
    kk = kk / fmaxf(sqrtf(ss), 1e-12f);
    const float k2 = kk0 * (1.f + (a - 1.f) * p.k_a[c]);
    const size_t o = (size_t)t * 256 + c;
    p.r[o] = rr; p.w[o] = decay; p.k[o] = k2; p.v[o] = vv; p.a[o] = -kk; p.b[o] = kk * a; p.g[o] = sg;
    (void)red;
}

struct RecArgs {
    const float* z; const float* gla_logf; const float* gla_norm_w; const float* hgrn_norm_w; const float* lbs;
    const float *r, *w, *k, *v, *a, *b, *g; const float *r_k, *lnx_w, *lnx_b;
    bf16_t* mix;
};
constexpr int RCH = 32;
__global__ __launch_bounds__(64) void k_rec(RecArgs p) {
    __shared__ __attribute__((aligned(16))) float sm[RCH * 5 * 64];
    const int lane = threadIdx.x, blk = blockIdx.x;
    if (blk < 8) {
        const bool gla = blk < 4; const int h = blk & 3; const int DK = gla ? 32 : 64;
        float S[64];
#pragma unroll
        for (int k = 0; k < 64; ++k) S[k] = 0.f;
        const float nw = gla ? p.gla_norm_w[lane] : p.hgrn_norm_w[lane];
        for (int t0 = 0; t0 < T; t0 += RCH) {
            __syncthreads();
            for (int i = lane; i < RCH * DK; i += 64) {
                const int s = i / DK, k = i % DK; const float* zt = p.z + (size_t)(t0 + s) * ZLD;
                float q, kv, f;
                if (gla) { q = zt[Z_GQ + h * 32 + k] * 0.17677669529663687f; kv = zt[Z_GK + h * 32 + k]; f = __expf(p.gla_logf[(size_t)(t0 + s) * 128 + h * 32 + k]); }
                else {
                    const float fq = zt[Z_HQ + h * 64 + k], ff = zt[Z_HF + h * 64 + k], lb = p.lbs[h * 64 + k];
                    q = siluf_(fq); const float sg = sigmoidf_(ff);
                    f = lb + (1.f - lb) * sg; kv = (1.f - lb) * sigmoidf_(-ff);
                }
                sm[(s * 3 + 0) * 64 + k] = q; sm[(s * 3 + 1) * 64 + k] = kv; sm[(s * 3 + 2) * 64 + k] = f;
            }
            __syncthreads();
            for (int s = 0; s < RCH; ++s) {
                const int t = t0 + s; const float* zt = p.z + (size_t)t * ZLD;
                const float vj = gla ? zt[Z_GV + h * 64 + lane] : zt[Z_HI + h * 64 + lane];
                const float gj = gla ? zt[Z_GG + h * 64 + lane] : zt[Z_HG + h * 64 + lane];
                float o = 0.f;
                if (gla) {
#pragma unroll
                    for (int k = 0; k < 32; ++k) { S[k] = S[k] * sm[(s * 3 + 2) * 64 + k] + sm[(s * 3 + 1) * 64 + k] * vj; o += S[k] * sm[(s * 3 + 0) * 64 + k]; }
                } else {
#pragma unroll
                    for (int k = 0; k < 64; ++k) { S[k] = S[k] * sm[(s * 3 + 2) * 64 + k] + sm[(s * 3 + 1) * 64 + k] * vj; o += S[k] * sm[(s * 3 + 0) * 64 + k]; }
                }
                const float ms = wave_sum(o * o) * (1.f / 64.f);
                const float res = o * rsqrtf(ms + RMS_EPS) * nw * siluf_(gj);
                p.mix[(size_t)t * D + (gla ? 0 : 256) + h * 64 + lane] = (bf16_t)f2bf(res);
            }
        }
    } else {
        const int h = blk - 8, c = h * 64 + lane;
        float S[64];
#pragma unroll
        for (int k = 0; k < 64; ++k) S[k] = 0.f;
        const float lw = p.lnx_w[c], lb = p.lnx_b[c], rk = p.r_k[c];
        for (int t0 = 0; t0 < T; t0 += RCH) {
            __syncthreads();
            for (int i = lane; i < RCH * 64; i += 64) {
                const int s = i >> 6, k = i & 63; const size_t o = (size_t)(t0 + s) * 256 + h * 64 + k;
                sm[(s * 5 + 0) * 64 + k] = p.r[o]; sm[(s * 5 + 1) * 64 + k] = p.w[o]; sm[(s * 5 + 2) * 64 + k] = p.k[o];
                sm[(s * 5 + 3) * 64 + k] = p.a[o]; sm[(s * 5 + 4) * 64 + k] = p.b[o];
            }
            __syncthreads();
            for (int s = 0; s < RCH; ++s) {
                const int t = t0 + s; const size_t o = (size_t)t * 256 + c;
                const float vi = p.v[o], gi = p.g[o];
                const float* R = sm + (s * 5 + 0) * 64; const float* Wd = sm + (s * 5 + 1) * 64; const float* Kv = sm + (s * 5 + 2) * 64;
                const float* Av = sm + (s * 5 + 3) * 64; const float* Bv = sm + (s * 5 + 4) * 64;
                float sa = 0.f;
#pragma unroll
                for (int k = 0; k < 64; ++k) sa += S[k] * Av[k];
                float y = 0.f;
#pragma unroll
                for (int k = 0; k < 64; ++k) { S[k] = S[k] * Wd[k] + sa * Bv[k] + vi * Kv[k]; y += S[k] * R[k]; }
                const float bon = wave_sum(R[lane] * Kv[lane] * rk);
                const float mu = wave_sum(y) * (1.f / 64.f); const float d = y - mu;
                const float var = wave_sum(d * d) * (1.f / 64.f);
                const float yn = d * rsqrtf(var + GN_EPS) * lw + lb;
                p.mix[(size_t)t * D + 768 + c] = (bf16_t)f2bf((yn + bon * vi) * gi);
            }
        }
    }
}

__global__ __launch_bounds__(256) void k_swa(const float* z, const float* sinks, bf16_t* mix) {
    const int wg = blockIdx.x * 4 + (threadIdx.x >> 6), lane = threadIdx.x & 63;
    const int t = wg >> 2, h = wg & 3, kvh = h >> 1;
    const float* q = z + (size_t)t * ZLD + Z_SQ + h * 64;
    float sc[2];
#pragma unroll
    for (int i = 0; i < 2; ++i) {
        const int s = t - (lane + 64 * i);
        float d = -INFINITY;
        if (s >= 0) {
            const float4* kp = (const float4*)(z + (size_t)s * ZLD + Z_SK + kvh * 64); const float4* qp = (const float4*)q;
            float acc = 0.f;
#pragma unroll
            for (int j = 0; j < 16; ++j) { const float4 a = qp[j], b = kp[j]; acc += (a.x * b.x + a.y * b.y) + (a.z * b.z + a.w * b.w); }
            d = acc * 0.125f;
        }
        sc[i] = d;
    }
    const float sink = sinks[h];
    const float m = fmaxf(wave_max(fmaxf(sc[0], sc[1])), sink);
    const float e0 = (sc[0] == -INFINITY) ? 0.f : __expf(sc[0] - m), e1 = (sc[1] == -INFINITY) ? 0.f : __expf(sc[1] - m);
    const float den = wave_sum(e0 + e1) + __expf(sink - m);
    const float p0 = e0 / den, p1 = e1 / den;
    float o = 0.f;
    for (int dd = 0; dd < 128; ++dd) {
        const int s = t - dd; if (s < 0) break;
        const float pv = __shfl(dd < 64 ? p0 : p1, dd & 63);
        o += pv * z[(size_t)s * ZLD + Z_SV + kvh * 64 + lane];
    }
    mix[(size_t)t * D + 512 + h * 64 + lane] = (bf16_t)f2bf(o);
}

__global__ __launch_bounds__(256) void k_route(const float* x, const float* router, int* top_e, float* top_g, int* ctl) {
    const int t = blockIdx.x * 4 + (threadIdx.x >> 6), lane = threadIdx.x & 63;
    float acc[8];
#pragma unroll
    for (int e = 0; e < 8; ++e) acc[e] = 0.f;
    for (int i = 0; i < 16; ++i) {
        const int d = lane + 64 * i; const float xv = x[(size_t)t * D + d];
        const float4 r0 = *(const float4*)(router + d * 8), r1 = *(const float4*)(router + d * 8 + 4);
        acc[0] += xv * r0.x; acc[1] += xv * r0.y; acc[2] += xv * r0.z; acc[3] += xv * r0.w;
        acc[4] += xv * r1.x; acc[5] += xv * r1.y; acc[6] += xv * r1.z; acc[7] += xv * r1.w;
    }
#pragma unroll
    for (int e = 0; e < 8; ++e) acc[e] = wave_sum(acc[e]);
    if (lane == 0) {
        int e0 = 0; float l0 = acc[0];
#pragma unroll
        for (int e = 1; e < 8; ++e) if (acc[e] > l0) { l0 = acc[e]; e0 = e; }
        int e1 = -1; float l1 = -INFINITY;
#pragma unroll
        for (int e = 0; e < 8; ++e) if (e != e0 && acc[e] > l1) { l1 = acc[e]; e1 = e; }
        const float g1 = __expf(l1 - l0), den = 1.f + g1;
        top_e[t * 2] = e0; top_e[t * 2 + 1] = e1; top_g[t * 2] = 1.f / den; top_g[t * 2 + 1] = g1 / den;
        atomicAdd(&ctl[e0], 1); atomicAdd(&ctl[e1], 1);
    }
}
__global__ void k_moe_offsets(int* ctl, int* blk_expert) {
    if (threadIdx.x == 0 && blockIdx.x == 0) {
        int off = 0;
        for (int e = 0; e < NE; ++e) { const int c = ctl[e], pd = (c + 63) / 64 * 64; ctl[16 + e] = off; for (int b = off / 64; b < (off + pd) / 64; ++b) blk_expert[b] = e; off += pd; }
        ctl[24] = off;
        for (int b = off / 64; b < MOE_MAXBLK; ++b) blk_expert[b] = -1;
    }
}
__global__ __launch_bounds__(256) void k_moe_fill(const int* top_e, int* ctl, int* row_tok, int* tok_row) {
    const int i = blockIdx.x * 256 + threadIdx.x;
    const int e = top_e[i]; const int pos = atomicAdd(&ctl[8 + e], 1); const int dest = ctl[16 + e] + pos;
    row_tok[dest] = i >> 1; tok_row[i] = dest;
}
__global__ __launch_bounds__(256) void k_moe_combine(const float* x, const float* Y, const int* tok_row, const float* top_g, float* out) {
    const int t = blockIdx.x, c = threadIdx.x * 4;
    const int r0 = tok_row[t * 2], r1 = tok_row[t * 2 + 1]; const float g0 = top_g[t * 2], g1 = top_g[t * 2 + 1];
    const float4 xv = *(const float4*)(x + (size_t)t * D + c), y0 = *(const float4*)(Y + (size_t)r0 * D + c), y1 = *(const float4*)(Y + (size_t)r1 * D + c);
    float4 o; o.x = ALPHA * xv.x + g0 * y0.x + g1 * y1.x; o.y = ALPHA * xv.y + g0 * y0.y + g1 * y1.y; o.z = ALPHA * xv.z + g0 * y0.z + g1 * y1.z; o.w = ALPHA * xv.w + g0 * y0.w + g1 * y1.w;
    *(float4*)(out + (size_t)t * D + c) = o;
}
__global__ void k_lbs(const float* hl, float* lbs) {
    const int c = threadIdx.x; const float a = hl[c], b = hl[256 + c]; const float m = fmaxf(a, b); const float ea = __expf(a - m), eb = __expf(b - m);
    lbs[c] = 0.f; lbs[256 + c] = eb / (ea + eb);
}

static void launch_gemm(hipStream_t st, const void* A, int a_bf16, int lda, const int* rowidx, const float* W, const float* W2, int ldw, long long estride, const int* blk_expert,
                        int M, int N, int K, int mode, void* out, int ldo, const float* aux1, const float* aux2, int ldaux, float alpha) {
    GemmArgs g{}; g.A = A; g.a_bf16 = a_bf16; g.lda = lda; g.rowidx = rowidx; g.W = W; g.W2 = W2; g.ldw = ldw; g.w_estride = estride; g.blk_expert = blk_expert;
    g.M = M; g.N = N; g.K = K; g.mode = mode; g.out = out; g.ldo = ldo; g.aux1 = aux1; g.aux2 = aux2; g.ldaux = ldaux; g.alpha = alpha; g.pad = 0;
    hipLaunchKernelGGL(k_gemm, dim3((N + 63) / 64, M / 64), dim3(256), 0, st, g);
}

extern "C" void kernel_launch(void* const* d_in, const int* in_sizes, int n_in, void* d_out, int out_size, void* d_ws, size_t ws_size, hipStream_t stream) {
    const size_t MiB = 1u << 20;
    if (ws_size < 500 * MiB || n_in != 38) { fprintf(stderr, "kernel_launch: unexpected ws_size %zu / n_in %d\n", ws_size, n_in); return; }
    auto F = [&](int i) { return (const float*)d_in[i]; };
    char* ws = (char*)d_ws;
    float* z = (float*)(ws + 0);
    float* gla_logf = (float*)(ws + 198 * MiB);
    float* rw[7]; for (int i = 0; i < 7; ++i) rw[i] = (float*)(ws + (206 + 16 * i) * MiB);
    float* vfirst = (float*)(ws + 318 * MiB);
    bf16_t* mix = (bf16_t*)(ws + 334 * MiB);
    float* preln = (float*)(ws + 366 * MiB);
    float* XB = (float*)(ws + 430 * MiB);
    char* misc = ws + 494 * MiB;
    int* ctl = (int*)misc;
    float* lbs = (float*)(misc + 4096);
    int* top_e = (int*)(misc + 65536);
    float* top_g = (float*)(misc + 65536 + 131072);
    int* tok_row = (int*)(misc + 65536 + 2 * 131072);
    int* row_tok = (int*)(misc + 65536 + 3 * 131072);
    int* blk_expert = (int*)(misc + 65536 + 3 * 131072 + 262144);
    bf16_t* Hd = (bf16_t*)(ws + 0);
    bf16_t* Hm = (bf16_t*)(ws + 0);
    float* Ym = (float*)(ws + 228 * MiB);
    float* pp = (float*)(ws + 0);
    float* XA = (float*)d_out;

    hipLaunchKernelGGL(k_lbs, dim3(1), dim3(256), 0, stream, F(7), lbs);
    for (int L = 0; L < 2; ++L) {
        const float* xin = (L == 0) ? F(0) : XA;
        launch_gemm(stream, xin, 0, D, nullptr, F(2) + (size_t)L * D * PIN, nullptr, PIN, 0, nullptr, T, PIN, D, 0, z, ZLD, nullptr, nullptr, 0, 0.f);
        if (L > 0) launch_gemm(stream, xin, 0, D, nullptr, F(21), nullptr, 8, 0, nullptr, T, 8, D, 0, z + Z_VD, ZLD, nullptr, nullptr, 0, 0.f);
        PrepArgs pa{}; pa.z = z; pa.layer = L; pa.gk_up = F(4) + L * 16 * 128; pa.gk_bias = F(5) + L * 128;
        pa.mu = F(10) + L * 832; pa.w0 = F(11) + L * GW; pa.w_up = F(12) + L * 16 * GW; pa.a0 = F(13) + L * GW; pa.a_up = F(14) + L * 16 * GW; pa.g_up = F(15) + L * 32 * GW;
        pa.k_k = F(16) + L * GW; pa.k_a = F(17) + L * GW; pa.vres_mu = F(22); pa.v0 = F(23); pa.v_up = F(24);
        pa.gla_logf = gla_logf; pa.r = rw[0]; pa.w = rw[1]; pa.k = rw[2]; pa.v = rw[3]; pa.a = rw[4]; pa.b = rw[5]; pa.g = rw[6]; pa.vfirst = vfirst;
        hipLaunchKernelGGL(k_prep, dim3(T), dim3(256), 0, stream, pa);
        RecArgs ra{}; ra.z = z; ra.gla_logf = gla_logf; ra.gla_norm_w = F(6) + L * 64; ra.hgrn_norm_w = F(8) + L * 64; ra.lbs = lbs + L * 256;
        ra.r = rw[0]; ra.w = rw[1]; ra.k = rw[2]; ra.v = rw[3]; ra.a = rw[4]; ra.b = rw[5]; ra.g = rw[6]; ra.r_k = F(18) + L * 256; ra.lnx_w = F(19) + L * GW; ra.lnx_b = F(20) + L * GW; ra.mix = mix;
        hipLaunchKernelGGL(k_rec, dim3(12), dim3(64), 0, stream, ra);
        hipLaunchKernelGGL(k_swa, dim3(T), dim3(256), 0, stream, z, F(9) + L * 4, mix);
        launch_gemm(stream, mix, 1, D, nullptr, F(3) + (size_t)L * D * D, nullptr, D, 0, nullptr, T, D, D, 1, preln, D, xin, nullptr, D, ALPHA);
        hipLaunchKernelGGL(k_ln, dim3(T / 4), dim3(256), 0, stream, preln, F(25) + L * D, F(26) + L * D, XB);
        if (L == 0) {
            launch_gemm(stream, XB, 0, D, nullptr, F(29), F(30), DFF, 0, nullptr, T, DFF, D, 2, Hd, DFF, nullptr, nullptr, 0, 0.f);
            launch_gemm(stream, Hd, 1, DFF, nullptr, F(31), nullptr, D, 0, nullptr, T, D, DFF, 1, preln, D, XB, nullptr, D, ALPHA);
        } else {
            hipMemsetAsync(ctl, 0, 128, stream);
            hipMemsetAsync(row_tok, 0, MOE_MAXROWS * 4, stream);
            hipLaunchKernelGGL(k_route, dim3(T / 4), dim3(256), 0, stream, XB, F(32), top_e, top_g, ctl);
            hipLaunchKernelGGL(k_moe_offsets, dim3(1), dim3(64), 0, stream, ctl, blk_expert);
            hipLaunchKernelGGL(k_moe_fill, dim3(T * 2 / 256), dim3(256), 0, stream, top_e, ctl, row_tok, tok_row);
            launch_gemm(stream, XB, 0, D, row_tok, F(33), F(34), DFE, (long long)D * DFE, blk_expert, MOE_MAXROWS, DFE, D, 2, Hm, DFE, nullptr, nullptr, 0, 0.f);
            launch_gemm(stream, Hm, 1, DFE, nullptr, F(35), nullptr, D, (long long)DFE * D, blk_expert, MOE_MAXROWS, D, DFE, 0, Ym, D, nullptr, nullptr, 0, 0.f);
            hipLaunchKernelGGL(k_moe_combine, dim3(T), dim3(256), 0, stream, XB, Ym, tok_row, top_g, preln);
        }
        hipLaunchKernelGGL(k_ln, dim3(T / 4), dim3(256), 0, stream, preln, F(27) + L * D, F(28) + L * D, XB);
        launch_gemm(stream, F(1) + (size_t)L * T * 256, 0, 256, nullptr, F(36) + (size_t)L * 256 * D, nullptr, D, 0, nullptr, T, D, 256, 0, pp, D, nullptr, nullptr, 0, 0.f);
        launch_gemm(stream, XB, 0, D, nullptr, F(37) + (size_t)L * D * D, nullptr, D, 0, nullptr, T, D, D, 3, XA, D, XB, pp, D, 0.f);
    }
}
```

```cpp
#include <hip/hip_runtime.h>
#include <cstdio>
#include <cstdint>
namespace pg8 {
#define PG8_LAS __attribute__((address_space(3)))
typedef unsigned short bf16_t;
typedef short bf16x8 __attribute__((ext_vector_type(8)));
typedef float f32x4 __attribute__((ext_vector_type(4)));
typedef unsigned u32x4 __attribute__((ext_vector_type(4)));
constexpr int BM = 256, BK = 64, HALF = 128, HTB = HALF * BK * 2  , STAGE_BYTES = 8 * HTB, NXCD = 8, WGM = 8;

__host__ __device__ __forceinline__ int lds_byte(int r, int c) { const int st = (r >> 4) * 2 + (c >> 5), rr = r & 15, cc = c & 31, ob = rr * 64 + cc * 2; return st * 1024 + (ob ^ (((ob >> 9) & 1) << 5)); }
__host__ __device__ __forceinline__ void stage_rc(int b, int& R, int& C) { const int st = b / 1024, sb = b % 1024, swz = sb ^ (((sb >> 9) & 1) << 5); R = (st >> 1) * 16 + swz / 64; C = (st & 1) * 32 + (swz % 64) / 2; }
__host__ __device__ __forceinline__ int perm32(int rho) { const int n = rho >> 4, i = rho & 15; return 8 * (i >> 2) + 4 * n + (i & 3); }

struct Unit { int pm, pn, on; };
struct Gemm { const bf16_t* A; const bf16_t* Bt; int M, N, K; };

struct StaticOrder {
    int nM, nN, nwg, G, c;
    __host__ __device__ void init(int M, int N, int G_, int c_) { nM = M / BM; nN = N / BM; nwg = nM * nN; G = G_; c = c_; }
    __host__ __device__ bool next(int i, Unit& u) const {
        const long L = (long)i * G + c; if (L >= nwg) return false;
        int wgid = (int)L; { const int q = nwg / NXCD, r = nwg % NXCD, xcd = wgid % NXCD, off = wgid / NXCD; wgid = (xcd < r ? xcd * (q + 1) : r * (q + 1) + (xcd - r) * q) + off; }
        const int nig = WGM * nN, gid = wgid / nig, fm = gid * WGM, gsz = (nM - fm) < WGM ? (nM - fm) : WGM;
        u.pm = fm + ((wgid % nig) % gsz); u.pn = (wgid % nig) / gsz; u.on = u.pn; return true;
    }
    __device__ __forceinline__ void a_ready(const Unit&) const {}
    __device__ __forceinline__ void done(const Unit&) const {}
};

__device__ __forceinline__ unsigned cvt_pk_bf16(float lo, float hi) { unsigned r; asm volatile("v_cvt_pk_bf16_f32 %0, %1, %2" : "=v"(r) : "v"(lo), "v"(hi)); return r; }
__device__ __forceinline__ float fast_sigmoid(float x) { return __builtin_amdgcn_rcpf(1.f + __expf(-x)); }
struct EpiStoreBf16 {
    static constexpr bool PERM = true, AFTER_DRAIN = false;
    bf16_t* O; int ldc;
    __device__ __forceinline__ void operator()(const f32x4 (&acc)[2][2][4][2], const Unit& u, int wr, int wc, int fr, int fq) const {
        const int row0 = u.pm * BM + wr * 64 + fr, col0 = u.on * BM + wc * 32 + 8 * fq;
#pragma unroll
        for (int ai = 0; ai < 2; ++ai)
#pragma unroll
            for (int m = 0; m < 4; ++m) { bf16_t* rowp = O + (size_t)(row0 + ai * HALF + m * 16) * ldc + col0;
#pragma unroll
                for (int bj = 0; bj < 2; ++bj) { const f32x4 v0 = acc[ai][bj][m][0], v1 = acc[ai][bj][m][1];
                    u32x4 w; w.x = cvt_pk_bf16(v0[0], v0[1]); w.y = cvt_pk_bf16(v0[2], v0[3]); w.z = cvt_pk_bf16(v1[0], v1[1]); w.w = cvt_pk_bf16(v1[2], v1[3]);
                    *(u32x4*)(rowp + bj * HALF) = w; } }
    }
};
struct EpiResF32 {
    static constexpr bool PERM = false, AFTER_DRAIN = false;
    const float* res; float* out; int ldc; float alpha;
    __device__ __forceinline__ void operator()(const f32x4 (&acc)[2][2][4][2], const Unit& u, int wr, int wc, int fr, int fq) const {
        const int row0 = u.pm * BM + wr * 64 + fr, col0 = u.on * BM + wc * 32 + 4 * fq;
#pragma unroll
        for (int ai = 0; ai < 2; ++ai)
#pragma unroll
            for (int m = 0; m < 4; ++m) { const size_t off = (size_t)(row0 + ai * HALF + m * 16) * ldc + col0;
#pragma unroll
                for (int bj = 0; bj < 2; ++bj)
#pragma unroll
                    for (int n = 0; n < 2; ++n) { const f32x4 r = *(const f32x4*)(res + off + bj * HALF + n * 16); *(f32x4*)(out + off + bj * HALF + n * 16) = r * alpha + acc[ai][bj][m][n]; }
                asm volatile("" ::: "memory"); }
    }
};
struct EpiSwiglu {
    static constexpr bool PERM = true, AFTER_DRAIN = false;
    bf16_t* H; int ldc;
    __device__ __forceinline__ void operator()(const f32x4 (&acc)[2][2][4][2], const Unit& u, int wr, int wc, int fr, int fq) const {
        const int row0 = u.pm * BM + wr * 64 + fr, col0 = u.on * HALF + wc * 32 + 8 * fq;
#pragma unroll
        for (int ai = 0; ai < 2; ++ai)
#pragma unroll
            for (int m = 0; m < 4; ++m) {
                f32x4 h[2];
#pragma unroll
                for (int n = 0; n < 2; ++n) { const f32x4 g = acc[ai][0][m][n], up = acc[ai][1][m][n];
#pragma unroll
                    for (int i = 0; i < 4; ++i) h[n][i] = g[i] * fast_sigmoid(g[i]) * up[i]; }
                u32x4 w; w.x = cvt_pk_bf16(h[0][0], h[0][1]); w.y = cvt_pk_bf16(h[0][2], h[0][3]); w.z = cvt_pk_bf16(h[1][0], h[1][1]); w.w = cvt_pk_bf16(h[1][2], h[1][3]);
                *(u32x4*)(H + (size_t)(row0 + ai * HALF + m * 16) * ldc + col0) = w; }
    }
};
struct EpiPle {
    static constexpr bool PERM = false, AFTER_DRAIN = false;
    float* x; const bf16_t* pp; bf16_t* xbo; int ldc;
    __device__ __forceinline__ void operator()(const f32x4 (&acc)[2][2][4][2], const Unit& u, int wr, int wc, int fr, int fq) const {
        typedef unsigned u32x2v __attribute__((ext_vector_type(2)));
        const int row0 = u.pm * BM + wr * 64 + fr, col0 = u.on * BM + wc * 32 + 4 * fq;
#pragma unroll
        for (int ai = 0; ai < 2; ++ai)
#pragma unroll
            for (int m = 0; m < 4; ++m) { const size_t off = (size_t)(row0 + ai * HALF + m * 16) * ldc + col0;
#pragma unroll
                for (int bj = 0; bj < 2; ++bj)
#pragma unroll
                    for (int n = 0; n < 2; ++n) { const size_t o = off + bj * HALF + n * 16;
                        const f32x4 xv = *(const f32x4*)(x + o); const u32x2v pw = *(const u32x2v*)(pp + o); const f32x4 a = acc[ai][bj][m][n];
                        f32x4 pv; pv[0] = __uint_as_float(pw.x << 16); pv[1] = __uint_as_float(pw.x & 0xffff0000u); pv[2] = __uint_as_float(pw.y << 16); pv[3] = __uint_as_float(pw.y & 0xffff0000u);
                        f32x4 xn;
#pragma unroll
                        for (int i = 0; i < 4; ++i) xn[i] = xv[i] + fast_sigmoid(a[i]) * pv[i];
                        *(f32x4*)(x + o) = xn; u32x2v w; w.x = cvt_pk_bf16(xn[0], xn[1]); w.y = cvt_pk_bf16(xn[2], xn[3]); *(u32x2v*)(xbo + o) = w; }
                asm volatile("" ::: "memory"); }
    }
};
struct MoeOrder {
    const int* tile_e; int nrt, ncol, G, c;
    __device__ __forceinline__ bool next(int i, Unit& u) const {
        const int L = i * G + c; if (L >= nrt * ncol) return false;
        const int rt = L / ncol, cn = L - rt * ncol; const int e = tile_e[rt];
        u.pm = rt; u.pn = e * ncol + cn; u.on = cn; return true;
    }
    __device__ __forceinline__ void a_ready(const Unit&) const {}
    __device__ __forceinline__ void done(const Unit&) const {}
};

template <class Epi, class Sched, bool ALIGN_EPI = false, bool SP2 = false>
__device__ __forceinline__ void gemm_phase(PG8_LAS unsigned char* lds, const Gemm g, const Sched& S, const Epi& E) {
    int tid_ = threadIdx.x; asm volatile("" : "+v"(tid_));
    const int tid = tid_, wid = __builtin_amdgcn_readfirstlane(tid >> 6), lane = tid & 63, wr = wid >> 2, wc = wid & 3, fr = lane & 15, fq = lane >> 4;
    const int K = g.K, nt = K / BK;
    unsigned voffA[2], voffB[2];
#pragma unroll
    for (int i = 0; i < 2; ++i) { int R, C; stage_rc(tid * 16 + i * 8192, R, C); const int Rb = Epi::PERM ? ((R & ~31) + perm32(R & 31)) : R;
        voffA[i] = (unsigned)(R * K + C) * 2u; voffB[i] = (unsigned)(Rb * K + C) * 2u; }
    const size_t kstep = (size_t)(BK * 2);
    const size_t hstep = (size_t)HALF * K * 2;
    const size_t tstep = 2 * hstep;
    const unsigned ldsw = (unsigned)wid * 1024u;
    const int aoff = lds_byte(wr * 64 + fr, fq * 8), boff = lds_byte(wc * 32 + fr, fq * 8);
#define PG8_SA(b, h) (((b) * 2 + (h)) * HTB)
#define PG8_SB(b, h) ((4 + (b) * 2 + (h)) * HTB)
#define PG8_STAGE(bufoff, gbase, voff) do { _Pragma("unroll") for (int _i = 0; _i < 2; ++_i) \
        __builtin_amdgcn_global_load_lds((const unsigned*)((const char*)(gbase) + (voff)[_i]), (PG8_LAS unsigned*)(lds + (bufoff) + ldsw + _i * 8192), 16, 0, 0); } while (0)
#define PG8_LDA(dst, b, h) do { _Pragma("unroll") for (int m = 0; m < 4; ++m) _Pragma("unroll") for (int k = 0; k < 2; ++k) dst[m][k] = *(const PG8_LAS bf16x8*)(lds + PG8_SA(b, h) + aoff + m * 2048 + k * 1024); } while (0)
#define PG8_LDB(dst, b, h) do { _Pragma("unroll") for (int n = 0; n < 2; ++n) _Pragma("unroll") for (int k = 0; k < 2; ++k) dst[n][k] = *(const PG8_LAS bf16x8*)(lds + PG8_SB(b, h) + boff + n * 2048 + k * 1024); } while (0)
#define PG8_MMA(ai, bj, At, Bt) do { __builtin_amdgcn_s_setprio(1); _Pragma("unroll") for (int m = 0; m < 4; ++m) _Pragma("unroll") for (int n = 0; n < 2; ++n) _Pragma("unroll") for (int k = 0; k < 2; ++k) \
        acc[ai][bj][m][n] = __builtin_amdgcn_mfma_f32_16x16x32_bf16(Bt[n][k], At[m][k], acc[ai][bj][m][n], 0, 0, 0); __builtin_amdgcn_s_setprio(0); } while (0)
#define PG8_WAIT_V(n) asm volatile("s_waitcnt vmcnt(" #n ")" ::: "memory")
#define PG8_WAIT_L(n) asm volatile("s_waitcnt lgkmcnt(" #n ")" ::: "memory")
#define PG8_BAR __builtin_amdgcn_s_barrier()
#define PG8_SCHED __builtin_amdgcn_sched_barrier(0)
    Unit cur, nxt; int ui = 0;
    if (!S.next(0, cur)) return;
    f32x4 acc[2][2][4][2];
#pragma unroll
    for (int a = 0; a < 2; ++a)
#pragma unroll
        for (int b = 0; b < 2; ++b)
#pragma unroll
            for (int m = 0; m < 4; ++m)
#pragma unroll
                for (int n = 0; n < 2; ++n) acc[a][b][m][n] = (f32x4){0.f, 0.f, 0.f, 0.f};
    bf16x8 At[4][2], B0[2][2], B1[2][2];
    const char* cA = (const char*)g.A + (size_t)cur.pm * tstep; const char* cB = (const char*)g.Bt + (size_t)cur.pn * tstep;
    S.a_ready(cur);
    if constexpr (SP2) {
        PG8_STAGE(PG8_SB(0, 0), cB, voffB); PG8_STAGE(PG8_SB(0, 1), cB + hstep, voffB); PG8_STAGE(PG8_SA(0, 0), cA, voffA); PG8_STAGE(PG8_SA(0, 1), cA + hstep, voffA);
        if (wr == 1) PG8_BAR;
        PG8_WAIT_V(2); PG8_BAR;
        PG8_STAGE(PG8_SB(1, 0), cB + kstep, voffB); PG8_STAGE(PG8_SA(1, 0), cA + kstep, voffA); PG8_STAGE(PG8_SB(1, 1), cB + hstep + kstep, voffB);
        PG8_WAIT_V(6); PG8_BAR;
    } else {
        PG8_STAGE(PG8_SB(0, 0), cB, voffB); PG8_STAGE(PG8_SA(0, 0), cA, voffA); PG8_STAGE(PG8_SB(0, 1), cB + hstep, voffB); PG8_STAGE(PG8_SA(0, 1), cA + hstep, voffA);
        if (wr == 1) PG8_BAR;
        PG8_WAIT_V(4); PG8_BAR;
        PG8_STAGE(PG8_SB(1, 0), cB + kstep, voffB); PG8_STAGE(PG8_SA(1, 0), cA + kstep, voffA); PG8_STAGE(PG8_SB(1, 1), cB + hstep + kstep, voffB);
        PG8_WAIT_V(6); PG8_BAR;
    }
    for (;;) {
        const bool has_next = S.next(ui + 1, nxt);
        const char* nA = has_next ? (const char*)g.A + (size_t)nxt.pm * tstep : cA; const char* nB = has_next ? (const char*)g.Bt + (size_t)nxt.pn * tstep : cB;
        for (int t = 0; t < nt; t += 2) {
            const bool last = (t == nt - 2);
            const char* a1 = cA + (size_t)(t + 1) * kstep;
            const char* a2 = last ? nA : cA + (size_t)(t + 2) * kstep; const char* b2 = last ? nB : cB + (size_t)(t + 2) * kstep;
            const char* a3 = a2 + kstep; const char* b3 = b2 + kstep;
            if (last && has_next) S.a_ready(nxt);
            if constexpr (SP2) {
            PG8_LDB(B0, 0, 0); PG8_LDB(B1, 0, 1); PG8_SCHED; PG8_LDA(At, 0, 0); PG8_STAGE(PG8_SA(1, 1), a1 + hstep, voffA);
            PG8_WAIT_V(8); PG8_WAIT_L(0); PG8_BAR; PG8_MMA(0, 0, At, B0); PG8_MMA(0, 1, At, B1); PG8_BAR; PG8_SCHED;
            PG8_LDA(At, 0, 1); PG8_STAGE(PG8_SB(0, 0), b2, voffB); PG8_STAGE(PG8_SB(0, 1), b2 + hstep, voffB); PG8_STAGE(PG8_SA(0, 0), a2, voffA);
            PG8_WAIT_V(8); PG8_WAIT_L(0); PG8_BAR; PG8_MMA(1, 0, At, B0); PG8_MMA(1, 1, At, B1); PG8_BAR; PG8_SCHED;
            PG8_LDB(B0, 1, 0); PG8_LDB(B1, 1, 1); PG8_SCHED; PG8_LDA(At, 1, 0); PG8_STAGE(PG8_SA(0, 1), a2 + hstep, voffA);
            PG8_WAIT_V(8); PG8_WAIT_L(0); PG8_BAR; PG8_MMA(0, 0, At, B0); PG8_MMA(0, 1, At, B1); PG8_BAR; PG8_SCHED;
            PG8_LDA(At, 1, 1); PG8_STAGE(PG8_SB(1, 0), b3, voffB); PG8_STAGE(PG8_SB(1, 1), b3 + hstep, voffB); PG8_STAGE(PG8_SA(1, 0), a3, voffA);
            PG8_WAIT_V(8); PG8_WAIT_L(0); PG8_BAR; PG8_MMA(1, 0, At, B0); PG8_MMA(1, 1, At, B1); PG8_BAR; PG8_SCHED;
            } else {
            PG8_LDB(B0, 0, 0); PG8_SCHED; PG8_LDA(At, 0, 0); PG8_STAGE(PG8_SA(1, 1), a1 + hstep, voffA);
            PG8_WAIT_L(8); PG8_BAR; PG8_WAIT_L(0); PG8_MMA(0, 0, At, B0); PG8_BAR; PG8_SCHED;
            PG8_LDB(B1, 0, 1); PG8_STAGE(PG8_SB(0, 0), b2, voffB);
            PG8_BAR; PG8_WAIT_L(0); PG8_MMA(0, 1, At, B1); PG8_BAR;
            PG8_LDA(At, 0, 1); PG8_STAGE(PG8_SA(0, 0), a2, voffA);
            PG8_BAR; PG8_WAIT_L(0); PG8_MMA(1, 0, At, B0); PG8_BAR; PG8_SCHED;
            PG8_STAGE(PG8_SB(0, 1), b2 + hstep, voffB);
            PG8_WAIT_V(6); PG8_BAR; PG8_MMA(1, 1, At, B1); PG8_BAR;
            PG8_LDB(B0, 1, 0); PG8_SCHED; PG8_LDA(At, 1, 0); PG8_STAGE(PG8_SA(0, 1), a2 + hstep, voffA);
            PG8_WAIT_L(8); PG8_BAR; PG8_WAIT_L(0); PG8_MMA(0, 0, At, B0); PG8_BAR; PG8_SCHED;
            PG8_LDB(B1, 1, 1); PG8_STAGE(PG8_SB(1, 0), b3, voffB);
            PG8_BAR; PG8_WAIT_L(0); PG8_MMA(0, 1, At, B1); PG8_BAR;
            PG8_LDA(At, 1, 1); PG8_STAGE(PG8_SA(1, 0), a3, voffA);
            PG8_BAR; PG8_WAIT_L(0); PG8_MMA(1, 0, At, B0); PG8_BAR; PG8_SCHED;
            PG8_STAGE(PG8_SB(1, 1), b3 + hstep, voffB);
            PG8_WAIT_V(6); PG8_BAR; PG8_MMA(1, 1, At, B1); PG8_BAR;
            }
        }
        if constexpr (ALIGN_EPI) { if (wr == 0) PG8_BAR; }
        if constexpr (!Epi::AFTER_DRAIN) { E(acc, cur, wr, wc, fr, fq); S.done(cur); }
        if (!has_next) break;
#pragma unroll
        for (int a = 0; a < 2; ++a)
#pragma unroll
            for (int b = 0; b < 2; ++b)
#pragma unroll
                for (int m = 0; m < 4; ++m)
#pragma unroll
                    for (int n = 0; n < 2; ++n) acc[a][b][m][n] = (f32x4){0.f, 0.f, 0.f, 0.f};
        cur = nxt; cA = nA; cB = nB; ++ui;
        if constexpr (ALIGN_EPI) { if (wr == 1) PG8_BAR; }
    }
    PG8_WAIT_V(0);
    if constexpr (!ALIGN_EPI) { if (wr == 0) PG8_BAR; }
    PG8_BAR;
    if constexpr (Epi::AFTER_DRAIN) { E.fused(acc, cur, wr, wc, fr, fq, lds, wid, lane); S.done(cur); }
#undef PG8_SA
#undef PG8_SB
#undef PG8_STAGE
#undef PG8_LDA
#undef PG8_LDB
#undef PG8_MMA
#undef PG8_WAIT_V
#undef PG8_WAIT_L
#undef PG8_BAR
#undef PG8_SCHED
}
}

#ifndef MEGA_ALL
#define MEGA_ALL 0
#endif
#define PG8_SP2 true
#define PG8_ALIGN true
constexpr int NWAVES = 8;
constexpr int T = 16384, D = 1024, GW = 256, PIN = 3152, ZLD = 3328;
constexpr int DFF = 2816, NE = 8, DFE = 3584, DFH = 1792;
constexpr int MOE_MAXTILES = 136, MOE_MAXROWS = MOE_MAXTILES * 256;
constexpr float LN_EPS = 1e-5f, RMS_EPS = 1e-6f, GN_EPS = 64e-5f;
constexpr float ALPHA = 1.4142135623730951f;
constexpr int Z_GQ = 0, Z_GK = 128, Z_GV = 256, Z_GG = 512, Z_GGK = 768, Z_HQ = 784, Z_HF = 1040, Z_HI = 1296, Z_HG = 1552,
              Z_SQ = 1808, Z_SK = 2064, Z_SV = 2192, Z_RZ = 2320, Z_VD = 3152;
constexpr size_t MiB = 1u << 20;
constexpr size_t WS_MOEGU = 0, WS_MOED = 56 * MiB;
constexpr size_t WS_WIN0 = 84 * MiB, WS_WIN1 = WS_WIN0 + (size_t)ZLD * D * 2, WS_WOUT0 = 97 * MiB, WS_WOUT1 = 99 * MiB, WS_FGU = 101 * MiB, WS_FD = 112 * MiB,
                 WS_PG0 = 117 * MiB + 512 * 1024, WS_PG1 = WS_PG0 + 2 * MiB, WS_PP0 = WS_PG1 + 2 * MiB, WS_PP1 = WS_PP0 + 512 * 1024;
constexpr size_t WS_XB0 = 123 * MiB, WS_XB1 = 155 * MiB, WS_VFIRST = 187 * MiB, WS_PB0 = 203 * MiB, WS_PB1 = 211 * MiB, WS_MISC = 219 * MiB, WS_CTL = 222 * MiB, CTL_BYTES = 1 * MiB;
constexpr size_t WS_R = 224 * MiB;
constexpr size_t WS_Z = WS_R, WS_MIX = WS_R + 104 * MiB, WS_PREP = WS_R + 136 * MiB, WS_PRELN = WS_R + 136 * MiB;
constexpr size_t WS_HD = WS_R, WS_HM = WS_R, WS_XG = WS_R + 119 * MiB, WS_Y1 = WS_R + 187 * MiB, WS_PPO = WS_R;
constexpr size_t WS_END = 480 * MiB + 27 * MiB;
static_assert(WS_WIN1 + (size_t)ZLD * D * 2 <= WS_WOUT0 && WS_PP1 + 512 * 1024 <= WS_XB0, "weights map");
static_assert(WS_HM + (size_t)MOE_MAXROWS * DFH * 2 <= WS_XG && WS_XG + (size_t)MOE_MAXROWS * D * 2 <= WS_Y1 && WS_Y1 + (size_t)MOE_MAXROWS * D * 2 <= WS_END, "moe map");
static_assert(WS_PREP + 120 * MiB <= WS_END && WS_Z + (size_t)T * ZLD * 2 <= WS_MIX, "mixer map");
constexpr size_t MS_TOPE = 65536, MS_TOPG = MS_TOPE + 131072, MS_TOKROW = MS_TOPG + 131072, MS_ROWTOK = MS_TOKROW + 131072, MS_TILEE = MS_ROWTOK + 196608;
constexpr size_t MS_PARAMS = 1 * MiB;
constexpr int P_GKUP = 0, P_GKB = P_GKUP + 2 * 2048, P_GNW = P_GKB + 2 * 128, P_HLB = P_GNW + 2 * 64, P_HNW = P_HLB + 2 * 256, P_SINK = P_HNW + 2 * 64, P_MU = P_SINK + 8,
              P_W0 = P_MU + 2 * 832, P_WUP = P_W0 + 2 * 256, P_A0 = P_WUP + 2 * 4096, P_AUP = P_A0 + 2 * 256, P_GUP = P_AUP + 2 * 4096, P_KK = P_GUP + 2 * 8192, P_KA = P_KK + 2 * 256,
              P_RK = P_KA + 2 * 256, P_LNXW = P_RK + 2 * 256, P_LNXB = P_LNXW + 2 * 256, P_VMU = P_LNXB + 2 * 256, P_V0 = P_VMU + 8, P_VUP = P_V0 + 256, P_LN1G = P_VUP + 2048,
              P_LN1B = P_LN1G + 2048, P_LN2G = P_LN1B + 2048, P_LN2B = P_LN2G + 2048, P_ROUTER = P_LN2B + 2048, P_LBS = P_ROUTER + 8192, P_END = P_LBS + 512;
static_assert(P_END * 4 <= 1 * MiB, "params block");
constexpr int CW_BAR = 4096, CW_MOE = 16384;
constexpr int LDS_BYTES = 147456, RING_BYTES = 131072, MISC_OFF = RING_BYTES + 320;

#define GAS __attribute__((address_space(1)))
#define LAS __attribute__((address_space(3)))
typedef unsigned short bf16;
typedef unsigned v4u __attribute__((ext_vector_type(4)));
typedef unsigned v2u __attribute__((ext_vector_type(2)));
typedef float f32x4 __attribute__((ext_vector_type(4)));
typedef short bf16x8 __attribute__((ext_vector_type(8)));
typedef GAS unsigned gu32;
#define RLX_AGENT __ATOMIC_RELAXED, __HIP_MEMORY_SCOPE_AGENT
#define LDS_WAIT() asm volatile("s_waitcnt lgkmcnt(0)" ::: "memory")
#define VM_WAIT() asm volatile("s_waitcnt vmcnt(0)" ::: "memory")
__device__ __forceinline__ unsigned f2bf(float f) { unsigned u = __builtin_bit_cast(unsigned, f); return (u + 0x7fffu + ((u >> 16) & 1u)) >> 16; }
__device__ __forceinline__ unsigned pk2(float lo, float hi) { return f2bf(lo) | (f2bf(hi) << 16); }
__device__ __forceinline__ float bf2f(unsigned short b) { return __uint_as_float(((unsigned)b) << 16); }
__device__ __forceinline__ float sigmoidf_(float x) { return 1.f / (1.f + __expf(-x)); }
__device__ __forceinline__ float siluf_(float x) { return x / (1.f + __expf(-x)); }
__device__ __forceinline__ float softplusf_(float x) { return fmaxf(x, 0.f) + log1pf(__expf(-fabsf(x))); }
__device__ __forceinline__ float logsigmoidf_(float x) { return -softplusf_(-x); }
__device__ __forceinline__ float wave_sum(float v) {
#pragma unroll
    for (int o = 1; o < 64; o <<= 1) v += __shfl_xor(v, o);
    return v;
}
__device__ __forceinline__ float wave_max(float v) {
#pragma unroll
    for (int o = 1; o < 64; o <<= 1) v = fmaxf(v, __shfl_xor(v, o));
    return v;
}
#define XB_TMO      128
#define XB_XCNT(j)  (256  + 64 * (j))
#define XB_XSUB(j)  (1280 + 64 * (j))
#define XB_XGEN(j)  (2304 + 64 * (j))
#define XB_TOP      3328
#define XB_TOPGEN   3392
#define XCD_BAR_WORDS 3456
#define XB_SPIN_CAP (1u << 27)

__device__ __forceinline__ unsigned xb_ld(unsigned* p)              { return __hip_atomic_load(p, __ATOMIC_RELAXED, __HIP_MEMORY_SCOPE_AGENT); }
__device__ __forceinline__ unsigned xb_add(unsigned* p, unsigned v) { return __hip_atomic_fetch_add(p, v, __ATOMIC_RELAXED, __HIP_MEMORY_SCOPE_AGENT); }
__device__ __forceinline__ unsigned xb_xcc_id() { return (unsigned)__builtin_amdgcn_s_getreg((3 << 11) | 20) & 0xFu; }
#define XB_SPIN(cond, bar) do { unsigned _sp = 0; while (cond) { __builtin_amdgcn_s_sleep(1); \
    if ((++_sp & 255u) == 0u) { if (xb_ld(&(bar)[XB_TMO])) break; if (_sp > XB_SPIN_CAP) { atomicAdd(&(bar)[XB_TMO], 1u); break; } } } } while (0)

struct XcdBarrier {
    unsigned* bar; unsigned x;
    volatile LAS unsigned* st;
};

__device__ __forceinline__ XcdBarrier xcd_barrier_post(unsigned* bar, volatile LAS unsigned* st) {
    XcdBarrier b; b.bar = bar; b.x = xb_xcc_id(); b.st = st;
    if (threadIdx.x == 0) (void)xb_add(&bar[XB_XCNT(b.x)], 1u);
    return b;
}
__device__ __forceinline__ void xcd_barrier_complete(unsigned* bar, unsigned x, unsigned& nloc, unsigned& nx) {
    const unsigned G = gridDim.x * gridDim.y * gridDim.z;
    unsigned sum, cnt, mine, sp = 0u;
    for (;;) {
        sum = 0u; cnt = 0u; mine = 0u;
#pragma unroll
        for (unsigned j = 0; j < 16; ++j) { const unsigned c = xb_ld(&bar[XB_XCNT(j)]); sum += c; cnt += (c > 0u) ? 1u : 0u; }
        if (sum == G) break;
        __builtin_amdgcn_s_sleep(1);
        if ((++sp & 255u) == 0u) { if (xb_ld(&bar[XB_TMO])) break; if (sp > XB_SPIN_CAP) { atomicAdd(&bar[XB_TMO], 1u); break; } }
    }
    mine = xb_ld(&bar[XB_XCNT(x)]);
    nloc = mine > 0u ? mine : 1u; nx = cnt > 0u ? cnt : 1u;
}

__device__ __forceinline__ void xcd_barrier(const XcdBarrier& b) {
    asm volatile("s_waitcnt vmcnt(0)" ::: "memory");
    __syncthreads();
    if (threadIdx.x == 0) {
        unsigned* bar = b.bar;
        __builtin_amdgcn_s_waitcnt(0);
        unsigned nloc = b.st[0], nx = b.st[1];
        if (nloc == 0u) { xcd_barrier_complete(bar, b.x, nloc, nx); b.st[0] = nloc; b.st[1] = nx; }
        const unsigned old = xb_add(&bar[XB_XSUB(b.x)], 1u);
        const unsigned gen = old / nloc;
        if (old + 1u == (gen + 1u) * nloc) {
            __builtin_amdgcn_fence(__ATOMIC_RELEASE, "agent");
            asm volatile("s_waitcnt vmcnt(0)" ::: "memory");
            const unsigned og = xb_add(&bar[XB_TOP], 1u);
            const unsigned tg = og / nx;
            if (og + 1u == (tg + 1u) * nx) xb_add(&bar[XB_TOPGEN], 1u);
            else XB_SPIN(xb_ld(&bar[XB_TOPGEN]) == tg, bar);
            __builtin_amdgcn_fence(__ATOMIC_ACQUIRE, "agent");
            xb_add(&bar[XB_XGEN(b.x)], 1u);
            asm volatile("s_waitcnt vmcnt(0)" ::: "memory");
        } else {
            XB_SPIN(xb_ld(&bar[XB_XGEN(b.x)]) == gen, bar);
            __builtin_amdgcn_fence(__ATOMIC_ACQUIRE, "agent");
            asm volatile("s_waitcnt vmcnt(0)" ::: "memory");
        }
    }
    __syncthreads();
}

__device__ __forceinline__ void tr_item(const float* src, int ldw, int nvalid, bf16* dst, int dld, LAS float* scr, int lane) {
    const int nl = lane & 31;
#pragma unroll 8
    for (int i = 0; i < 32; ++i) { const int kk = 2 * i + (lane >> 5); scr[kk * 33 + nl] = (nl < nvalid) ? src[(size_t)kk * ldw + nl] : 0.f; }
    LDS_WAIT(); asm volatile("" ::: "memory");
    const int c = lane & 7;
#pragma unroll
    for (int j = 0; j < 4; ++j) { const int n = (lane >> 3) + 8 * j; const LAS float* s = scr + (8 * c) * 33 + n;
        v4u o; o.x = pk2(s[0 * 33], s[1 * 33]); o.y = pk2(s[2 * 33], s[3 * 33]); o.z = pk2(s[4 * 33], s[5 * 33]); o.w = pk2(s[6 * 33], s[7 * 33]);
        if (n < nvalid) *(GAS v4u*)(dst + (size_t)n * dld + 8 * c) = o; }
    LDS_WAIT(); asm volatile("" ::: "memory");
}
__device__ __forceinline__ void tr_job(const float* src, int ldw, int nblocks, int ncols, bf16* dst, int dld, int il, int rowoff, int it, LAS float* scr, int lane) {
    const int kb = it / nblocks, nb = it - kb * nblocks, n0 = nb * 32; const int nv = (ncols - n0) < 32 ? (ncols - n0) : 32;
    const int row = il ? ((n0 >> 7) * 256 + (n0 & 127) + rowoff) : (n0 + rowoff);
    tr_item(src + (size_t)kb * 64 * ldw + n0, ldw, nv, dst + (size_t)row * dld + kb * 64, dld, scr, lane);
}
__device__ __forceinline__ void moe_weights_half(const float* wg, const float* wu, const float* wd, bf16* gu, bf16* dn, int hh, int gw, int NGW, LAS float* scr, int lane) {
    constexpr int PER = 896, PE = 3 * PER;
    for (int it = gw; it < NE * PE; it += NGW) {
        const int e = it / PE, r = it - e * PE, which = r / PER, idx = r - which * PER;
        const float* src; int ldw, nblocks, ncols, dld, il, rowoff; bf16* dst;
        if (which == 0) { src = wg + (size_t)e * D * DFE + hh * DFH; ldw = DFE; nblocks = 56; ncols = DFH; dst = gu + (size_t)e * 3584 * D; dld = D; il = 1; rowoff = 0; }
        else if (which == 1) { src = wu + (size_t)e * D * DFE + hh * DFH; ldw = DFE; nblocks = 56; ncols = DFH; dst = gu + (size_t)e * 3584 * D; dld = D; il = 1; rowoff = 128; }
        else { src = wd + (size_t)e * DFE * D + (size_t)hh * DFH * D; ldw = D; nblocks = 32; ncols = D; dst = dn + (size_t)e * D * DFH; dld = DFH; il = 0; rowoff = 0; }
        tr_job(src, ldw, nblocks, ncols, dst, dld, il, rowoff, idx, scr, lane);
    }
}
__device__ __forceinline__ void cvt_rows(const float* src, bf16* dst, size_t n, size_t gtid, size_t nthreads) {
    for (size_t i = gtid * 8; i < n; i += nthreads * 8) { const f32x4 a = *(const GAS f32x4*)(src + i), b = *(const GAS f32x4*)(src + i + 4);
        v4u o; o.x = pk2(a[0], a[1]); o.y = pk2(a[2], a[3]); o.z = pk2(b[0], b[1]); o.w = pk2(b[2], b[3]); *(GAS v4u*)(dst + i) = o; }
}

struct LnArgs { const float* src; const float* gam; const float* bet; float* xout; bf16* xb; int mode; const bf16* Y1; const bf16* Y2; const int* tok_row; const float* top_g;
                int route; const float* router; int* top_e; float* top_gw; gu32* cnt; };
__device__ __forceinline__ void ln_rows(const LnArgs& a, int gw, int NGW, int lane) {
    for (int row = gw; row < T; row += NGW) {
        f32x4 v[4]; float s = 0.f;
        if (a.mode == 0) {
#pragma unroll
            for (int j = 0; j < 4; ++j) v[j] = *((const GAS f32x4*)(a.src + (size_t)row * D) + lane + 64 * j);
        } else {
            const int r0 = a.tok_row[row * 2], r1 = a.tok_row[row * 2 + 1]; const float g0 = a.top_g[row * 2], g1 = a.top_g[row * 2 + 1];
#pragma unroll
            for (int j = 0; j < 4; ++j) {
                const f32x4 xv = *((const GAS f32x4*)(a.xout + (size_t)row * D) + lane + 64 * j);
                const v2u a0 = *((const GAS v2u*)(a.Y1 + (size_t)r0 * D) + lane + 64 * j), b0 = *((const GAS v2u*)(a.Y2 + (size_t)r0 * D) + lane + 64 * j);
                const v2u a1 = *((const GAS v2u*)(a.Y1 + (size_t)r1 * D) + lane + 64 * j), b1 = *((const GAS v2u*)(a.Y2 + (size_t)r1 * D) + lane + 64 * j);
                f32x4 y0, y1;
                y0[0] = __uint_as_float(a0.x << 16) + __uint_as_float(b0.x << 16); y0[1] = __uint_as_float(a0.x & 0xffff0000u) + __uint_as_float(b0.x & 0xffff0000u);
                y0[2] = __uint_as_float(a0.y << 16) + __uint_as_float(b0.y << 16); y0[3] = __uint_as_float(a0.y & 0xffff0000u) + __uint_as_float(b0.y & 0xffff0000u);
                y1[0] = __uint_as_float(a1.x << 16) + __uint_as_float(b1.x << 16); y1[1] = __uint_as_float(a1.x & 0xffff0000u) + __uint_as_float(b1.x & 0xffff0000u);
                y1[2] = __uint_as_float(a1.y << 16) + __uint_as_float(b1.y << 16); y1[3] = __uint_as_float(a1.y & 0xffff0000u) + __uint_as_float(b1.y & 0xffff0000u);
                v[j] = xv * ALPHA + y0 * g0 + y1 * g1;
            }
        }
#pragma unroll
        for (int j = 0; j < 4; ++j) s += (v[j][0] + v[j][1]) + (v[j][2] + v[j][3]);
        const float mean = wave_sum(s) * (1.f / D); float q = 0.f;
#pragma unroll
        for (int j = 0; j < 4; ++j) { v[j] = v[j] - mean; q += (v[j][0] * v[j][0] + v[j][1] * v[j][1]) + (v[j][2] * v[j][2] + v[j][3] * v[j][3]); }
        const float rstd = rsqrtf(wave_sum(q) * (1.f / D) + LN_EPS);
#pragma unroll
        for (int j = 0; j < 4; ++j) {
            const f32x4 gg = *((const GAS f32x4*)a.gam + lane + 64 * j), bb = *((const GAS f32x4*)a.bet + lane + 64 * j);
            v[j] = v[j] * rstd * gg + bb;
            *((GAS f32x4*)(a.xout + (size_t)row * D) + lane + 64 * j) = v[j];
            v2u w; w.x = pk2(v[j][0], v[j][1]); w.y = pk2(v[j][2], v[j][3]);
            *((GAS v2u*)(a.xb + (size_t)row * D) + lane + 64 * j) = w;
        }
        if (a.route) {
            float lg[8];
#pragma unroll
            for (int e = 0; e < 8; ++e) lg[e] = 0.f;
#pragma unroll
            for (int j = 0; j < 4; ++j)
#pragma unroll
                for (int i = 0; i < 4; ++i) { const int d = 4 * lane + 256 * j + i; const f32x4 r0 = *(const GAS f32x4*)(a.router + d * 8), r1 = *(const GAS f32x4*)(a.router + d * 8 + 4); const float xv = v[j][i];
                    lg[0] += xv * r0[0]; lg[1] += xv * r0[1]; lg[2] += xv * r0[2]; lg[3] += xv * r0[3]; lg[4] += xv * r1[0]; lg[5] += xv * r1[1]; lg[6] += xv * r1[2]; lg[7] += xv * r1[3]; }
#pragma unroll
            for (int e = 0; e < 8; ++e) lg[e] = wave_sum(lg[e]);
            if (lane == 0) {
                int e0 = 0; float l0 = lg[0];
#pragma unroll
                for (int e = 1; e < 8; ++e) if (lg[e] > l0) { l0 = lg[e]; e0 = e; }
                int e1 = 0; float l1 = -INFINITY;
#pragma unroll
                for (int e = 0; e < 8; ++e) if (e != e0 && lg[e] > l1) { l1 = lg[e]; e1 = e; }
                const float g1 = __expf(l1 - l0), den = 1.f + g1;
                a.top_e[row * 2] = e0; a.top_e[row * 2 + 1] = e1; a.top_gw[row * 2] = 1.f / den; a.top_gw[row * 2 + 1] = g1 / den;
                __hip_atomic_fetch_add(a.cnt + e0, 1u, RLX_AGENT); __hip_atomic_fetch_add(a.cnt + e1, 1u, RLX_AGENT);
            }
        }
    }
}

struct PrepArgs { const bf16* z; const float* P; float* gla_logf; float* rwb; float* vfirst; int layer; int pad; };
template <int NT> __device__ __forceinline__ void prep_tokens(const PrepArgs& p, LAS float* sm, int vcu, int G, int tid) {
    const int half = tid >> 8, c = tid & 255;
    LAS float* lr = sm + half * 128; LAS float* gd = lr + 80;
    for (int t0 = vcu * NT; t0 < T; t0 += G * NT) {
        const int t = t0 + half;
        const bf16* zt = p.z + (size_t)t * ZLD; const bf16* zp = zt - ZLD;
        __syncthreads();
        if (c < 16) gd[c] = bf2f(zt[Z_GGK + c]);
        if (c < 72) {
            const int col = (c < 64) ? (Z_RZ + 768 + c) : (Z_VD + c - 64);
            if (c < 64 || p.layer > 0) {
                const float cur = bf2f(zt[col]), prev = t > 0 ? bf2f(zp[col]) : 0.f;
                const float m = (c < 64) ? p.P[P_MU + p.layer * 832 + 768 + c] : p.P[P_VMU + c - 64];
                lr[c] = cur + (prev - cur) * m;
            }
        }
        __syncthreads();
        if (c < 128) {
            float s = p.P[P_GKB + p.layer * 128 + c];
#pragma unroll
            for (int j = 0; j < 16; ++j) s += gd[j] * p.P[P_GKUP + p.layer * 2048 + j * 128 + c];
            p.gla_logf[(size_t)t * 128 + c] = logsigmoidf_(s) * (1.f / 16.f);
        }
        float rr, kk0, vv;
        {
            const float c0 = bf2f(zt[Z_RZ + c]), p0 = t > 0 ? bf2f(zp[Z_RZ + c]) : 0.f; rr = c0 + (p0 - c0) * p.P[P_MU + p.layer * 832 + c];
            const float c1 = bf2f(zt[Z_RZ + 256 + c]), p1 = t > 0 ? bf2f(zp[Z_RZ + 256 + c]) : 0.f; kk0 = c1 + (p1 - c1) * p.P[P_MU + p.layer * 832 + 256 + c];
            const float c2 = bf2f(zt[Z_RZ + 512 + c]), p2 = t > 0 ? bf2f(zp[Z_RZ + 512 + c]) : 0.f; vv = c2 + (p2 - c2) * p.P[P_MU + p.layer * 832 + 512 + c];
        }
        float sw = p.P[P_W0 + p.layer * 256 + c], sa = p.P[P_A0 + p.layer * 256 + c], sg = 0.f;
#pragma unroll
        for (int j = 0; j < 16; ++j) { sw += tanhf(lr[j]) * p.P[P_WUP + p.layer * 4096 + j * 256 + c]; sa += lr[16 + j] * p.P[P_AUP + p.layer * 4096 + j * 256 + c]; }
#pragma unroll
        for (int j = 0; j < 32; ++j) sg += sigmoidf_(lr[32 + j]) * p.P[P_GUP + p.layer * 8192 + j * 256 + c];
        const float wlog = -softplusf_(-sw) - 0.5f;
        const float decay = __expf(-__expf(wlog));
        const float av = sigmoidf_(sa);
        if (p.layer == 0) p.vfirst[(size_t)t * 256 + c] = vv;
        else {
            float sv = p.P[P_V0 + c];
#pragma unroll
            for (int j = 0; j < 8; ++j) sv += lr[64 + j] * p.P[P_VUP + j * 256 + c];
            vv = vv + (p.vfirst[(size_t)t * 256 + c] - vv) * sigmoidf_(sv);
        }
        float kk = kk0 * p.P[P_KK + p.layer * 256 + c];
        const float ss = wave_sum(kk * kk);
        kk = kk / fmaxf(sqrtf(ss), 1e-12f);
        const float k2 = kk0 * (1.f + (av - 1.f) * p.P[P_KA + p.layer * 256 + c]);
        const size_t o = (size_t)t * 256 + c;
        constexpr size_t TS = (size_t)T * 256; p.rwb[o] = rr; p.rwb[TS + o] = decay; p.rwb[2 * TS + o] = k2; p.rwb[3 * TS + o] = vv; p.rwb[4 * TS + o] = -kk; p.rwb[5 * TS + o] = kk * av; p.rwb[6 * TS + o] = sg;
    }
}

struct RecArgs { const bf16* z; const float* gla_logf; const float* P; const float* rwb; bf16* mix; int layer; int pad; };
constexpr int RCH = 32;
__device__ __forceinline__ void rec_wave(const RecArgs& p, LAS float* sm, int blk, int lane) {
    if (blk < 8) {
        const bool gla = blk < 4; const int h = blk & 3; const int DK = gla ? 32 : 64;
        float S[64];
#pragma unroll
        for (int k = 0; k < 64; ++k) S[k] = 0.f;
        const float nw = gla ? p.P[P_GNW + p.layer * 64 + lane] : p.P[P_HNW + p.layer * 64 + lane];
        for (int t0 = 0; t0 < T; t0 += RCH) {
            LDS_WAIT(); asm volatile("" ::: "memory");
            for (int i = lane; i < RCH * DK; i += 64) {
                const int s = i / DK, k = i % DK; const bf16* zt = p.z + (size_t)(t0 + s) * ZLD;
                float q, kv, f;
                if (gla) { q = bf2f(zt[Z_GQ + h * 32 + k]) * 0.17677669529663687f; kv = bf2f(zt[Z_GK + h * 32 + k]); f = __expf(p.gla_logf[(size_t)(t0 + s) * 128 + h * 32 + k]); }
                else {
                    const float fq = bf2f(zt[Z_HQ + h * 64 + k]), ff = bf2f(zt[Z_HF + h * 64 + k]), lb = p.P[P_LBS + p.layer * 256 + h * 64 + k];
                    q = siluf_(fq); f = lb + (1.f - lb) * sigmoidf_(ff); kv = (1.f - lb) * sigmoidf_(-ff);
                }
                sm[(s * 3 + 0) * 64 + k] = q; sm[(s * 3 + 1) * 64 + k] = kv; sm[(s * 3 + 2) * 64 + k] = f;
            }
            LDS_WAIT(); asm volatile("" ::: "memory");
            for (int s = 0; s < RCH; ++s) {
                const int t = t0 + s; const bf16* zt = p.z + (size_t)t * ZLD;
                const float vj = bf2f(gla ? zt[Z_GV + h * 64 + lane] : zt[Z_HI + h * 64 + lane]);
                const float gj = bf2f(gla ? zt[Z_GG + h * 64 + lane] : zt[Z_HG + h * 64 + lane]);
                float o = 0.f;
                if (gla) {
#pragma unroll
                    for (int k = 0; k < 32; ++k) { S[k] = S[k] * sm[(s * 3 + 2) * 64 + k] + sm[(s * 3 + 1) * 64 + k] * vj; o += S[k] * sm[(s * 3 + 0) * 64 + k]; }
                } else {
#pragma unroll
                    for (int k = 0; k < 64; ++k) { S[k] = S[k] * sm[(s * 3 + 2) * 64 + k] + sm[(s * 3 + 1) * 64 + k] * vj; o += S[k] * sm[(s * 3 + 0) * 64 + k]; }
                }
                const float ms = wave_sum(o * o) * (1.f / 64.f);
                const float res = o * rsqrtf(ms + RMS_EPS) * nw * siluf_(gj);
                p.mix[(size_t)t * D + (gla ? 0 : 256) + h * 64 + lane] = (bf16)f2bf(res);
            }
        }
    } else {
        const int h = blk - 8, c = h * 64 + lane;
        float S[64];
#pragma unroll
        for (int k = 0; k < 64; ++k) S[k] = 0.f;
        const float lw = p.P[P_LNXW + p.layer * 256 + c], lb = p.P[P_LNXB + p.layer * 256 + c], rk = p.P[P_RK + p.layer * 256 + c]; constexpr size_t TS = (size_t)T * 256;
        for (int t0 = 0; t0 < T; t0 += RCH) {
            LDS_WAIT(); asm volatile("" ::: "memory");
            for (int i = lane; i < RCH * 64; i += 64) {
                const int s = i >> 6, k = i & 63; const size_t o = (size_t)(t0 + s) * 256 + h * 64 + k;
                sm[(s * 5 + 0) * 64 + k] = p.rwb[o]; sm[(s * 5 + 1) * 64 + k] = p.rwb[TS + o]; sm[(s * 5 + 2) * 64 + k] = p.rwb[2 * TS + o];
                sm[(s * 5 + 3) * 64 + k] = p.rwb[4 * TS + o]; sm[(s * 5 + 4) * 64 + k] = p.rwb[5 * TS + o];
            }
            LDS_WAIT(); asm volatile("" ::: "memory");
            for (int s = 0; s < RCH; ++s) {
                const int t = t0 + s; const size_t o = (size_t)t * 256 + c;
                const float vi = p.rwb[3 * TS + o], gi = p.rwb[6 * TS + o];
                const LAS float* R = sm + (s * 5 + 0) * 64; const LAS float* Wd = sm + (s * 5 + 1) * 64; const LAS float* Kv = sm + (s * 5 + 2) * 64;
                const LAS float* Av = sm + (s * 5 + 3) * 64; const LAS float* Bv = sm + (s * 5 + 4) * 64;
                float sa = 0.f;
#pragma unroll
                for (int k = 0; k < 64; ++k) sa += S[k] * Av[k];
                float y = 0.f;
#pragma unroll
                for (int k = 0; k < 64; ++k) { S[k] = S[k] * Wd[k] + sa * Bv[k] + vi * Kv[k]; y += S[k] * R[k]; }
                const float bon = wave_sum(R[lane] * Kv[lane] * rk);
                const float mu = wave_sum(y) * (1.f / 64.f); const float d = y - mu;
                const float var = wave_sum(d * d) * (1.f / 64.f);
                const float yn = d * rsqrtf(var + GN_EPS) * lw + lb;
                p.mix[(size_t)t * D + 768 + c] = (bf16)f2bf((yn + bon * vi) * gi);
            }
        }
    }
}

__device__ __forceinline__ void swa_items(const bf16* z, const float* sinks, bf16* mix, int w0, int NW, int lane) {
    for (int item = w0; item < T * 4; item += NW) {
        const int t = item >> 2, h = item & 3, kvh = h >> 1;
        const bf16* q = z + (size_t)t * ZLD + Z_SQ + h * 64;
        float sc[2];
#pragma unroll
        for (int i = 0; i < 2; ++i) {
            const int s = t - (lane + 64 * i);
            float d = -INFINITY;
            if (s >= 0) {
                const bf16* kp = z + (size_t)s * ZLD + Z_SK + kvh * 64;
                float acc = 0.f;
#pragma unroll
                for (int j = 0; j < 8; ++j) { const v4u a = *(const GAS v4u*)(q + 8 * j), b = *(const GAS v4u*)(kp + 8 * j);
#pragma unroll
                    for (int e = 0; e < 4; ++e) acc += __uint_as_float(a[e] << 16) * __uint_as_float(b[e] << 16) + __uint_as_float(a[e] & 0xffff0000u) * __uint_as_float(b[e] & 0xffff0000u); }
                d = acc * 0.125f;
            }
            sc[i] = d;
        }
        const float sink = sinks[h];
        const float m = fmaxf(wave_max(fmaxf(sc[0], sc[1])), sink);
        const float e0 = (sc[0] == -INFINITY) ? 0.f : __expf(sc[0] - m), e1 = (sc[1] == -INFINITY) ? 0.f : __expf(sc[1] - m);
        const float den = wave_sum(e0 + e1) + __expf(sink - m);
        const float p0 = e0 / den, p1 = e1 / den;
        float o = 0.f;
        for (int dd = 0; dd < 128; ++dd) {
            const int s = t - dd; if (s < 0) break;
            const float pv = __shfl(dd < 64 ? p0 : p1, dd & 63);
            o += pv * bf2f(z[(size_t)s * ZLD + Z_SV + kvh * 64 + lane]);
        }
        mix[(size_t)t * D + 512 + h * 64 + lane] = (bf16)f2bf(o);
    }
}

struct Args { const float* in[38]; float* out; unsigned char* ws; };
template <int I> __device__ __forceinline__ const float* in_ptr() {
    unsigned long long v; auto kp = __builtin_amdgcn_kernarg_segment_ptr();
    asm volatile("s_load_dwordx2 %0, %1, %2\n\ts_waitcnt lgkmcnt(0)" : "=s"(v) : "s"(kp), "n"(I * 8));
    return (const float*)v;
}
#define IN(i) in_ptr<(i)>()
#define GRID_BAR() xcd_barrier(bar)
template <int L, bool DO_IN, bool DO_MIX, bool DO_POST>
__device__ __forceinline__ void layer_body(const Args& args, LAS unsigned char* lds, const XcdBarrier& bar, int tid, int lane, int wave, int G, int bx, int vcu, int gw, int NGW) {
    unsigned char* ws = args.ws;
    gu32* ctl = (gu32*)(ws + WS_CTL);
    bf16* Wmoegu = (bf16*)(ws + WS_MOEGU); bf16* Wmoed = (bf16*)(ws + WS_MOED);
    float* vfirst = (float*)(ws + WS_VFIRST);
    bf16* zb = (bf16*)(ws + WS_Z); bf16* mix = (bf16*)(ws + WS_MIX); float* preln = (float*)(ws + WS_PRELN);
    float* gla_logf = (float*)(ws + WS_PREP); float* rwb = (float*)(ws + WS_PREP + 8 * MiB);
    const float* PB = (const float*)(ws + WS_MISC + MS_PARAMS); int* top_e = (int*)(ws + WS_MISC + MS_TOPE); float* top_g = (float*)(ws + WS_MISC + MS_TOPG);
    int* tok_row = (int*)(ws + WS_MISC + MS_TOKROW); int* row_tok = (int*)(ws + WS_MISC + MS_ROWTOK); int* tile_e = (int*)(ws + WS_MISC + MS_TILEE);
    float* xf = args.out;

        bf16* xb_in = (bf16*)(ws + (L == 0 ? WS_XB0 : WS_XB1)); bf16* xb_out = (bf16*)(ws + (L == 0 ? WS_XB1 : WS_XB0));
        const float* xres = (L == 0) ? IN(0) : xf;
        if constexpr (DO_IN) {
        {
            pg8::Gemm g{xb_in, (const bf16*)(ws + (L == 0 ? WS_WIN0 : WS_WIN1)), T, ZLD, D}; pg8::StaticOrder S; S.init(T, ZLD, G, bx);
            pg8::EpiStoreBf16 E{zb, ZLD};
            pg8::gemm_phase<pg8::EpiStoreBf16, pg8::StaticOrder, PG8_ALIGN, PG8_SP2>(lds, g, S, E);
        }
        if constexpr (DO_MIX || DO_POST) GRID_BAR();
        }
        if constexpr (DO_MIX) {
        {
            PrepArgs pa{}; pa.z = zb; pa.layer = L; pa.P = PB; pa.gla_logf = gla_logf; pa.rwb = rwb; pa.vfirst = vfirst;
            prep_tokens<2>(pa, (LAS float*)lds, vcu, G, tid);
        }
        GRID_BAR();
        {
            if (bx < 12) {
                if (wave == 0) {
                    RecArgs ra{}; ra.z = zb; ra.gla_logf = gla_logf; ra.P = PB; ra.layer = L; ra.rwb = rwb; ra.mix = mix;
                    rec_wave(ra, (LAS float*)lds, bx, lane);
                }
            } else swa_items(zb, PB + P_SINK + L * 4, mix, (bx - 12) * NWAVES + wave, (G - 12) * NWAVES, lane);
        }
        GRID_BAR();
        }
        if constexpr (DO_POST) {
        {
            pg8::Gemm g{mix, (const bf16*)(ws + (L == 0 ? WS_WOUT0 : WS_WOUT1)), T, D, D}; pg8::StaticOrder S; S.init(T, D, G, bx);
            pg8::EpiResF32 E{xres, preln, D, ALPHA};
            pg8::gemm_phase<pg8::EpiResF32, pg8::StaticOrder, PG8_ALIGN, PG8_SP2>(lds, g, S, E);
        }
        GRID_BAR();
        {
            LnArgs la{}; la.src = preln; la.gam = PB + P_LN1G + L * D; la.bet = PB + P_LN1B + L * D; la.xout = xf; la.xb = xb_in; la.mode = 0;
            la.route = (L == 1); la.router = PB + P_ROUTER; la.top_e = top_e; la.top_gw = top_g; la.cnt = ctl + CW_MOE;
            ln_rows(la, gw, NGW, lane);
        }
        GRID_BAR();
        if constexpr (L == 0) {
            {
                pg8::Gemm g{xb_in, (const bf16*)(ws + WS_FGU), T, 2 * DFF, D}; pg8::StaticOrder S; S.init(T, 2 * DFF, G, bx);
                pg8::EpiSwiglu E{(bf16*)(ws + WS_HD), DFF};
                pg8::gemm_phase<pg8::EpiSwiglu, pg8::StaticOrder, PG8_ALIGN, PG8_SP2>(lds, g, S, E);
            }
            GRID_BAR();
            {
                pg8::Gemm g{(const bf16*)(ws + WS_HD), (const bf16*)(ws + WS_FD), T, D, DFF}; pg8::StaticOrder S; S.init(T, D, G, bx);
                pg8::EpiResF32 E{xf, preln, D, ALPHA};
                pg8::gemm_phase<pg8::EpiResF32, pg8::StaticOrder, PG8_ALIGN, PG8_SP2>(lds, g, S, E);
            }
            GRID_BAR();
            {
                LnArgs la{}; la.src = preln; la.gam = PB + P_LN2G + L * D; la.bet = PB + P_LN2B + L * D; la.xout = xf; la.xb = xb_in; la.mode = 0; la.route = 0;
                ln_rows(la, gw, NGW, lane);
            }
        } else {
            int start[NE + 1]; int nrt;
            {
                int off = 0;
#pragma unroll
                for (int e = 0; e < NE; ++e) { start[e] = off; const int c = (int)__hip_atomic_load(ctl + CW_MOE + e, RLX_AGENT); off += (c + 255) / 256 * 256; }
                start[NE] = off; nrt = off / 256;
                if (bx == 0 && tid < MOE_MAXTILES) { int e = 0;
#pragma unroll
                    for (int q = 1; q < NE; ++q) if (tid * 256 >= start[q]) e = q;
                    tile_e[tid] = e; }
                const int gtid = vcu * (NWAVES * 64) + tid, nth = G * NWAVES * 64;
                for (int i = gtid; i < T * 2; i += nth) { const int e = top_e[i]; const int pos = (int)__hip_atomic_fetch_add(ctl + CW_MOE + 64 + e, 1u, RLX_AGENT);
                    int st = 0;
#pragma unroll
                    for (int q = 0; q < NE; ++q) st = (e == q) ? start[q] : st;
                    const int dest = st + pos; row_tok[dest] = i >> 1; tok_row[i] = dest; }
            }
            GRID_BAR();
            {
                bf16* xg = (bf16*)(ws + WS_XG);
                for (int row = gw; row < nrt * 256; row += NGW) { const int t = row_tok[row];
                    const v4u a = *((const GAS v4u*)(xb_in + (size_t)t * D) + lane), b = *((const GAS v4u*)(xb_in + (size_t)t * D) + 64 + lane);
                    *((GAS v4u*)(xg + (size_t)row * D) + lane) = a; *((GAS v4u*)(xg + (size_t)row * D) + 64 + lane) = b; }
            }
            GRID_BAR();
#pragma unroll
            for (int hh = 0; hh < 2; ++hh) {
                if (hh == 1) { moe_weights_half(IN(33), IN(34), IN(35), Wmoegu, Wmoed, 1, gw, NGW, (LAS float*)(lds + wave * 16384), lane); GRID_BAR(); }
                {
                    pg8::Gemm g{(const bf16*)(ws + WS_XG), Wmoegu, MOE_MAXROWS, 0, D}; pg8::MoeOrder S{tile_e, nrt, 14, G, bx};
                    pg8::EpiSwiglu E{(bf16*)(ws + WS_HM), DFH};
                    pg8::gemm_phase<pg8::EpiSwiglu, pg8::MoeOrder, PG8_ALIGN, PG8_SP2>(lds, g, S, E);
                }
                GRID_BAR();
                {
                    pg8::Gemm g{(const bf16*)(ws + WS_HM), Wmoed, MOE_MAXROWS, 0, DFH}; pg8::MoeOrder S{tile_e, nrt, 4, G, bx};
                    pg8::EpiStoreBf16 E{(bf16*)(ws + (hh == 0 ? WS_Y1 : WS_XG)), D};
                    pg8::gemm_phase<pg8::EpiStoreBf16, pg8::MoeOrder, PG8_ALIGN, PG8_SP2>(lds, g, S, E);
                }
                GRID_BAR();
            }
            {
                LnArgs la{}; la.gam = PB + P_LN2G + L * D; la.bet = PB + P_LN2B + L * D; la.xout = xf; la.xb = xb_in; la.mode = 1; la.Y1 = (const bf16*)(ws + WS_Y1); la.Y2 = (const bf16*)(ws + WS_XG);
                la.tok_row = tok_row; la.top_g = top_g; la.route = 0;
                ln_rows(la, gw, NGW, lane);
            }
        }
        GRID_BAR();
        {
            pg8::Gemm g{(const bf16*)(ws + (L == 0 ? WS_PB0 : WS_PB1)), (const bf16*)(ws + (L == 0 ? WS_PP0 : WS_PP1)), T, D, 256}; pg8::StaticOrder S; S.init(T, D, G, bx);
            pg8::EpiStoreBf16 E{(bf16*)(ws + WS_PPO), D};
            pg8::gemm_phase<pg8::EpiStoreBf16, pg8::StaticOrder, PG8_ALIGN, PG8_SP2>(lds, g, S, E);
        }
        GRID_BAR();
        {
            pg8::Gemm g{xb_in, (const bf16*)(ws + (L == 0 ? WS_PG0 : WS_PG1)), T, D, D}; pg8::StaticOrder S; S.init(T, D, G, bx);
            pg8::EpiPle E{xf, (const bf16*)(ws + WS_PPO), xb_out, D};
            pg8::gemm_phase<pg8::EpiPle, pg8::StaticOrder, PG8_ALIGN, PG8_SP2>(lds, g, S, E);
        }
        }
}
__global__ void __launch_bounds__(NWAVES * 64, 2) mega_fwd(Args args, int seg) {
    extern __shared__ __attribute__((aligned(16))) unsigned char lds_raw[];
    LAS unsigned char* lds = (LAS unsigned char*)lds_raw;
    volatile LAS unsigned* MISC = (volatile LAS unsigned*)(lds + MISC_OFF);
    const int tid = threadIdx.x, lane = tid & 63, wave = __builtin_amdgcn_readfirstlane(tid >> 6);
    const int G = gridDim.x, bx = blockIdx.x; const int vcu = (G % 8 == 0) ? (bx % 8) * (G / 8) + bx / 8 : bx;
    const int gw = vcu * NWAVES + wave, NGW = G * NWAVES;
    unsigned char* ws = args.ws;
    gu32* ctl = (gu32*)(ws + WS_CTL);
    for (int u = tid; u < (LDS_BYTES - RING_BYTES) / 4; u += NWAVES * 64) ((LAS unsigned*)(lds + RING_BYTES))[u] = 0u;
    __syncthreads();
    XcdBarrier bar = xcd_barrier_post((unsigned*)(ctl + CW_BAR) + (seg < 0 ? 0 : seg) * XCD_BAR_WORDS, MISC + 8);
    bf16* Wmoegu = (bf16*)(ws + WS_MOEGU); bf16* Wmoed = (bf16*)(ws + WS_MOED);
    float* vfirst = (float*)(ws + WS_VFIRST);
    bf16* zb = (bf16*)(ws + WS_Z); bf16* mix = (bf16*)(ws + WS_MIX); float* preln = (float*)(ws + WS_PRELN);
    float* gla_logf = (float*)(ws + WS_PREP); float* rwb = (float*)(ws + WS_PREP + 8 * MiB);
    const float* PB = (const float*)(ws + WS_MISC + MS_PARAMS); int* top_e = (int*)(ws + WS_MISC + MS_TOPE); float* top_g = (float*)(ws + WS_MISC + MS_TOPG);
    int* tok_row = (int*)(ws + WS_MISC + MS_TOKROW); int* row_tok = (int*)(ws + WS_MISC + MS_ROWTOK); int* tile_e = (int*)(ws + WS_MISC + MS_TILEE);
    float* xf = args.out;

    if (seg <= 0) {
    {
        LAS float* scr = (LAS float*)(lds + wave * 16384);
        constexpr int I_WIN = 16 * 99, I_VD = 16, I_SQ = 16 * 32, I_FG = 16 * 88, I_FD = 44 * 32, I_PP = 4 * 32;
        constexpr int NIT = 2 * I_WIN + I_VD + 4 * I_SQ + 2 * I_FG + I_FD + 2 * I_PP;
        for (int it = gw; it < NIT; it += NGW) {
            int r = it; const float* src; int ldw, nblocks, ncols, dld, il = 0, rowoff = 0; bf16* dst;
            if (r < I_WIN) { src = IN(2); ldw = PIN; nblocks = 99; ncols = PIN; dst = (bf16*)(ws + WS_WIN0); dld = D; }
            else if ((r -= I_WIN) < I_WIN) { src = IN(2) + (size_t)D * PIN; ldw = PIN; nblocks = 99; ncols = PIN; dst = (bf16*)(ws + WS_WIN1); dld = D; }
            else if ((r -= I_WIN) < I_VD) { src = IN(21); ldw = 8; nblocks = 1; ncols = 8; dst = (bf16*)(ws + WS_WIN1); dld = D; rowoff = PIN; }
            else if ((r -= I_VD) < I_SQ) { src = IN(3); ldw = D; nblocks = 32; ncols = D; dst = (bf16*)(ws + WS_WOUT0); dld = D; }
            else if ((r -= I_SQ) < I_SQ) { src = IN(3) + (size_t)D * D; ldw = D; nblocks = 32; ncols = D; dst = (bf16*)(ws + WS_WOUT1); dld = D; }
            else if ((r -= I_SQ) < I_SQ) { src = IN(37); ldw = D; nblocks = 32; ncols = D; dst = (bf16*)(ws + WS_PG0); dld = D; }
            else if ((r -= I_SQ) < I_SQ) { src = IN(37) + (size_t)D * D; ldw = D; nblocks = 32; ncols = D; dst = (bf16*)(ws + WS_PG1); dld = D; }
            else if ((r -= I_SQ) < I_FG) { src = IN(29); ldw = DFF; nblocks = 88; ncols = DFF; dst = (bf16*)(ws + WS_FGU); dld = D; il = 1; }
            else if ((r -= I_FG) < I_FG) { src = IN(30); ldw = DFF; nblocks = 88; ncols = DFF; dst = (bf16*)(ws + WS_FGU); dld = D; il = 1; rowoff = 128; }
            else if ((r -= I_FG) < I_FD) { src = IN(31); ldw = D; nblocks = 32; ncols = D; dst = (bf16*)(ws + WS_FD); dld = DFF; }
            else if ((r -= I_FD) < I_PP) { src = IN(36); ldw = D; nblocks = 32; ncols = D; dst = (bf16*)(ws + WS_PP0); dld = 256; }
            else { r -= I_PP; src = IN(36) + (size_t)256 * D; ldw = D; nblocks = 32; ncols = D; dst = (bf16*)(ws + WS_PP1); dld = 256; }
            tr_job(src, ldw, nblocks, ncols, dst, dld, il, rowoff, r, scr, lane);
        }
        moe_weights_half(IN(33), IN(34), IN(35), Wmoegu, Wmoed, 0, gw, NGW, scr, lane);
        const size_t gtid = (size_t)vcu * (NWAVES * 64) + tid, nth = (size_t)G * NWAVES * 64;
        for (size_t i = gtid * 8; i < (size_t)(ZLD - PIN) * D; i += nth * 8) *(GAS v4u*)((bf16*)(ws + WS_WIN0) + (size_t)PIN * D + i) = (v4u){0u, 0u, 0u, 0u};
        for (size_t i = gtid * 8; i < (size_t)(ZLD - PIN - 8) * D; i += nth * 8) *(GAS v4u*)((bf16*)(ws + WS_WIN1) + (size_t)(PIN + 8) * D + i) = (v4u){0u, 0u, 0u, 0u};
        cvt_rows(IN(0), (bf16*)(ws + WS_XB0), (size_t)T * D, gtid, nth);
        cvt_rows(IN(1), (bf16*)(ws + WS_PB0), (size_t)T * 256, gtid, nth);
        cvt_rows(IN(1) + (size_t)T * 256, (bf16*)(ws + WS_PB1), (size_t)T * 256, gtid, nth);
        {
            float* PW = (float*)(ws + WS_MISC + MS_PARAMS);
#define CPY(idx, off, n) do { const float* _s = IN(idx); for (int _i = (int)gtid; _i < (n); _i += (int)nth) PW[(off) + _i] = _s[_i]; } while (0)
            CPY(4, P_GKUP, 4096); CPY(5, P_GKB, 256); CPY(6, P_GNW, 128); CPY(7, P_HLB, 512); CPY(8, P_HNW, 128); CPY(9, P_SINK, 8); CPY(10, P_MU, 1664); CPY(11, P_W0, 512);
            CPY(12, P_WUP, 8192); CPY(13, P_A0, 512); CPY(14, P_AUP, 8192); CPY(15, P_GUP, 16384); CPY(16, P_KK, 512); CPY(17, P_KA, 512); CPY(18, P_RK, 512); CPY(19, P_LNXW, 512);
            CPY(20, P_LNXB, 512); CPY(22, P_VMU, 8); CPY(23, P_V0, 256); CPY(24, P_VUP, 2048); CPY(25, P_LN1G, 2048); CPY(26, P_LN1B, 2048); CPY(27, P_LN2G, 2048); CPY(28, P_LN2B, 2048);
            CPY(32, P_ROUTER, 8192);
#undef CPY
            if (bx == 0 && tid < 256) { const float* hl = IN(7); const float a = hl[tid], b = hl[256 + tid]; const float m = fmaxf(a, b); const float ea = __expf(a - m), eb = __expf(b - m); PW[P_LBS + tid] = 0.f; PW[P_LBS + 256 + tid] = eb / (ea + eb); }
        }
        for (int i = (int)gtid; i < MOE_MAXROWS; i += (int)nth) row_tok[i] = 0;
    }
    GRID_BAR();

    }
#if MEGA_ALL
    if (seg < 0) {
        layer_body<0, true, true, true>(args, lds, bar, tid, lane, wave, G, bx, vcu, gw, NGW);
        GRID_BAR();
        layer_body<1, true, true, true>(args, lds, bar, tid, lane, wave, G, bx, vcu, gw, NGW);
    } else
#endif
    if (seg == 0) {
        layer_body<0, true, false, false>(args, lds, bar, tid, lane, wave, G, bx, vcu, gw, NGW);
    } else if (seg == 1) {
        layer_body<0, false, false, true>(args, lds, bar, tid, lane, wave, G, bx, vcu, gw, NGW);
        GRID_BAR();
        layer_body<1, true, false, false>(args, lds, bar, tid, lane, wave, G, bx, vcu, gw, NGW);
    } else {
        layer_body<1, false, false, true>(args, lds, bar, tid, lane, wave, G, bx, vcu, gw, NGW);
    }
}
#undef IN


#ifndef MEGA_ALL
#define MEGA_ALL 0
#endif
__global__ void __launch_bounds__(256) k_prep2(PrepArgs pa) { __shared__ float sm[256]; prep_tokens<1>(pa, (LAS float*)sm, blockIdx.x, gridDim.x, threadIdx.x); }
__global__ void __launch_bounds__(64) k_rec2(RecArgs ra) { __shared__ __attribute__((aligned(16))) float sm[RCH * 5 * 64]; rec_wave(ra, (LAS float*)sm, blockIdx.x, threadIdx.x); }
__global__ void __launch_bounds__(512) k_swa2(const bf16* z, const float* sinks, bf16* mix) { swa_items(z, sinks, mix, blockIdx.x * 8 + (threadIdx.x >> 6), gridDim.x * 8, threadIdx.x & 63); }
extern "C" void kernel_launch(void* const* d_in, const int* in_sizes, int n_in, void* d_out, int out_size, void* d_ws, size_t ws_size, hipStream_t stream) {
    static int grid = 0;
    if (grid == 0) {
        if (n_in != 38 || in_sizes[0] != T * D || out_size != T * D || ws_size < WS_END) { fprintf(stderr, "kernel_launch: unexpected problem (n_in %d, in0 %d, out %d, ws %zu < %zu)\n", n_in, n_in > 0 ? in_sizes[0] : -1, out_size, ws_size, (size_t)WS_END); grid = -1; return; }
        int dev = 0, cus = 0, per_cu = 0;
        if (hipGetDevice(&dev) != hipSuccess || hipDeviceGetAttribute(&cus, hipDeviceAttributeMultiprocessorCount, dev) != hipSuccess) { grid = -1; return; }
        if (hipFuncSetAttribute((const void*)mega_fwd, hipFuncAttributeMaxDynamicSharedMemorySize, LDS_BYTES) != hipSuccess) { fprintf(stderr, "kernel_launch: hipFuncSetAttribute failed\n"); grid = -1; return; }
        if (hipOccupancyMaxActiveBlocksPerMultiprocessor(&per_cu, (const void*)mega_fwd, NWAVES * 64, LDS_BYTES) != hipSuccess || per_cu < 1) { fprintf(stderr, "kernel_launch: occupancy query says %d\n", per_cu); per_cu = 1; }
        (void)hipGetLastError();
        grid = cus;
    }
    if (grid < 0) return;
    if (hipMemsetAsync((char*)d_ws + WS_CTL, 0, CTL_BYTES, stream) != hipSuccess) { fprintf(stderr, "kernel_launch: memset failed\n"); return; }
    Args a{};
    for (int i = 0; i < 38; ++i) a.in[i] = (const float*)d_in[i];
    a.out = (float*)d_out; a.ws = (unsigned char*)d_ws;
#if MEGA_ALL
    int seg = -1; void* kargs[] = {&a, &seg};
    hipError_t e = hipLaunchCooperativeKernel((const void*)mega_fwd, dim3(grid), dim3(NWAVES * 64), kargs, LDS_BYTES, stream);
    if (e != hipSuccess) fprintf(stderr, "kernel_launch: cooperative launch failed: %s (grid %d)\n", hipGetErrorString(e), grid);
#else
    unsigned char* ws = (unsigned char*)d_ws;
    for (int seg = 0; seg < 3; ++seg) {
        int sg = seg; void* kargs[] = {&a, &sg};
        hipError_t e = hipLaunchCooperativeKernel((const void*)mega_fwd, dim3(grid), dim3(NWAVES * 64), kargs, LDS_BYTES, stream);
        if (e != hipSuccess) { fprintf(stderr, "kernel_launch: cooperative launch %d failed: %s (grid %d)\n", seg, hipGetErrorString(e), grid); return; }
        if (seg < 2) {
            const int L = seg; const float* PB = (const float*)(ws + WS_MISC + MS_PARAMS);
            PrepArgs pa{}; pa.z = (const bf16*)(ws + WS_Z); pa.layer = L; pa.P = PB; pa.gla_logf = (float*)(ws + WS_PREP); pa.rwb = (float*)(ws + WS_PREP + 8 * MiB); pa.vfirst = (float*)(ws + WS_VFIRST);
            hipLaunchKernelGGL(k_prep2, dim3(2048), dim3(256), 0, stream, pa);
            RecArgs ra{}; ra.z = pa.z; ra.gla_logf = pa.gla_logf; ra.P = PB; ra.layer = L; ra.rwb = pa.rwb; ra.mix = (bf16*)(ws + WS_MIX);
            hipLaunchKernelGGL(k_rec2, dim3(12), dim3(64), 0, stream, ra);
            hipLaunchKernelGGL(k_swa2, dim3(2048), dim3(512), 0, stream, pa.z, PB + P_SINK + L * 4, ra.mix);
        }
    }
#endif
}
```

```cpp
#include <hip/hip_runtime.h>
#include <cstdio>
#include <cstdint>
namespace pg8 {
#define PG8_LAS __attribute__((address_space(3)))
typedef unsigned short bf16_t;
typedef short bf16x8 __attribute__((ext_vector_type(8)));
typedef float f32x4 __attribute__((ext_vector_type(4)));
typedef unsigned u32x4 __attribute__((ext_vector_type(4)));
constexpr int BM = 256, BK = 64, HALF = 128, HTB = HALF * BK * 2  , STAGE_BYTES = 8 * HTB, NXCD = 8, WGM = 8;

__host__ __device__ __forceinline__ int lds_byte(int r, int c) { const int st = (r >> 4) * 2 + (c >> 5), rr = r & 15, cc = c & 31, ob = rr * 64 + cc * 2; return st * 1024 + (ob ^ (((ob >> 9) & 1) << 5)); }
__host__ __device__ __forceinline__ void stage_rc(int b, int& R, int& C) { const int st = b / 1024, sb = b % 1024, swz = sb ^ (((sb >> 9) & 1) << 5); R = (st >> 1) * 16 + swz / 64; C = (st & 1) * 32 + (swz % 64) / 2; }
__host__ __device__ __forceinline__ int perm32(int rho) { const int n = rho >> 4, i = rho & 15; return 8 * (i >> 2) + 4 * n + (i & 3); }

struct Unit { int pm, pn, on; };
struct Gemm { const bf16_t* A; const bf16_t* Bt; int M, N, K; };

struct StaticOrder {
    int nM, nN, nwg, G, c;
    __host__ __device__ void init(int M, int N, int G_, int c_) { nM = M / BM; nN = N / BM; nwg = nM * nN; G = G_; c = c_; }
    __host__ __device__ bool next(int i, Unit& u) const {
        const long L = (long)i * G + c; if (L >= nwg) return false;
        int wgid = (int)L; { const int q = nwg / NXCD, r = nwg % NXCD, xcd = wgid % NXCD, off = wgid / NXCD; wgid = (xcd < r ? xcd * (q + 1) : r * (q + 1) + (xcd - r) * q) + off; }
        const int nig = WGM * nN, gid = wgid / nig, fm = gid * WGM, gsz = (nM - fm) < WGM ? (nM - fm) : WGM;
        u.pm = fm + ((wgid % nig) % gsz); u.pn = (wgid % nig) / gsz; u.on = u.pn; return true;
    }
    __device__ __forceinline__ void a_ready(const Unit&) const {}
    __device__ __forceinline__ void done(const Unit&) const {}
};

typedef __bf16 bf16v2_t __attribute__((ext_vector_type(2)));
__device__ __forceinline__ unsigned cvt_pk_bf16(float lo, float hi) { bf16v2_t v; v[0] = (__bf16)lo; v[1] = (__bf16)hi; return __builtin_bit_cast(unsigned, v); }
__device__ __forceinline__ float fast_sigmoid(float x) { return __builtin_amdgcn_rcpf(1.f + __expf(-x)); }
struct EpiStoreBf16 {
    static constexpr bool PERM = true, AFTER_DRAIN = false;
    bf16_t* O; int ldc;
    __device__ __forceinline__ void operator()(const f32x4 (&acc)[2][2][4][2], const Unit& u, int wr, int wc, int fr, int fq) const {
        const int row0 = u.pm * BM + wr * 64 + fr, col0 = u.on * BM + wc * 32 + 8 * fq;
#pragma unroll
        for (int ai = 0; ai < 2; ++ai)
#pragma unroll
            for (int m = 0; m < 4; ++m) { bf16_t* rowp = O + (size_t)(row0 + ai * HALF + m * 16) * ldc + col0;
#pragma unroll
                for (int bj = 0; bj < 2; ++bj) { const f32x4 v0 = acc[ai][bj][m][0], v1 = acc[ai][bj][m][1];
                    u32x4 w; w.x = cvt_pk_bf16(v0[0], v0[1]); w.y = cvt_pk_bf16(v0[2], v0[3]); w.z = cvt_pk_bf16(v1[0], v1[1]); w.w = cvt_pk_bf16(v1[2], v1[3]);
                    *(u32x4*)(rowp + bj * HALF) = w; } }
    }
};
struct EpiResF32 {
    static constexpr bool PERM = false, AFTER_DRAIN = false;
    const float* res; float* out; int ldc; float alpha;
    __device__ __forceinline__ void operator()(const f32x4 (&acc)[2][2][4][2], const Unit& u, int wr, int wc, int fr, int fq) const {
        const int row0 = u.pm * BM + wr * 64 + fr, col0 = u.on * BM + wc * 32 + 4 * fq;
#pragma unroll
        for (int ai = 0; ai < 2; ++ai)
#pragma unroll
            for (int m = 0; m < 4; ++m) { const size_t off = (size_t)(row0 + ai * HALF + m * 16) * ldc + col0;
#pragma unroll
                for (int bj = 0; bj < 2; ++bj)
#pragma unroll
                    for (int n = 0; n < 2; ++n) { const f32x4 r = *(const f32x4*)(res + off + bj * HALF + n * 16); *(f32x4*)(out + off + bj * HALF + n * 16) = r * alpha + acc[ai][bj][m][n]; }
                asm volatile("" ::: "memory"); }
    }
};
struct EpiSwiglu {
    static constexpr bool PERM = true, AFTER_DRAIN = false;
    bf16_t* H; int ldc;
    __device__ __forceinline__ void operator()(const f32x4 (&acc)[2][2][4][2], const Unit& u, int wr, int wc, int fr, int fq) const {
        const int row0 = u.pm * BM + wr * 64 + fr, col0 = u.on * HALF + wc * 32 + 8 * fq;
#pragma unroll
        for (int ai = 0; ai < 2; ++ai)
#pragma unroll
            for (int m = 0; m < 4; ++m) {
                f32x4 h[2];
#pragma unroll
                for (int n = 0; n < 2; ++n) { const f32x4 g = acc[ai][0][m][n], up = acc[ai][1][m][n];
#pragma unroll
                    for (int i = 0; i < 4; ++i) h[n][i] = g[i] * fast_sigmoid(g[i]) * up[i]; }
                u32x4 w; w.x = cvt_pk_bf16(h[0][0], h[0][1]); w.y = cvt_pk_bf16(h[0][2], h[0][3]); w.z = cvt_pk_bf16(h[1][0], h[1][1]); w.w = cvt_pk_bf16(h[1][2], h[1][3]);
                *(u32x4*)(H + (size_t)(row0 + ai * HALF + m * 16) * ldc + col0) = w; }
    }
};
struct EpiPle {
    static constexpr bool PERM = false, AFTER_DRAIN = false;
    float* x; const bf16_t* pp; bf16_t* xbo; int ldc;
    __device__ __forceinline__ void operator()(const f32x4 (&acc)[2][2][4][2], const Unit& u, int wr, int wc, int fr, int fq) const {
        typedef unsigned u32x2v __attribute__((ext_vector_type(2)));
        const int row0 = u.pm * BM + wr * 64 + fr, col0 = u.on * BM + wc * 32 + 4 * fq;
#pragma unroll
        for (int ai = 0; ai < 2; ++ai)
#pragma unroll
            for (int m = 0; m < 4; ++m) { const size_t off = (size_t)(row0 + ai * HALF + m * 16) * ldc + col0;
#pragma unroll
                for (int bj = 0; bj < 2; ++bj)
#pragma unroll
                    for (int n = 0; n < 2; ++n) { const size_t o = off + bj * HALF + n * 16;
                        const f32x4 xv = *(const f32x4*)(x + o); const u32x2v pw = *(const u32x2v*)(pp + o); const f32x4 a = acc[ai][bj][m][n];
                        f32x4 pv; pv[0] = __uint_as_float(pw.x << 16); pv[1] = __uint_as_float(pw.x & 0xffff0000u); pv[2] = __uint_as_float(pw.y << 16); pv[3] = __uint_as_float(pw.y & 0xffff0000u);
                        f32x4 xn;
#pragma unroll
                        for (int i = 0; i < 4; ++i) xn[i] = xv[i] + fast_sigmoid(a[i]) * pv[i];
                        *(f32x4*)(x + o) = xn; u32x2v w; w.x = cvt_pk_bf16(xn[0], xn[1]); w.y = cvt_pk_bf16(xn[2], xn[3]); *(u32x2v*)(xbo + o) = w; }
                asm volatile("" ::: "memory"); }
    }
};
struct MoeOrder {
    const int* tile_e; int nrt, ncol, G, c;
    __device__ __forceinline__ bool next(int i, Unit& u) const {
        const int L = i * G + c; if (L >= nrt * ncol) return false;
        const int rt = L / ncol, cn = L - rt * ncol; const int e = tile_e[rt];
        u.pm = rt; u.pn = e * ncol + cn; u.on = cn; return true;
    }
    __device__ __forceinline__ void a_ready(const Unit&) const {}
    __device__ __forceinline__ void done(const Unit&) const {}
};

template <class Epi, class Sched, bool ALIGN_EPI = false, bool SP2 = false>
__device__ __forceinline__ void gemm_phase(PG8_LAS unsigned char* lds, const Gemm g, const Sched& S, const Epi& E) {
    int tid_ = threadIdx.x; asm volatile("" : "+v"(tid_));
    const int tid = tid_, wid = __builtin_amdgcn_readfirstlane(tid >> 6), lane = tid & 63, wr = wid >> 2, wc = wid & 3, fr = lane & 15, fq = lane >> 4;
    const int K = g.K, nt = K / BK;
    unsigned voffA[2], voffB[2];
#pragma unroll
    for (int i = 0; i < 2; ++i) { int R, C; stage_rc(tid * 16 + i * 8192, R, C); const int Rb = Epi::PERM ? ((R & ~31) + perm32(R & 31)) : R;
        voffA[i] = (unsigned)(R * K + C) * 2u; voffB[i] = (unsigned)(Rb * K + C) * 2u; }
    const size_t kstep = (size_t)(BK * 2);
    const size_t hstep = (size_t)HALF * K * 2;
    const size_t tstep = 2 * hstep;
    const unsigned ldsw = (unsigned)wid * 1024u;
    const int aoff = lds_byte(wr * 64 + fr, fq * 8), boff = lds_byte(wc * 32 + fr, fq * 8);
#define PG8_SA(b, h) (((b) * 2 + (h)) * HTB)
#define PG8_SB(b, h) ((4 + (b) * 2 + (h)) * HTB)
#define PG8_STAGE(bufoff, gbase, voff) do { _Pragma("unroll") for (int _i = 0; _i < 2; ++_i) \
        __builtin_amdgcn_global_load_lds((const unsigned*)((const char*)(gbase) + (voff)[_i]), (PG8_LAS unsigned*)(lds + (bufoff) + ldsw + _i * 8192), 16, 0, 0); } while (0)
#define PG8_LDA(dst, b, h) do { _Pragma("unroll") for (int m = 0; m < 4; ++m) _Pragma("unroll") for (int k = 0; k < 2; ++k) dst[m][k] = *(const PG8_LAS bf16x8*)(lds + PG8_SA(b, h) + aoff + m * 2048 + k * 1024); } while (0)
#define PG8_LDB(dst, b, h) do { _Pragma("unroll") for (int n = 0; n < 2; ++n) _Pragma("unroll") for (int k = 0; k < 2; ++k) dst[n][k] = *(const PG8_LAS bf16x8*)(lds + PG8_SB(b, h) + boff + n * 2048 + k * 1024); } while (0)
#define PG8_MMA(ai, bj, At, Bt) do { __builtin_amdgcn_s_setprio(1); _Pragma("unroll") for (int m = 0; m < 4; ++m) _Pragma("unroll") for (int n = 0; n < 2; ++n) _Pragma("unroll") for (int k = 0; k < 2; ++k) \
        acc[ai][bj][m][n] = __builtin_amdgcn_mfma_f32_16x16x32_bf16(Bt[n][k], At[m][k], acc[ai][bj][m][n], 0, 0, 0); __builtin_amdgcn_s_setprio(0); } while (0)
#define PG8_WAIT_V(n) asm volatile("s_waitcnt vmcnt(" #n ")" ::: "memory")
#define PG8_WAIT_L(n) asm volatile("s_waitcnt lgkmcnt(" #n ")" ::: "memory")
#define PG8_BAR __builtin_amdgcn_s_barrier()
#define PG8_SCHED __builtin_amdgcn_sched_barrier(0)
    Unit cur, nxt; int ui = 0;
    if (!S.next(0, cur)) return;
    f32x4 acc[2][2][4][2];
#pragma unroll
    for (int a = 0; a < 2; ++a)
#pragma unroll
        for (int b = 0; b < 2; ++b)
#pragma unroll
            for (int m = 0; m < 4; ++m)
#pragma unroll
                for (int n = 0; n < 2; ++n) acc[a][b][m][n] = (f32x4){0.f, 0.f, 0.f, 0.f};
    bf16x8 At[4][2], B0[2][2], B1[2][2];
    const char* cA = (const char*)g.A + (size_t)cur.pm * tstep; const char* cB = (const char*)g.Bt + (size_t)cur.pn * tstep;
    S.a_ready(cur);
    if constexpr (SP2) {
        PG8_STAGE(PG8_SB(0, 0), cB, voffB); PG8_STAGE(PG8_SB(0, 1), cB + hstep, voffB); PG8_STAGE(PG8_SA(0, 0), cA, voffA); PG8_STAGE(PG8_SA(0, 1), cA + hstep, voffA);
        if (wr == 1) PG8_BAR;
        PG8_WAIT_V(2); PG8_BAR;
        PG8_STAGE(PG8_SB(1, 0), cB + kstep, voffB); PG8_STAGE(PG8_SA(1, 0), cA + kstep, voffA); PG8_STAGE(PG8_SB(1, 1), cB + hstep + kstep, voffB);
        PG8_WAIT_V(6); PG8_BAR;
    } else {
        PG8_STAGE(PG8_SB(0, 0), cB, voffB); PG8_STAGE(PG8_SA(0, 0), cA, voffA); PG8_STAGE(PG8_SB(0, 1), cB + hstep, voffB); PG8_STAGE(PG8_SA(0, 1), cA + hstep, voffA);
        if (wr == 1) PG8_BAR;
        PG8_WAIT_V(4); PG8_BAR;
        PG8_STAGE(PG8_SB(1, 0), cB + kstep, voffB); PG8_STAGE(PG8_SA(1, 0), cA + kstep, voffA); PG8_STAGE(PG8_SB(1, 1), cB + hstep + kstep, voffB);
        PG8_WAIT_V(6); PG8_BAR;
    }
    for (;;) {
        const bool has_next = S.next(ui + 1, nxt);
        const char* nA = has_next ? (const char*)g.A + (size_t)nxt.pm * tstep : cA; const char* nB = has_next ? (const char*)g.Bt + (size_t)nxt.pn * tstep : cB;
        for (int t = 0; t < nt; t += 2) {
            const bool last = (t == nt - 2);
            const char* a1 = cA + (size_t)(t + 1) * kstep;
            const char* a2 = last ? nA : cA + (size_t)(t + 2) * kstep; const char* b2 = last ? nB : cB + (size_t)(t + 2) * kstep;
            const char* a3 = a2 + kstep; const char* b3 = b2 + kstep;
            if (last && has_next) S.a_ready(nxt);
            if constexpr (SP2) {
            PG8_LDB(B0, 0, 0); PG8_LDB(B1, 0, 1); PG8_SCHED; PG8_LDA(At, 0, 0); PG8_STAGE(PG8_SA(1, 1), a1 + hstep, voffA);
            PG8_WAIT_V(8); PG8_WAIT_L(0); PG8_BAR; PG8_MMA(0, 0, At, B0); PG8_MMA(0, 1, At, B1); PG8_BAR; PG8_SCHED;
            PG8_LDA(At, 0, 1); PG8_STAGE(PG8_SB(0, 0), b2, voffB); PG8_STAGE(PG8_SB(0, 1), b2 + hstep, voffB); PG8_STAGE(PG8_SA(0, 0), a2, voffA);
            PG8_WAIT_V(8); PG8_WAIT_L(0); PG8_BAR; PG8_MMA(1, 0, At, B0); PG8_MMA(1, 1, At, B1); PG8_BAR; PG8_SCHED;
            PG8_LDB(B0, 1, 0); PG8_LDB(B1, 1, 1); PG8_SCHED; PG8_LDA(At, 1, 0); PG8_STAGE(PG8_SA(0, 1), a2 + hstep, voffA);
            PG8_WAIT_V(8); PG8_WAIT_L(0); PG8_BAR; PG8_MMA(0, 0, At, B0); PG8_MMA(0, 1, At, B1); PG8_BAR; PG8_SCHED;
            PG8_LDA(At, 1, 1); PG8_STAGE(PG8_SB(1, 0), b3, voffB); PG8_STAGE(PG8_SB(1, 1), b3 + hstep, voffB); PG8_STAGE(PG8_SA(1, 0), a3, voffA);
            PG8_WAIT_V(8); PG8_WAIT_L(0); PG8_BAR; PG8_MMA(1, 0, At, B0); PG8_MMA(1, 1, At, B1); PG8_BAR; PG8_SCHED;
            } else {
            PG8_LDB(B0, 0, 0); PG8_SCHED; PG8_LDA(At, 0, 0); PG8_STAGE(PG8_SA(1, 1), a1 + hstep, voffA);
            PG8_WAIT_L(8); PG8_BAR; PG8_WAIT_L(0); PG8_MMA(0, 0, At, B0); PG8_BAR; PG8_SCHED;
            PG8_LDB(B1, 0, 1); PG8_STAGE(PG8_SB(0, 0), b2, voffB);
            PG8_BAR; PG8_WAIT_L(0); PG8_MMA(0, 1, At, B1); PG8_BAR;
            PG8_LDA(At, 0, 1); PG8_STAGE(PG8_SA(0, 0), a2, voffA);
            PG8_BAR; PG8_WAIT_L(0); PG8_MMA(1, 0, At, B0); PG8_BAR; PG8_SCHED;
            PG8_STAGE(PG8_SB(0, 1), b2 + hstep, voffB);
            PG8_WAIT_V(6); PG8_BAR; PG8_MMA(1, 1, At, B1); PG8_BAR;
            PG8_LDB(B0, 1, 0); PG8_SCHED; PG8_LDA(At, 1, 0); PG8_STAGE(PG8_SA(0, 1), a2 + hstep, voffA);
            PG8_WAIT_L(8); PG8_BAR; PG8_WAIT_L(0); PG8_MMA(0, 0, At, B0); PG8_BAR; PG8_SCHED;
            PG8_LDB(B1, 1, 1); PG8_STAGE(PG8_SB(1, 0), b3, voffB);
            PG8_BAR; PG8_WAIT_L(0); PG8_MMA(0, 1, At, B1); PG8_BAR;
            PG8_LDA(At, 1, 1); PG8_STAGE(PG8_SA(1, 0), a3, voffA);
            PG8_BAR; PG8_WAIT_L(0); PG8_MMA(1, 0, At, B0); PG8_BAR; PG8_SCHED;
            PG8_STAGE(PG8_SB(1, 1), b3 + hstep, voffB);
            PG8_WAIT_V(6); PG8_BAR; PG8_MMA(1, 1, At, B1); PG8_BAR;
            }
        }
        if constexpr (ALIGN_EPI) { if (wr == 0) PG8_BAR; }
        if constexpr (!Epi::AFTER_DRAIN) { E(acc, cur, wr, wc, fr, fq); S.done(cur); }
        if (!has_next) break;
#pragma unroll
        for (int a = 0; a < 2; ++a)
#pragma unroll
            for (int b = 0; b < 2; ++b)
#pragma unroll
                for (int m = 0; m < 4; ++m)
#pragma unroll
                    for (int n = 0; n < 2; ++n) acc[a][b][m][n] = (f32x4){0.f, 0.f, 0.f, 0.f};
        cur = nxt; cA = nA; cB = nB; ++ui;
        if constexpr (ALIGN_EPI) { if (wr == 1) PG8_BAR; }
    }
    PG8_WAIT_V(0);
    if constexpr (!ALIGN_EPI) { if (wr == 0) PG8_BAR; }
    PG8_BAR;
    if constexpr (Epi::AFTER_DRAIN) { E.fused(acc, cur, wr, wc, fr, fq, lds, wid, lane); S.done(cur); }
#undef PG8_SA
#undef PG8_SB
#undef PG8_STAGE
#undef PG8_LDA
#undef PG8_LDB
#undef PG8_MMA
#undef PG8_WAIT_V
#undef PG8_WAIT_L
#undef PG8_BAR
#undef PG8_SCHED
}
}

#ifndef MEGA_ALL
#define MEGA_ALL 0
#endif
#define PG8_SP2 true
#define PG8_ALIGN true
constexpr int NWAVES = 8;
constexpr int T = 16384, D = 1024, GW = 256, PIN = 3152, ZLD = 3328;
constexpr int DFF = 2816, NE = 8, DFE = 3584, DFH = 1792;
constexpr int MOE_MAXTILES = 136, MOE_MAXROWS = MOE_MAXTILES * 256;
constexpr float LN_EPS = 1e-5f, RMS_EPS = 1e-6f, GN_EPS = 64e-5f;
constexpr float ALPHA = 1.4142135623730951f;
constexpr int Z_GQ = 0, Z_GK = 128, Z_GV = 256, Z_GG = 512, Z_GGK = 768, Z_HQ = 784, Z_HF = 1040, Z_HI = 1296, Z_HG = 1552,
              Z_SQ = 1808, Z_SK = 2064, Z_SV = 2192, Z_RZ = 2320, Z_VD = 3152;
constexpr size_t MiB = 1u << 20;
constexpr size_t WS_MOEGU = 0, WS_MOED = 56 * MiB;
constexpr size_t WS_WIN0 = 84 * MiB, WS_WIN1 = WS_WIN0 + (size_t)ZLD * D * 2, WS_WOUT0 = 97 * MiB, WS_WOUT1 = 99 * MiB, WS_FGU = 101 * MiB, WS_FD = 112 * MiB,
                 WS_PG0 = 117 * MiB + 512 * 1024, WS_PG1 = WS_PG0 + 2 * MiB, WS_PP0 = WS_PG1 + 2 * MiB, WS_PP1 = WS_PP0 + 512 * 1024;
constexpr size_t WS_XB0 = 123 * MiB, WS_XB1 = 155 * MiB, WS_VFIRST = 187 * MiB, WS_PB0 = 203 * MiB, WS_PB1 = 211 * MiB, WS_MISC = 219 * MiB, WS_CTL = 222 * MiB, CTL_BYTES = 1 * MiB;
constexpr size_t WS_R = 224 * MiB;
constexpr size_t WS_Z = WS_R, WS_MIX = WS_R + 104 * MiB, WS_PREP = WS_R + 136 * MiB, WS_PRELN = WS_R + 136 * MiB;
constexpr size_t WS_HD = WS_R, WS_HM = WS_R, WS_XG = WS_R + 119 * MiB, WS_Y1 = WS_R + 187 * MiB, WS_PPO = WS_R;
constexpr size_t WS_RWPACK = WS_XB0;
constexpr size_t WS_GLPACK = WS_PREP, WS_HGPACK = WS_PREP + 28 * MiB, WS_RAW = WS_PREP + 68 * MiB, WS_GOUT = WS_PREP + 116 * MiB, WS_VOUT = WS_PREP + 124 * MiB, WS_BC = WS_PREP + 132 * MiB;
constexpr size_t WS_END = 480 * MiB + 27 * MiB;
static_assert(WS_XB1 == WS_XB0 + 32 * MiB && WS_VFIRST == WS_XB1 + 32 * MiB && WS_BC + 1 * MiB <= WS_END, "mixer scratch map");
static_assert(WS_WIN1 + (size_t)ZLD * D * 2 <= WS_WOUT0 && WS_PP1 + 512 * 1024 <= WS_XB0, "weights map");
static_assert(WS_HM + (size_t)MOE_MAXROWS * DFH * 2 <= WS_XG && WS_XG + (size_t)MOE_MAXROWS * D * 2 <= WS_Y1 && WS_Y1 + (size_t)MOE_MAXROWS * D * 2 <= WS_END, "moe map");
static_assert(WS_PREP + 120 * MiB <= WS_END && WS_Z + (size_t)T * ZLD * 2 <= WS_MIX, "mixer map");
constexpr size_t MS_TOPE = 65536, MS_TOPG = MS_TOPE + 131072, MS_TOKROW = MS_TOPG + 131072, MS_ROWTOK = MS_TOKROW + 131072, MS_TILEE = MS_ROWTOK + 196608;
constexpr size_t MS_PARAMS = 1 * MiB;
constexpr int P_GKUP = 0, P_GKB = P_GKUP + 2 * 2048, P_GNW = P_GKB + 2 * 128, P_HLB = P_GNW + 2 * 64, P_HNW = P_HLB + 2 * 256, P_SINK = P_HNW + 2 * 64, P_MU = P_SINK + 8,
              P_W0 = P_MU + 2 * 832, P_WUP = P_W0 + 2 * 256, P_A0 = P_WUP + 2 * 4096, P_AUP = P_A0 + 2 * 256, P_GUP = P_AUP + 2 * 4096, P_KK = P_GUP + 2 * 8192, P_KA = P_KK + 2 * 256,
              P_RK = P_KA + 2 * 256, P_LNXW = P_RK + 2 * 256, P_LNXB = P_LNXW + 2 * 256, P_VMU = P_LNXB + 2 * 256, P_V0 = P_VMU + 8, P_VUP = P_V0 + 256, P_LN1G = P_VUP + 2048,
              P_LN1B = P_LN1G + 2048, P_LN2G = P_LN1B + 2048, P_LN2B = P_LN2G + 2048, P_ROUTER = P_LN2B + 2048, P_LBS = P_ROUTER + 8192, P_END = P_LBS + 512;
static_assert(P_END * 4 <= 1 * MiB, "params block");
constexpr int CW_BAR = 4096, CW_MOE = 16384;
constexpr int LDS_BYTES = 147456, RING_BYTES = 131072, MISC_OFF = RING_BYTES + 320;

#define GAS __attribute__((address_space(1)))
#define LAS __attribute__((address_space(3)))
typedef unsigned short bf16;
typedef unsigned v4u __attribute__((ext_vector_type(4)));
typedef unsigned v2u __attribute__((ext_vector_type(2)));
typedef float f32x4 __attribute__((ext_vector_type(4)));
typedef short bf16x8 __attribute__((ext_vector_type(8)));
typedef GAS unsigned gu32;
#define RLX_AGENT __ATOMIC_RELAXED, __HIP_MEMORY_SCOPE_AGENT
#define LDS_WAIT() asm volatile("s_waitcnt lgkmcnt(0)" ::: "memory")
#define VM_WAIT() asm volatile("s_waitcnt vmcnt(0)" ::: "memory")
__device__ __forceinline__ unsigned f2bf(float f) { unsigned u = __builtin_bit_cast(unsigned, f); return (u + 0x7fffu + ((u >> 16) & 1u)) >> 16; }
__device__ __forceinline__ unsigned pk2(float lo, float hi) { return f2bf(lo) | (f2bf(hi) << 16); }
__device__ __forceinline__ float bf2f(unsigned short b) { return __uint_as_float(((unsigned)b) << 16); }
__device__ __forceinline__ float sigmoidf_(float x) { return 1.f / (1.f + __expf(-x)); }
__device__ __forceinline__ float siluf_(float x) { return x / (1.f + __expf(-x)); }
__device__ __forceinline__ float softplusf_(float x) { return fmaxf(x, 0.f) + log1pf(__expf(-fabsf(x))); }
__device__ __forceinline__ float logsigmoidf_(float x) { return -softplusf_(-x); }
__device__ __forceinline__ float wave_sum(float v) {
#pragma unroll
    for (int o = 1; o < 64; o <<= 1) v += __shfl_xor(v, o);
    return v;
}
__device__ __forceinline__ float wave_max(float v) {
#pragma unroll
    for (int o = 1; o < 64; o <<= 1) v = fmaxf(v, __shfl_xor(v, o));
    return v;
}
#define XB_TMO      128
#define XB_XCNT(j)  (256  + 64 * (j))
#define XB_XSUB(j)  (1280 + 64 * (j))
#define XB_XGEN(j)  (2304 + 64 * (j))
#define XB_TOP      3328
#define XB_TOPGEN   3392
#define XCD_BAR_WORDS 3456
#define XB_SPIN_CAP (1u << 27)

__device__ __forceinline__ unsigned xb_ld(unsigned* p)              { return __hip_atomic_load(p, __ATOMIC_RELAXED, __HIP_MEMORY_SCOPE_AGENT); }
__device__ __forceinline__ unsigned xb_add(unsigned* p, unsigned v) { return __hip_atomic_fetch_add(p, v, __ATOMIC_RELAXED, __HIP_MEMORY_SCOPE_AGENT); }
__device__ __forceinline__ unsigned xb_xcc_id() { return (unsigned)__builtin_amdgcn_s_getreg((3 << 11) | 20) & 0xFu; }
#define XB_SPIN(cond, bar) do { unsigned _sp = 0; while (cond) { __builtin_amdgcn_s_sleep(1); \
    if ((++_sp & 255u) == 0u) { if (xb_ld(&(bar)[XB_TMO])) break; if (_sp > XB_SPIN_CAP) { atomicAdd(&(bar)[XB_TMO], 1u); break; } } } } while (0)

struct XcdBarrier {
    unsigned* bar; unsigned x;
    volatile LAS unsigned* st;
};

__device__ __forceinline__ XcdBarrier xcd_barrier_post(unsigned* bar, volatile LAS unsigned* st) {
    XcdBarrier b; b.bar = bar; b.x = xb_xcc_id(); b.st = st;
    if (threadIdx.x == 0) (void)xb_add(&bar[XB_XCNT(b.x)], 1u);
    return b;
}
__device__ __forceinline__ void xcd_barrier_complete(unsigned* bar, unsigned x, unsigned& nloc, unsigned& nx) {
    const unsigned G = gridDim.x * gridDim.y * gridDim.z;
    unsigned sum, cnt, mine, sp = 0u;
    for (;;) {
        sum = 0u; cnt = 0u; mine = 0u;
#pragma unroll
        for (unsigned j = 0; j < 16; ++j) { const unsigned c = xb_ld(&bar[XB_XCNT(j)]); sum += c; cnt += (c > 0u) ? 1u : 0u; }
        if (sum == G) break;
        __builtin_amdgcn_s_sleep(1);
        if ((++sp & 255u) == 0u) { if (xb_ld(&bar[XB_TMO])) break; if (sp > XB_SPIN_CAP) { atomicAdd(&bar[XB_TMO], 1u); break; } }
    }
    mine = xb_ld(&bar[XB_XCNT(x)]);
    nloc = mine > 0u ? mine : 1u; nx = cnt > 0u ? cnt : 1u;
}

__device__ __forceinline__ void xcd_barrier(const XcdBarrier& b) {
    asm volatile("s_waitcnt vmcnt(0)" ::: "memory");
    __syncthreads();
    if (threadIdx.x == 0) {
        unsigned* bar = b.bar;
        __builtin_amdgcn_s_waitcnt(0);
        unsigned nloc = b.st[0], nx = b.st[1];
        if (nloc == 0u) { xcd_barrier_complete(bar, b.x, nloc, nx); b.st[0] = nloc; b.st[1] = nx; }
        const unsigned old = xb_add(&bar[XB_XSUB(b.x)], 1u);
        const unsigned gen = old / nloc;
        if (old + 1u == (gen + 1u) * nloc) {
            __builtin_amdgcn_fence(__ATOMIC_RELEASE, "agent");
            asm volatile("s_waitcnt vmcnt(0)" ::: "memory");
            const unsigned og = xb_add(&bar[XB_TOP], 1u);
            const unsigned tg = og / nx;
            if (og + 1u == (tg + 1u) * nx) xb_add(&bar[XB_TOPGEN], 1u);
            else XB_SPIN(xb_ld(&bar[XB_TOPGEN]) == tg, bar);
            __builtin_amdgcn_fence(__ATOMIC_ACQUIRE, "agent");
            xb_add(&bar[XB_XGEN(b.x)], 1u);
            asm volatile("s_waitcnt vmcnt(0)" ::: "memory");
        } else {
            XB_SPIN(xb_ld(&bar[XB_XGEN(b.x)]) == gen, bar);
            __builtin_amdgcn_fence(__ATOMIC_ACQUIRE, "agent");
            asm volatile("s_waitcnt vmcnt(0)" ::: "memory");
        }
    }
    __syncthreads();
}

constexpr int RW_PACK = 16384;
constexpr int RW_AHAT = 0, RW_W2 = 2048, RW_S2A = 6144, RW_V = 10240, RW_R = 12288, RW_ARK = 14336, RW_P = 15360;
constexpr int RWL_BYTES = 21504;
typedef __bf16 bf16v2_t __attribute__((ext_vector_type(2)));
__device__ __forceinline__ unsigned cvt_pk(float lo, float hi) { bf16v2_t v; v[0] = (__bf16)lo; v[1] = (__bf16)hi; return __builtin_bit_cast(unsigned, v); }
__device__ __forceinline__ bf16x8 pack8(const f32x4& a, const f32x4& b) { v4u p; p.x = cvt_pk(a[0], a[1]); p.y = cvt_pk(a[2], a[3]); p.z = cvt_pk(b[0], b[1]); p.w = cvt_pk(b[2], b[3]); return __builtin_bit_cast(bf16x8, p); }
__device__ __forceinline__ bf16x8 pack8u(const f32x4& a, v2u vb) { v4u p; p.x = cvt_pk(a[0], a[1]); p.y = cvt_pk(a[2], a[3]); p.z = vb.x; p.w = vb.y; return __builtin_bit_cast(bf16x8, p); }
__device__ __forceinline__ bf16x8 frag2(v2u a, v2u b) { v4u p; p.x = a.x; p.y = a.y; p.z = b.x; p.w = b.y; return __builtin_bit_cast(bf16x8, p); }
#define MFMA16(a, b, c) __builtin_amdgcn_mfma_f32_16x16x32_bf16((a), (b), (c), 0, 0, 0)

struct RwkvPrepArgs { const bf16* z; const float* P; float* vfirst; unsigned char* pack; bf16* gout; bf16* vout; float* bcout; };
template <int L>
__device__ __forceinline__ void rwkv_prep_wave(const RwkvPrepArgs& A, int hd, int c0, int cstride, LAS unsigned char* wl, int lane) {
    const int col = hd * 64 + lane, lo = lane & 15, h = lane >> 4;
    const float* P = A.P;
    float wup[16], aup[16], vup[8];
#pragma unroll
    for (int i = 0; i < 16; ++i) { wup[i] = P[P_WUP + L * 4096 + i * 256 + col]; aup[i] = P[P_AUP + L * 4096 + i * 256 + col]; }
#pragma unroll
    for (int i = 0; i < 8; ++i) vup[i] = (L > 0) ? P[P_VUP + i * 256 + col] : 0.f;
    const float w0 = P[P_W0 + L * 256 + col], a0 = P[P_A0 + L * 256 + col], kkp = P[P_KK + L * 256 + col], kap = P[P_KA + L * 256 + col], rkp = P[P_RK + L * 256 + col];
    const float v0p = (L > 0) ? P[P_V0 + col] : 0.f;
    const float mur = P[P_MU + L * 832 + col], muk = P[P_MU + L * 832 + 256 + col], muv = P[P_MU + L * 832 + 512 + col];
    LAS bf16* atX = (LAS bf16*)(wl + 0); LAS bf16* rtX = (LAS bf16*)(wl + 2048); LAS bf16* btX = (LAS bf16*)(wl + 4096); LAS bf16* ktX = (LAS bf16*)(wl + 6144);
    LAS bf16* atT = (LAS bf16*)(wl + 8192); LAS bf16* pbT = (LAS bf16*)(wl + 10240); LAS bf16* pkT = (LAS bf16*)(wl + 12288); LAS bf16* vT = (LAS bf16*)(wl + 14336);
    LAS float* LR = (LAS float*)(wl + 16384);
    LAS float* Lm = (LAS float*)(wl + 16384); LAS bf16* Tb = (LAS bf16*)(wl + 17472);
    LAS bf16* Gak = (LAS bf16*)(wl + 17984); LAS bf16* Grb = (LAS bf16*)(wl + 18496); LAS bf16* Grk = (LAS bf16*)(wl + 19008);
    const f32x4 z4 = (f32x4){0.f, 0.f, 0.f, 0.f}; const bf16x8 z8 = (bf16x8){0, 0, 0, 0, 0, 0, 0, 0};
    for (int c = c0; c < T / 16; c += cstride) {
        const int t0 = c * 16;
#pragma unroll 1
        for (int q = 0; q < 18; ++q) {
            const int e = lane + 64 * q, t = e / 72, i = e - t * 72;
            const int zc = (i < 64) ? (Z_RZ + 768 + i) : (Z_VD + i - 64);
            float val = 0.f;
            if (i < 64 || L > 0) {
                const float cur = bf2f(A.z[(size_t)(t0 + t) * ZLD + zc]); const float prev = (t0 + t > 0) ? bf2f(A.z[(size_t)(t0 + t - 1) * ZLD + zc]) : 0.f;
                const float m = (i < 64) ? P[P_MU + L * 832 + 768 + i] : P[P_VMU + i - 64];
                val = cur + (prev - cur) * m;
                if (i < 16) val = tanhf(val); else if (i >= 32 && i < 64) val = sigmoidf_(val);
            }
            LR[e] = val;
        }
        LDS_WAIT(); asm volatile("" ::: "memory");
        {
            float sg[16];
#pragma unroll
            for (int t = 0; t < 16; ++t) sg[t] = 0.f;
            const float* gp = P + P_GUP + L * 8192 + col;
#pragma unroll 1
            for (int i = 0; i < 32; ++i) { const float w = gp[i * 256];
#pragma unroll
                for (int t = 0; t < 16; ++t) sg[t] += LR[t * 72 + 32 + i] * w; }
            bf16* go = A.gout + (size_t)t0 * 256 + col;
#pragma unroll
            for (int t = 0; t < 16; ++t) go[t * 256] = (bf16)f2bf(sg[t]);
        }
        float pr = 0.f, pk = 0.f, pv = 0.f;
        if (t0 > 0) { const bf16* zp = A.z + (size_t)(t0 - 1) * ZLD + Z_RZ + col; pr = bf2f(zp[0]); pk = bf2f(zp[256]); pv = bf2f(zp[512]); }
        float cum = 0.f;
        const size_t ob = (size_t)t0 * 256 + col;
#pragma unroll 1
        for (int t = 0; t < 16; ++t) {
            const bf16* zt = A.z + (size_t)(t0 + t) * ZLD + Z_RZ + col;
            const float cr = bf2f(zt[0]), ck = bf2f(zt[256]), cv = bf2f(zt[512]);
            const float rr = cr + (pr - cr) * mur, kk0 = ck + (pk - ck) * muk; float vv = cv + (pv - cv) * muv;
            pr = cr; pk = ck; pv = cv;
            const LAS float* lr = LR + t * 72;
            float sw = w0, sa = a0;
#pragma unroll
            for (int i = 0; i < 16; ++i) { sw += lr[i] * wup[i]; sa += lr[16 + i] * aup[i]; }
            const float wlog = -softplusf_(-sw) - 0.5f;
            const float lw = -__expf(wlog);
            const float av = sigmoidf_(sa);
            if (L == 0) A.vfirst[ob + (size_t)t * 256] = vv;
            else { float sv = v0p;
#pragma unroll
                for (int i = 0; i < 8; ++i) sv += lr[64 + i] * vup[i];
                vv = vv + (A.vfirst[ob + (size_t)t * 256] - vv) * sigmoidf_(sv); }
            float kk = kk0 * kkp; const float ss = wave_sum(kk * kk); kk = kk / fmaxf(sqrtf(ss), 1e-12f);
            const float k2 = kk0 * (1.f + (av - 1.f) * kap);
            const float bc = wave_sum(rr * k2 * rkp);
            const float ea = __expf(cum); cum += lw; const float e = __expf(cum), ei = __expf(-cum);
            const float at = -kk * ea, bt = kk * av * ei, kt = k2 * ei, rt = rr * e;
            atX[t * 64 + lane] = (bf16)f2bf(at); rtX[t * 64 + lane] = (bf16)f2bf(rt); btX[t * 64 + lane] = (bf16)f2bf(bt); ktX[t * 64 + lane] = (bf16)f2bf(kt);
            atT[lane * 16 + t] = (bf16)f2bf(at); vT[lane * 16 + t] = (bf16)f2bf(vv);
            A.vout[ob + (size_t)t * 256] = (bf16)f2bf(vv);
            if (lane == 0) A.bcout[(size_t)(t0 + t) * 4 + hd] = bc;
        }
        const float PC = __expf(cum);
        LDS_WAIT(); asm volatile("" ::: "memory");
#pragma unroll 4
        for (int t = 0; t < 16; ++t) { pbT[lane * 16 + t] = (bf16)f2bf(bf2f(btX[t * 64 + lane]) * PC); pkT[lane * 16 + t] = (bf16)f2bf(bf2f(ktX[t * 64 + lane]) * PC); }
        unsigned char* pk_ = A.pack + ((size_t)c * 4 + hd) * RW_PACK;
        *(float*)(pk_ + RW_P + lane * 4) = PC;
        LDS_WAIT(); asm volatile("" ::: "memory");
        f32x4 Gab, Gak_, Grb_, Grk_;
        {
            bf16x8 af[2], rf[2], bq[2], kq[2];
#pragma unroll
            for (int s = 0; s < 2; ++s) { af[s] = *(const LAS bf16x8*)(atX + lo * 64 + 32 * s + 8 * h); rf[s] = *(const LAS bf16x8*)(rtX + lo * 64 + 32 * s + 8 * h);
                bq[s] = *(const LAS bf16x8*)(btX + lo * 64 + 32 * s + 8 * h); kq[s] = *(const LAS bf16x8*)(ktX + lo * 64 + 32 * s + 8 * h); }
            Gab = MFMA16(af[0], bq[0], z4); Gab = MFMA16(af[1], bq[1], Gab);
            Gak_ = MFMA16(af[0], kq[0], z4); Gak_ = MFMA16(af[1], kq[1], Gak_);
            Grb_ = MFMA16(rf[0], bq[0], z4); Grb_ = MFMA16(rf[1], bq[1], Grb_);
            Grk_ = MFMA16(rf[0], kq[0], z4); Grk_ = MFMA16(rf[1], kq[1], Grk_);
        }
#pragma unroll
        for (int r = 0; r < 4; ++r) { const int t = 4 * h + r; const bool sl = lo < t, sle = lo <= t;
            Lm[t * 17 + lo] = sl ? Gab[r] : 0.f; Gak[t * 16 + lo] = (bf16)f2bf(sl ? Gak_[r] : 0.f); Grb[t * 16 + lo] = (bf16)f2bf(sle ? Grb_[r] : 0.f); Grk[t * 16 + lo] = (bf16)f2bf(sle ? Grk_[r] : 0.f); }
        LDS_WAIT(); asm volatile("" ::: "memory");
        {
            float Tc[16];
#pragma unroll
            for (int t = 0; t < 16; ++t) { float acc = (t == lo) ? 1.f : 0.f;
#pragma unroll
                for (int s = 0; s < t; ++s) acc += Lm[t * 17 + s] * Tc[s];
                Tc[t] = acc; }
#pragma unroll
            for (int t = 0; t < 16; ++t) Tb[t * 16 + lo] = (bf16)f2bf(Tc[t]);
        }
        LDS_WAIT(); asm volatile("" ::: "memory");
        {
            const bf16x8 Tfr = (h < 2) ? *(const LAS bf16x8*)(Tb + lo * 16 + 8 * h) : z8;
            f32x4 Cm[4];
#pragma unroll
            for (int m = 0; m < 4; ++m) { const bf16x8 Afr = (h < 2) ? *(const LAS bf16x8*)(atT + (16 * m + lo) * 16 + 8 * h) : z8;
                Cm[m] = MFMA16(Afr, Tfr, z4); }
            *(bf16x8*)(pk_ + RW_AHAT + 0 * 1024 + lane * 16) = pack8(Cm[0], Cm[1]);
            *(bf16x8*)(pk_ + RW_AHAT + 1 * 1024 + lane * 16) = pack8(Cm[2], Cm[3]);
        }
        {
            const bf16x8 Gfr = (h < 2) ? *(const LAS bf16x8*)(Gak + lo * 16 + 8 * h) : z8;
            const v2u t4 = *(const LAS v2u*)(Tb + lo * 16 + 4 * h); const bf16x8 T2 = frag2(t4, (v2u){0u, 0u});
#pragma unroll
            for (int vb = 0; vb < 4; ++vb) {
                const bf16x8 Vn = (h < 2) ? *(const LAS bf16x8*)(vT + (16 * vb + lo) * 16 + 8 * h) : z8;
                const f32x4 X = MFMA16(Gfr, Vn, z4);
                const f32x4 W2 = MFMA16(T2, pack8(X, z4), z4);
                *(f32x4*)(pk_ + RW_W2 + vb * 1024 + lane * 16) = W2;
                *(v2u*)(pk_ + RW_V + vb * 512 + lane * 8) = *(const LAS v2u*)(vT + (16 * vb + lo) * 16 + 4 * h);
            }
        }
#pragma unroll
        for (int m = 0; m < 4; ++m) *(bf16x8*)(pk_ + RW_S2A + m * 1024 + lane * 16) = frag2(*(const LAS v2u*)(pbT + (16 * m + lo) * 16 + 4 * h), *(const LAS v2u*)(pkT + (16 * m + lo) * 16 + 4 * h));
#pragma unroll
        for (int s = 0; s < 2; ++s) *(bf16x8*)(pk_ + RW_R + s * 1024 + lane * 16) = frag2(*(const LAS v2u*)(rtX + lo * 64 + 32 * s + 4 * h), *(const LAS v2u*)(rtX + lo * 64 + 32 * s + 16 + 4 * h));
        *(bf16x8*)(pk_ + RW_ARK + lane * 16) = frag2(*(const LAS v2u*)(Grb + lo * 16 + 4 * h), *(const LAS v2u*)(Grk + lo * 16 + 4 * h));
        LDS_WAIT(); asm volatile("" ::: "memory");
    }
}

struct RwkvSeqArgs { const unsigned char* pack; float* raw; };
__device__ __forceinline__ void rwkv_seq_wave(const RwkvSeqArgs& A, int hd, int vb, int cb, int ce, f32x4 (&St)[4], int lane) {
    const int lo = lane & 15, h = lane >> 4;
    for (int c = cb; c < ce; ++c) {
        const unsigned char* pk_ = A.pack + ((size_t)c * 4 + hd) * RW_PACK;
        const bf16x8 Ah0 = *(const bf16x8*)(pk_ + RW_AHAT + lane * 16), Ah1 = *(const bf16x8*)(pk_ + RW_AHAT + 1024 + lane * 16);
        const f32x4 W2 = *(const f32x4*)(pk_ + RW_W2 + vb * 1024 + lane * 16);
        bf16x8 S2A[4];
#pragma unroll
        for (int m = 0; m < 4; ++m) S2A[m] = *(const bf16x8*)(pk_ + RW_S2A + m * 1024 + lane * 16);
        const v2u Vf = *(const v2u*)(pk_ + RW_V + vb * 512 + lane * 8);
        const bf16x8 R0 = *(const bf16x8*)(pk_ + RW_R + lane * 16), R1 = *(const bf16x8*)(pk_ + RW_R + 1024 + lane * 16), ARK = *(const bf16x8*)(pk_ + RW_ARK + lane * 16);
        f32x4 Pm[4];
#pragma unroll
        for (int m = 0; m < 4; ++m) Pm[m] = *(const f32x4*)(pk_ + RW_P + (16 * m + 4 * h) * 4);
        const bf16x8 B0 = pack8(St[0], St[1]), B1 = pack8(St[2], St[3]);
        f32x4 U = MFMA16(Ah0, B0, W2); U = MFMA16(Ah1, B1, U);
        const f32x4 zz = (f32x4){0.f, 0.f, 0.f, 0.f}; f32x4 y = MFMA16(R0, B0, zz); y = MFMA16(R1, B1, y);
        const bf16x8 BU = pack8u(U, Vf);
        y = MFMA16(ARK, BU, y);
#pragma unroll
        for (int m = 0; m < 4; ++m) St[m] = MFMA16(S2A[m], BU, St[m] * Pm[m]);
#pragma unroll
        for (int r = 0; r < 4; ++r) A.raw[(size_t)(c * 16 + 4 * h + r) * 768 + 512 + hd * 64 + vb * 16 + lo] = y[r];
    }
}
template <int MT> struct GLP { static constexpr int DK = MT ? 64 : 32, Q = 0, AV = DK / 32 * 1024, KH = AV + 1024, V = KH + DK / 16 * 1024, G = V + 2048, PACK = MT ? 10240 : 7168; };
constexpr int GLL_BYTES = 10240;
struct GlaPrepArgs { const bf16* z; const float* P; unsigned char* pack; };
template <int L, int MT>
__device__ __forceinline__ void gla_prep_wave(const GlaPrepArgs& A, int hd, int c0, int cstride, LAS unsigned char* wl, int lane) {
    constexpr int DK = MT ? 64 : 32;
    const int ch = lane & (DK - 1), lo = lane & 15, h = lane >> 4;
    const float* P = A.P;
    float gku[16]; float gkb = 0.f, lb = 0.f;
    if (MT == 0) {
#pragma unroll
        for (int i = 0; i < 16; ++i) gku[i] = P[P_GKUP + L * 2048 + i * 128 + hd * 32 + ch];
        gkb = P[P_GKB + L * 128 + hd * 32 + ch];
    } else lb = P[P_LBS + L * 256 + hd * 64 + ch];
    LAS bf16* qX = (LAS bf16*)(wl + 0); LAS bf16* ktX = (LAS bf16*)(wl + 2048); LAS bf16* khT = (LAS bf16*)(wl + 4096); LAS bf16* vT = (LAS bf16*)(wl + 6144);
    LAS bf16* Aimg = (LAS bf16*)(wl + 8192); LAS float* LR = (LAS float*)(wl + 8704);
    const f32x4 z4 = (f32x4){0.f, 0.f, 0.f, 0.f};
    for (int c = c0; c < T / 16; c += cstride) {
        const int t0 = c * 16;
        if (MT == 0) {
#pragma unroll
            for (int q = 0; q < 4; ++q) { const int e = lane + 64 * q; LR[e] = bf2f(A.z[(size_t)(t0 + (e >> 4)) * ZLD + Z_GGK + (e & 15)]); }
            LDS_WAIT(); asm volatile("" ::: "memory");
        }
        float cum = 0.f;
#pragma unroll 1
        for (int t = 0; t < 16; ++t) {
            const bf16* zt = A.z + (size_t)(t0 + t) * ZLD;
            float q, k, lf;
            if (MT == 0) {
                q = bf2f(zt[Z_GQ + hd * 32 + ch]) * 0.17677669529663687f; k = bf2f(zt[Z_GK + hd * 32 + ch]);
                float s = gkb;
#pragma unroll
                for (int i = 0; i < 16; ++i) s += LR[t * 16 + i] * gku[i];
                lf = logsigmoidf_(s) * (1.f / 16.f);
            } else {
                const float fq = bf2f(zt[Z_HQ + hd * 64 + ch]), ff = bf2f(zt[Z_HF + hd * 64 + ch]);
                q = siluf_(fq); k = (1.f - lb) * sigmoidf_(-ff);
                lf = (lb == 0.f) ? logsigmoidf_(ff) : __logf(lb + (1.f - lb) * sigmoidf_(ff));
            }
            cum += lf;
            qX[t * 64 + ch] = (bf16)f2bf(q * __expf(cum)); ktX[t * 64 + ch] = (bf16)f2bf(k * __expf(-cum));
            vT[lane * 16 + t] = zt[(MT ? Z_HI : Z_GV) + hd * 64 + lane];
        }
        LDS_WAIT(); asm volatile("" ::: "memory");
        { const float gch = __expf(cum);
#pragma unroll 4
          for (int t = 0; t < 16; ++t) khT[ch * 16 + t] = (bf16)f2bf(bf2f(ktX[t * 64 + ch]) * gch); }
        unsigned char* pk_ = A.pack + ((size_t)c * 4 + hd) * GLP<MT>::PACK;
        if (lane < DK) *(float*)(pk_ + GLP<MT>::G + ch * 4) = __expf(cum);
        LDS_WAIT(); asm volatile("" ::: "memory");
        f32x4 Am = z4;
#pragma unroll
        for (int s = 0; s < DK / 32; ++s) Am = MFMA16(*(const LAS bf16x8*)(qX + lo * 64 + 32 * s + 8 * h), *(const LAS bf16x8*)(ktX + lo * 64 + 32 * s + 8 * h), Am);
#pragma unroll
        for (int r = 0; r < 4; ++r) { const int t = 4 * h + r; Aimg[t * 16 + lo] = (bf16)f2bf(lo <= t ? Am[r] : 0.f); }
        LDS_WAIT(); asm volatile("" ::: "memory");
#pragma unroll
        for (int s = 0; s < DK / 32; ++s) *(bf16x8*)(pk_ + GLP<MT>::Q + s * 1024 + lane * 16) = frag2(*(const LAS v2u*)(qX + lo * 64 + 32 * s + 4 * h), *(const LAS v2u*)(qX + lo * 64 + 32 * s + 16 + 4 * h));
        *(bf16x8*)(pk_ + GLP<MT>::AV + lane * 16) = frag2(*(const LAS v2u*)(Aimg + lo * 16 + 4 * h), (v2u){0u, 0u});
#pragma unroll
        for (int m = 0; m < DK / 16; ++m) *(bf16x8*)(pk_ + GLP<MT>::KH + m * 1024 + lane * 16) = frag2(*(const LAS v2u*)(khT + (16 * m + lo) * 16 + 4 * h), (v2u){0u, 0u});
#pragma unroll
        for (int vb = 0; vb < 4; ++vb) *(v2u*)(pk_ + GLP<MT>::V + vb * 512 + lane * 8) = *(const LAS v2u*)(vT + (16 * vb + lo) * 16 + 4 * h);
        LDS_WAIT(); asm volatile("" ::: "memory");
    }
}
struct GlaSeqArgs { const unsigned char* pack; float* raw; };
template <int MT>
__device__ __forceinline__ void gla_seq_wave(const GlaSeqArgs& A, int hd, int vb, int cb, int ce, f32x4 (&S)[4], int lane) {
    constexpr int DK = MT ? 64 : 32;
    const int lo = lane & 15, h = lane >> 4; const f32x4 z4 = (f32x4){0.f, 0.f, 0.f, 0.f};
    for (int c = cb; c < ce; ++c) {
        const unsigned char* pk_ = A.pack + ((size_t)c * 4 + hd) * GLP<MT>::PACK;
        bf16x8 Q[2], KH[4];
#pragma unroll
        for (int s = 0; s < DK / 32; ++s) Q[s] = *(const bf16x8*)(pk_ + GLP<MT>::Q + s * 1024 + lane * 16);
        const bf16x8 AV = *(const bf16x8*)(pk_ + GLP<MT>::AV + lane * 16);
#pragma unroll
        for (int m = 0; m < DK / 16; ++m) KH[m] = *(const bf16x8*)(pk_ + GLP<MT>::KH + m * 1024 + lane * 16);
        const v2u Vf = *(const v2u*)(pk_ + GLP<MT>::V + vb * 512 + lane * 8);
        f32x4 Gm[4];
#pragma unroll
        for (int m = 0; m < DK / 16; ++m) Gm[m] = *(const f32x4*)(pk_ + GLP<MT>::G + (16 * m + 4 * h) * 4);
        const bf16x8 BV = frag2(Vf, (v2u){0u, 0u});
        f32x4 o = MFMA16(AV, BV, z4);
#pragma unroll
        for (int s = 0; s < DK / 32; ++s) o = MFMA16(Q[s], pack8(S[2 * s], S[2 * s + 1]), o);
#pragma unroll
        for (int m = 0; m < DK / 16; ++m) S[m] = MFMA16(KH[m], BV, S[m] * Gm[m]);
#pragma unroll
        for (int r = 0; r < 4; ++r) A.raw[(size_t)(c * 16 + 4 * h + r) * 768 + MT * 256 + hd * 64 + vb * 16 + lo] = o[r];
    }
}
struct MixPostArgs { const float* raw; const bf16* z; const float* P; const bf16* g; const bf16* v; const float* bc; bf16* mix; int layer; int pad; };
__device__ __forceinline__ void mix_post_items(const MixPostArgs& A, int w0, int NW, int lane) {
    for (int item = w0; item < T * 12; item += NW) {
        const int t = item / 12, mh = item - t * 12, mt = mh >> 2, hd = mh & 3;
        const float o = A.raw[(size_t)t * 768 + mh * 64 + lane];
        float res;
        if (mt < 2) {
            const float ms = wave_sum(o * o) * (1.f / 64.f);
            const float nw = A.P[(mt ? P_HNW : P_GNW) + A.layer * 64 + lane];
            const float gj = bf2f(A.z[(size_t)t * ZLD + (mt ? Z_HG : Z_GG) + hd * 64 + lane]);
            res = o * rsqrtf(ms + RMS_EPS) * nw * siluf_(gj);
        } else {
            const int col = hd * 64 + lane;
            const float mu = wave_sum(o) * (1.f / 64.f); const float d = o - mu; const float var = wave_sum(d * d) * (1.f / 64.f);
            const float yn = d * rsqrtf(var + GN_EPS) * A.P[P_LNXW + A.layer * 256 + col] + A.P[P_LNXB + A.layer * 256 + col];
            res = (yn + A.bc[(size_t)t * 4 + hd] * bf2f(A.v[(size_t)t * 256 + col])) * bf2f(A.g[(size_t)t * 256 + col]);
        }
        A.mix[(size_t)t * D + (mt < 2 ? mt * 256 : 768) + hd * 64 + lane] = (bf16)f2bf(res);
    }
}
constexpr int SW_KLD = 72, SW_VLD = 264, SW_PLD = 40;
constexpr int SW_K = 0, SW_V = 256 * SW_KLD * 2, SW_P = SW_V + 64 * SW_VLD * 2, SW_PW = 32 * SW_PLD * 2, SW_LDS = SW_P + 8 * SW_PW;
typedef float f32x16 __attribute__((ext_vector_type(16)));
#define MFMA32(a, b, c) __builtin_amdgcn_mfma_f32_32x32x16_bf16((a), (b), (c), 0, 0, 0)
__device__ __forceinline__ void swa_items(const bf16* z, const float* sinks, bf16* mix, int i0, int istride, LAS unsigned char* lds, int tid) {
    const int lane = tid & 63, wave = tid >> 6, l31 = lane & 31, hh = lane >> 5;
    LAS bf16* Ks = (LAS bf16*)(lds + SW_K); LAS bf16* Vt = (LAS bf16*)(lds + SW_V); LAS bf16* Pw = (LAS bf16*)(lds + SW_P + wave * SW_PW);
    for (int item = i0; item < (T / 128) * 2; item += istride) {
        const int nb = item >> 1, kvh = item & 1, tk0 = nb * 128 - 128;
        __syncthreads();
#pragma unroll
        for (int q = 0; q < 4; ++q) {
            const int e = tid + 512 * q, key = e >> 3, ch = e & 7; int tok = tk0 + key; tok = tok < 0 ? 0 : tok;
            const v4u kv = *(const GAS v4u*)(z + (size_t)tok * ZLD + Z_SK + kvh * 64 + ch * 8);
            *(LAS v4u*)(Ks + key * SW_KLD + ch * 8) = kv;
            const v4u vv = *(const GAS v4u*)(z + (size_t)tok * ZLD + Z_SV + kvh * 64 + ch * 8);
#pragma unroll
            for (int j = 0; j < 4; ++j) { Vt[(ch * 8 + 2 * j) * SW_VLD + key] = (bf16)(vv[j] & 0xffffu); Vt[(ch * 8 + 2 * j + 1) * SW_VLD + key] = (bf16)(vv[j] >> 16); }
        }
        __syncthreads();
        const int g = wave >> 2, qh = kvh * 2 + g, q0 = (wave & 3) * 32, kt0 = wave & 3;
        const float sink = sinks[qh];
        bf16x8 Qf[4];
        { const bf16* qp = z + (size_t)(nb * 128 + q0 + l31) * ZLD + Z_SQ + qh * 64 + 8 * hh;
#pragma unroll
          for (int s = 0; s < 4; ++s) Qf[s] = *(const GAS bf16x8*)(qp + 16 * s); }
        f32x16 Sc[5];
#pragma unroll
        for (int kt = 0; kt < 5; ++kt) {
            f32x16 acc;
#pragma unroll
            for (int i = 0; i < 16; ++i) acc[i] = 0.f;
            const LAS bf16* kp = Ks + ((kt0 + kt) * 32 + l31) * SW_KLD + 8 * hh;
#pragma unroll
            for (int s = 0; s < 4; ++s) acc = MFMA32(Qf[s], *(const LAS bf16x8*)(kp + 16 * s), acc);
            Sc[kt] = acc;
        }
        int l31o = l31, hho = hh; asm volatile("" : "+v"(l31o), "+v"(hho));
        float mx[16];
#pragma unroll
        for (int r = 0; r < 16; ++r) {
            const int ro = (r & 3) + 8 * (r >> 2) + 4 * hho;
            const bool lowv = l31o > ro;
            float m = -INFINITY;
#pragma unroll
            for (int kt = 0; kt < 5; ++kt) { bool vis = (kt == 0) ? lowv : ((kt == 4) ? !lowv : true); if (nb == 0 && kt0 + kt < 4) vis = false;
                const float sv = vis ? Sc[kt][r] * 0.125f : -INFINITY; Sc[kt][r] = sv; m = fmaxf(m, sv); }
#pragma unroll
            for (int o = 1; o < 32; o <<= 1) m = fmaxf(m, __shfl_xor(m, o));
            mx[r] = fmaxf(m, sink);
        }
        float inv[16];
#pragma unroll
        for (int r = 0; r < 16; ++r) {
            float s = 0.f;
#pragma unroll
            for (int kt = 0; kt < 5; ++kt) { const float p = __expf(Sc[kt][r] - mx[r]); Sc[kt][r] = p; s += p; }
#pragma unroll
            for (int o = 1; o < 32; o <<= 1) s += __shfl_xor(s, o);
            inv[r] = 1.f / (s + __expf(sink - mx[r]));
        }
        f32x16 O0, O1;
#pragma unroll
        for (int i = 0; i < 16; ++i) { O0[i] = 0.f; O1[i] = 0.f; }
#pragma unroll
        for (int kt = 0; kt < 5; ++kt) {
#pragma unroll
            for (int r = 0; r < 16; ++r) Pw[((r & 3) + 8 * (r >> 2) + 4 * hh) * SW_PLD + l31] = (bf16)f2bf(Sc[kt][r] * inv[r]);
            LDS_WAIT(); asm volatile("" ::: "memory");
#pragma unroll
            for (int s = 0; s < 2; ++s) {
                const bf16x8 Pf = *(const LAS bf16x8*)(Pw + l31 * SW_PLD + 16 * s + 8 * hh);
                const int kb = (kt0 + kt) * 32 + 16 * s + 8 * hh;
                O0 = MFMA32(Pf, *(const LAS bf16x8*)(Vt + l31 * SW_VLD + kb), O0);
                O1 = MFMA32(Pf, *(const LAS bf16x8*)(Vt + (32 + l31) * SW_VLD + kb), O1);
            }
            LDS_WAIT(); asm volatile("" ::: "memory");
        }
#pragma unroll
        for (int r = 0; r < 16; ++r) { const int qi = q0 + (r & 3) + 8 * (r >> 2) + 4 * hh; bf16* op = mix + (size_t)(nb * 128 + qi) * D + 512 + qh * 64 + l31;
            op[0] = (bf16)f2bf(O0[r]); op[32] = (bf16)f2bf(O1[r]); }
    }
}
__device__ __forceinline__ void tr_item(const float* src, int ldw, int nvalid, bf16* dst, int dld, LAS float* scr, int lane) {
    const int nl = lane & 31;
#pragma unroll 8
    for (int i = 0; i < 32; ++i) { const int kk = 2 * i + (lane >> 5); scr[kk * 33 + nl] = (nl < nvalid) ? src[(size_t)kk * ldw + nl] : 0.f; }
    LDS_WAIT(); asm volatile("" ::: "memory");
    const int c = lane & 7;
#pragma unroll
    for (int j = 0; j < 4; ++j) { const int n = (lane >> 3) + 8 * j; const LAS float* s = scr + (8 * c) * 33 + n;
        v4u o; o.x = pk2(s[0 * 33], s[1 * 33]); o.y = pk2(s[2 * 33], s[3 * 33]); o.z = pk2(s[4 * 33], s[5 * 33]); o.w = pk2(s[6 * 33], s[7 * 33]);
        if (n < nvalid) *(GAS v4u*)(dst + (size_t)n * dld + 8 * c) = o; }
    LDS_WAIT(); asm volatile("" ::: "memory");
}
__device__ __forceinline__ void tr_job(const float* src, int ldw, int nblocks, int ncols, bf16* dst, int dld, int il, int rowoff, int it, LAS float* scr, int lane) {
    const int kb = it / nblocks, nb = it - kb * nblocks, n0 = nb * 32; const int nv = (ncols - n0) < 32 ? (ncols - n0) : 32;
    const int row = il ? ((n0 >> 7) * 256 + (n0 & 127) + rowoff) : (n0 + rowoff);
    tr_item(src + (size_t)kb * 64 * ldw + n0, ldw, nv, dst + (size_t)row * dld + kb * 64, dld, scr, lane);
}
__device__ __forceinline__ void moe_weights_half(const float* wg, const float* wu, const float* wd, bf16* gu, bf16* dn, int hh, int gw, int NGW, LAS float* scr, int lane) {
    constexpr int PER = 896, PE = 3 * PER;
    for (int it = gw; it < NE * PE; it += NGW) {
        const int e = it / PE, r = it - e * PE, which = r / PER, idx = r - which * PER;
        const float* src; int ldw, nblocks, ncols, dld, il, rowoff; bf16* dst;
        if (which == 0) { src = wg + (size_t)e * D * DFE + hh * DFH; ldw = DFE; nblocks = 56; ncols = DFH; dst = gu + (size_t)e * 3584 * D; dld = D; il = 1; rowoff = 0; }
        else if (which == 1) { src = wu + (size_t)e * D * DFE + hh * DFH; ldw = DFE; nblocks = 56; ncols = DFH; dst = gu + (size_t)e * 3584 * D; dld = D; il = 1; rowoff = 128; }
        else { src = wd + (size_t)e * DFE * D + (size_t)hh * DFH * D; ldw = D; nblocks = 32; ncols = D; dst = dn + (size_t)e * D * DFH; dld = DFH; il = 0; rowoff = 0; }
        tr_job(src, ldw, nblocks, ncols, dst, dld, il, rowoff, idx, scr, lane);
    }
}
__device__ __forceinline__ void cvt_rows(const float* src, bf16* dst, size_t n, size_t gtid, size_t nthreads) {
    for (size_t i = gtid * 8; i < n; i += nthreads * 8) { const f32x4 a = *(const GAS f32x4*)(src + i), b = *(const GAS f32x4*)(src + i + 4);
        v4u o; o.x = pk2(a[0], a[1]); o.y = pk2(a[2], a[3]); o.z = pk2(b[0], b[1]); o.w = pk2(b[2], b[3]); *(GAS v4u*)(dst + i) = o; }
}

struct LnArgs { const float* src; const float* gam; const float* bet; float* xout; bf16* xb; int mode; const bf16* Y1; const bf16* Y2; const int* tok_row; const float* top_g;
                int route; const float* router; int* top_e; float* top_gw; gu32* cnt; };
__device__ __forceinline__ void ln_rows(const LnArgs& a, int gw, int NGW, int lane) {
    for (int row = gw; row < T; row += NGW) {
        f32x4 v[4]; float s = 0.f;
        if (a.mode == 0) {
#pragma unroll
            for (int j = 0; j < 4; ++j) v[j] = *((const GAS f32x4*)(a.src + (size_t)row * D) + lane + 64 * j);
        } else {
            const int r0 = a.tok_row[row * 2], r1 = a.tok_row[row * 2 + 1]; const float g0 = a.top_g[row * 2], g1 = a.top_g[row * 2 + 1];
#pragma unroll
            for (int j = 0; j < 4; ++j) {
                const f32x4 xv = *((const GAS f32x4*)(a.xout + (size_t)row * D) + lane + 64 * j);
                const v2u a0 = *((const GAS v2u*)(a.Y1 + (size_t)r0 * D) + lane + 64 * j), b0 = *((const GAS v2u*)(a.Y2 + (size_t)r0 * D) + lane + 64 * j);
                const v2u a1 = *((const GAS v2u*)(a.Y1 + (size_t)r1 * D) + lane + 64 * j), b1 = *((const GAS v2u*)(a.Y2 + (size_t)r1 * D) + lane + 64 * j);
                f32x4 y0, y1;
                y0[0] = __uint_as_float(a0.x << 16) + __uint_as_float(b0.x << 16); y0[1] = __uint_as_float(a0.x & 0xffff0000u) + __uint_as_float(b0.x & 0xffff0000u);
                y0[2] = __uint_as_float(a0.y << 16) + __uint_as_float(b0.y << 16); y0[3] = __uint_as_float(a0.y & 0xffff0000u) + __uint_as_float(b0.y & 0xffff0000u);
                y1[0] = __uint_as_float(a1.x << 16) + __uint_as_float(b1.x << 16); y1[1] = __uint_as_float(a1.x & 0xffff0000u) + __uint_as_float(b1.x & 0xffff0000u);
                y1[2] = __uint_as_float(a1.y << 16) + __uint_as_float(b1.y << 16); y1[3] = __uint_as_float(a1.y & 0xffff0000u) + __uint_as_float(b1.y & 0xffff0000u);
                v[j] = xv * ALPHA + y0 * g0 + y1 * g1;
            }
        }
#pragma unroll
        for (int j = 0; j < 4; ++j) s += (v[j][0] + v[j][1]) + (v[j][2] + v[j][3]);
        const float mean = wave_sum(s) * (1.f / D); float q = 0.f;
#pragma unroll
        for (int j = 0; j < 4; ++j) { v[j] = v[j] - mean; q += (v[j][0] * v[j][0] + v[j][1] * v[j][1]) + (v[j][2] * v[j][2] + v[j][3] * v[j][3]); }
        const float rstd = rsqrtf(wave_sum(q) * (1.f / D) + LN_EPS);
#pragma unroll
        for (int j = 0; j < 4; ++j) {
            const f32x4 gg = *((const GAS f32x4*)a.gam + lane + 64 * j), bb = *((const GAS f32x4*)a.bet + lane + 64 * j);
            v[j] = v[j] * rstd * gg + bb;
            *((GAS f32x4*)(a.xout + (size_t)row * D) + lane + 64 * j) = v[j];
            v2u w; w.x = pk2(v[j][0], v[j][1]); w.y = pk2(v[j][2], v[j][3]);
            *((GAS v2u*)(a.xb + (size_t)row * D) + lane + 64 * j) = w;
        }
        if (a.route) {
            float lg[8];
#pragma unroll
            for (int e = 0; e < 8; ++e) lg[e] = 0.f;
#pragma unroll
            for (int j = 0; j < 4; ++j)
#pragma unroll
                for (int i = 0; i < 4; ++i) { const int d = 4 * lane + 256 * j + i; const f32x4 r0 = *(const GAS f32x4*)(a.router + d * 8), r1 = *(const GAS f32x4*)(a.router + d * 8 + 4); const float xv = v[j][i];
                    lg[0] += xv * r0[0]; lg[1] += xv * r0[1]; lg[2] += xv * r0[2]; lg[3] += xv * r0[3]; lg[4] += xv * r1[0]; lg[5] += xv * r1[1]; lg[6] += xv * r1[2]; lg[7] += xv * r1[3]; }
#pragma unroll
            for (int e = 0; e < 8; ++e) lg[e] = wave_sum(lg[e]);
            if (lane == 0) {
                int e0 = 0; float l0 = lg[0];
#pragma unroll
                for (int e = 1; e < 8; ++e) if (lg[e] > l0) { l0 = lg[e]; e0 = e; }
                int e1 = 0; float l1 = -INFINITY;
#pragma unroll
                for (int e = 0; e < 8; ++e) if (e != e0 && lg[e] > l1) { l1 = lg[e]; e1 = e; }
                const float g1 = __expf(l1 - l0), den = 1.f + g1;
                a.top_e[row * 2] = e0; a.top_e[row * 2 + 1] = e1; a.top_gw[row * 2] = 1.f / den; a.top_gw[row * 2 + 1] = g1 / den;
                __hip_atomic_fetch_add(a.cnt + e0, 1u, RLX_AGENT); __hip_atomic_fetch_add(a.cnt + e1, 1u, RLX_AGENT);
            }
        }
    }
}

struct Args { const float* in[38]; float* out; unsigned char* ws; };
template <int I> __device__ __forceinline__ const float* in_ptr() {
    unsigned long long v; auto kp = __builtin_amdgcn_kernarg_segment_ptr();
    asm volatile("s_load_dwordx2 %0, %1, %2\n\ts_waitcnt lgkmcnt(0)" : "=s"(v) : "s"(kp), "n"(I * 8));
    return (const float*)v;
}
#define IN(i) in_ptr<(i)>()
#define GRID_BAR() xcd_barrier(bar)
template <int L, bool DO_IN, bool DO_MIX, bool DO_POST>
__device__ __forceinline__ void layer_body(const Args& args, LAS unsigned char* lds, const XcdBarrier& bar, int tid, int lane, int wave, int G, int bx, int vcu, int gw, int NGW) {
    unsigned char* ws = args.ws;
    gu32* ctl = (gu32*)(ws + WS_CTL);
    bf16* Wmoegu = (bf16*)(ws + WS_MOEGU); bf16* Wmoed = (bf16*)(ws + WS_MOED);
    float* vfirst = (float*)(ws + WS_VFIRST);
    bf16* zb = (bf16*)(ws + WS_Z); bf16* mix = (bf16*)(ws + WS_MIX); float* preln = (float*)(ws + WS_PRELN);
    float* gla_logf = (float*)(ws + WS_PREP); float* rwb = (float*)(ws + WS_PREP + 8 * MiB);
    const float* PB = (const float*)(ws + WS_MISC + MS_PARAMS); int* top_e = (int*)(ws + WS_MISC + MS_TOPE); float* top_g = (float*)(ws + WS_MISC + MS_TOPG);
    int* tok_row = (int*)(ws + WS_MISC + MS_TOKROW); int* row_tok = (int*)(ws + WS_MISC + MS_ROWTOK); int* tile_e = (int*)(ws + WS_MISC + MS_TILEE);
    float* xf = args.out;

        bf16* xb_in = (bf16*)(ws + (L == 0 ? WS_XB0 : WS_XB1)); bf16* xb_out = (bf16*)(ws + (L == 0 ? WS_XB1 : WS_XB0));
        const float* xres = (L == 0) ? IN(0) : xf;
        if constexpr (DO_IN) {
        {
            pg8::Gemm g{xb_in, (const bf16*)(ws + (L == 0 ? WS_WIN0 : WS_WIN1)), T, ZLD, D}; pg8::StaticOrder S; S.init(T, ZLD, G, bx);
            pg8::EpiStoreBf16 E{zb, ZLD};
            pg8::gemm_phase<pg8::EpiStoreBf16, pg8::StaticOrder, PG8_ALIGN, PG8_SP2>(lds, g, S, E);
        }
        if constexpr (DO_MIX || DO_POST) GRID_BAR();
        }
        if constexpr (DO_MIX) {
        {
            if (wave < 4) { RwkvPrepArgs rp; rp.z = zb; rp.P = PB; rp.vfirst = vfirst; rp.pack = ws + WS_RWPACK; rp.gout = (bf16*)(ws + WS_GOUT); rp.vout = (bf16*)(ws + WS_VOUT); rp.bcout = (float*)(ws + WS_BC);
                rwkv_prep_wave<L>(rp, wave, vcu, G, lds + wave * RWL_BYTES, lane); }
            else { GlaPrepArgs g0; g0.z = zb; g0.P = PB; g0.pack = ws + WS_GLPACK; GlaPrepArgs g1 = g0; g1.pack = ws + WS_HGPACK;
                gla_prep_wave<L, 0>(g0, wave - 4, vcu, G, lds + 4 * RWL_BYTES + (wave - 4) * GLL_BYTES, lane);
                gla_prep_wave<L, 1>(g1, wave - 4, vcu, G, lds + 4 * RWL_BYTES + (wave - 4) * GLL_BYTES, lane); }
        }
        GRID_BAR();
        {
            if (bx < 12) {
                if (wave < 4) {
                    f32x4 St[4];
#pragma unroll
                    for (int m = 0; m < 4; ++m) St[m] = (f32x4){0.f, 0.f, 0.f, 0.f};
                    float* raw = (float*)(ws + WS_RAW);
                    if (bx < 4) { GlaSeqArgs sa; sa.pack = ws + WS_GLPACK; sa.raw = raw; gla_seq_wave<0>(sa, bx, wave, 0, T / 16, St, lane); }
                    else if (bx < 8) { GlaSeqArgs sa; sa.pack = ws + WS_HGPACK; sa.raw = raw; gla_seq_wave<1>(sa, bx - 4, wave, 0, T / 16, St, lane); }
                    else { RwkvSeqArgs sa; sa.pack = ws + WS_RWPACK; sa.raw = raw; rwkv_seq_wave(sa, bx - 8, wave, 0, T / 16, St, lane); }
                }
            } else swa_items(zb, PB + P_SINK + L * 4, mix, bx - 12, G - 12, lds, tid);
        }
        GRID_BAR();
        {
            MixPostArgs mp; mp.raw = (const float*)(ws + WS_RAW); mp.z = zb; mp.P = PB; mp.g = (const bf16*)(ws + WS_GOUT); mp.v = (const bf16*)(ws + WS_VOUT); mp.bc = (const float*)(ws + WS_BC); mp.mix = mix; mp.layer = L; mp.pad = 0;
            mix_post_items(mp, gw, NGW, lane);
        }
        GRID_BAR();
        }
        if constexpr (DO_POST) {
        {
            pg8::Gemm g{mix, (const bf16*)(ws + (L == 0 ? WS_WOUT0 : WS_WOUT1)), T, D, D}; pg8::StaticOrder S; S.init(T, D, G, bx);
            pg8::EpiResF32 E{xres, preln, D, ALPHA};
            pg8::gemm_phase<pg8::EpiResF32, pg8::StaticOrder, PG8_ALIGN, PG8_SP2>(lds, g, S, E);
        }
        GRID_BAR();
        {
            LnArgs la{}; la.src = preln; la.gam = PB + P_LN1G + L * D; la.bet = PB + P_LN1B + L * D; la.xout = xf; la.xb = xb_in; la.mode = 0;
            la.route = (L == 1); la.router = PB + P_ROUTER; la.top_e = top_e; la.top_gw = top_g; la.cnt = ctl + CW_MOE;
            ln_rows(la, gw, NGW, lane);
        }
        GRID_BAR();
        if constexpr (L == 0) {
            {
                pg8::Gemm g{xb_in, (const bf16*)(ws + WS_FGU), T, 2 * DFF, D}; pg8::StaticOrder S; S.init(T, 2 * DFF, G, bx);
                pg8::EpiSwiglu E{(bf16*)(ws + WS_HD), DFF};
                pg8::gemm_phase<pg8::EpiSwiglu, pg8::StaticOrder, PG8_ALIGN, PG8_SP2>(lds, g, S, E);
            }
            GRID_BAR();
            {
                pg8::Gemm g{(const bf16*)(ws + WS_HD), (const bf16*)(ws + WS_FD), T, D, DFF}; pg8::StaticOrder S; S.init(T, D, G, bx);
                pg8::EpiResF32 E{xf, preln, D, ALPHA};
                pg8::gemm_phase<pg8::EpiResF32, pg8::StaticOrder, PG8_ALIGN, PG8_SP2>(lds, g, S, E);
            }
            GRID_BAR();
            {
                LnArgs la{}; la.src = preln; la.gam = PB + P_LN2G + L * D; la.bet = PB + P_LN2B + L * D; la.xout = xf; la.xb = xb_in; la.mode = 0; la.route = 0;
                ln_rows(la, gw, NGW, lane);
            }
        } else {
            int start[NE + 1]; int nrt;
            {
                int off = 0;
#pragma unroll
                for (int e = 0; e < NE; ++e) { start[e] = off; const int c = (int)__hip_atomic_load(ctl + CW_MOE + e, RLX_AGENT); off += (c + 255) / 256 * 256; }
                start[NE] = off; nrt = off / 256;
                if (bx == 0 && tid < MOE_MAXTILES) { int e = 0;
#pragma unroll
                    for (int q = 1; q < NE; ++q) if (tid * 256 >= start[q]) e = q;
                    tile_e[tid] = e; }
                const int gtid = vcu * (NWAVES * 64) + tid, nth = G * NWAVES * 64;
                for (int i = gtid; i < T * 2; i += nth) { const int e = top_e[i]; const int pos = (int)__hip_atomic_fetch_add(ctl + CW_MOE + 64 + e, 1u, RLX_AGENT);
                    int st = 0;
#pragma unroll
                    for (int q = 0; q < NE; ++q) st = (e == q) ? start[q] : st;
                    const int dest = st + pos; row_tok[dest] = i >> 1; tok_row[i] = dest; }
            }
            GRID_BAR();
            {
                bf16* xg = (bf16*)(ws + WS_XG);
                for (int row = gw; row < nrt * 256; row += NGW) { const int t = row_tok[row];
                    const v4u a = *((const GAS v4u*)(xb_in + (size_t)t * D) + lane), b = *((const GAS v4u*)(xb_in + (size_t)t * D) + 64 + lane);
                    *((GAS v4u*)(xg + (size_t)row * D) + lane) = a; *((GAS v4u*)(xg + (size_t)row * D) + 64 + lane) = b; }
            }
            GRID_BAR();
#pragma unroll
            for (int hh = 0; hh < 2; ++hh) {
                if (hh == 1) { moe_weights_half(IN(33), IN(34), IN(35), Wmoegu, Wmoed, 1, gw, NGW, (LAS float*)(lds + wave * 16384), lane); GRID_BAR(); }
                {
                    pg8::Gemm g{(const bf16*)(ws + WS_XG), Wmoegu, MOE_MAXROWS, 0, D}; pg8::MoeOrder S{tile_e, nrt, 14, G, bx};
                    pg8::EpiSwiglu E{(bf16*)(ws + WS_HM), DFH};
                    pg8::gemm_phase<pg8::EpiSwiglu, pg8::MoeOrder, PG8_ALIGN, PG8_SP2>(lds, g, S, E);
                }
                GRID_BAR();
                {
                    pg8::Gemm g{(const bf16*)(ws + WS_HM), Wmoed, MOE_MAXROWS, 0, DFH}; pg8::MoeOrder S{tile_e, nrt, 4, G, bx};
                    pg8::EpiStoreBf16 E{(bf16*)(ws + (hh == 0 ? WS_Y1 : WS_XG)), D};
                    pg8::gemm_phase<pg8::EpiStoreBf16, pg8::MoeOrder, PG8_ALIGN, PG8_SP2>(lds, g, S, E);
                }
                GRID_BAR();
            }
            {
                LnArgs la{}; la.gam = PB + P_LN2G + L * D; la.bet = PB + P_LN2B + L * D; la.xout = xf; la.xb = xb_in; la.mode = 1; la.Y1 = (const bf16*)(ws + WS_Y1); la.Y2 = (const bf16*)(ws + WS_XG);
                la.tok_row = tok_row; la.top_g = top_g; la.route = 0;
                ln_rows(la, gw, NGW, lane);
            }
        }
        GRID_BAR();
        {
            pg8::Gemm g{(const bf16*)(ws + (L == 0 ? WS_PB0 : WS_PB1)), (const bf16*)(ws + (L == 0 ? WS_PP0 : WS_PP1)), T, D, 256}; pg8::StaticOrder S; S.init(T, D, G, bx);
            pg8::EpiStoreBf16 E{(bf16*)(ws + WS_PPO), D};
            pg8::gemm_phase<pg8::EpiStoreBf16, pg8::StaticOrder, PG8_ALIGN, PG8_SP2>(lds, g, S, E);
        }
        GRID_BAR();
        {
            pg8::Gemm g{xb_in, (const bf16*)(ws + (L == 0 ? WS_PG0 : WS_PG1)), T, D, D}; pg8::StaticOrder S; S.init(T, D, G, bx);
            pg8::EpiPle E{xf, (const bf16*)(ws + WS_PPO), xb_out, D};
            pg8::gemm_phase<pg8::EpiPle, pg8::StaticOrder, PG8_ALIGN, PG8_SP2>(lds, g, S, E);
        }
        }
}
__global__ void __launch_bounds__(NWAVES * 64, 2) mega_fwd(Args args, int seg) {
    extern __shared__ __attribute__((aligned(16))) unsigned char lds_raw[];
    LAS unsigned char* lds = (LAS unsigned char*)lds_raw;
    volatile LAS unsigned* MISC = (volatile LAS unsigned*)(lds + MISC_OFF);
    const int tid = threadIdx.x, lane = tid & 63, wave = __builtin_amdgcn_readfirstlane(tid >> 6);
    const int G = gridDim.x, bx = blockIdx.x; const int vcu = (G % 8 == 0) ? (bx % 8) * (G / 8) + bx / 8 : bx;
    const int gw = vcu * NWAVES + wave, NGW = G * NWAVES;
    unsigned char* ws = args.ws;
    gu32* ctl = (gu32*)(ws + WS_CTL);
    for (int u = tid; u < (LDS_BYTES - RING_BYTES) / 4; u += NWAVES * 64) ((LAS unsigned*)(lds + RING_BYTES))[u] = 0u;
    __syncthreads();
    XcdBarrier bar = xcd_barrier_post((unsigned*)(ctl + CW_BAR) + (seg < 0 ? 0 : seg) * XCD_BAR_WORDS, MISC + 8);
    bf16* Wmoegu = (bf16*)(ws + WS_MOEGU); bf16* Wmoed = (bf16*)(ws + WS_MOED);
    float* vfirst = (float*)(ws + WS_VFIRST);
    bf16* zb = (bf16*)(ws + WS_Z); bf16* mix = (bf16*)(ws + WS_MIX); float* preln = (float*)(ws + WS_PRELN);
    float* gla_logf = (float*)(ws + WS_PREP); float* rwb = (float*)(ws + WS_PREP + 8 * MiB);
    const float* PB = (const float*)(ws + WS_MISC + MS_PARAMS); int* top_e = (int*)(ws + WS_MISC + MS_TOPE); float* top_g = (float*)(ws + WS_MISC + MS_TOPG);
    int* tok_row = (int*)(ws + WS_MISC + MS_TOKROW); int* row_tok = (int*)(ws + WS_MISC + MS_ROWTOK); int* tile_e = (int*)(ws + WS_MISC + MS_TILEE);
    float* xf = args.out;

    {
    {
        LAS float* scr = (LAS float*)(lds + wave * 16384);
        constexpr int I_WIN = 16 * 99, I_VD = 16, I_SQ = 16 * 32, I_FG = 16 * 88, I_FD = 44 * 32, I_PP = 4 * 32;
        constexpr int NIT = 2 * I_WIN + I_VD + 4 * I_SQ + 2 * I_FG + I_FD + 2 * I_PP;
        for (int it = gw; it < NIT; it += NGW) {
            int r = it; const float* src; int ldw, nblocks, ncols, dld, il = 0, rowoff = 0; bf16* dst;
            if (r < I_WIN) { src = IN(2); ldw = PIN; nblocks = 99; ncols = PIN; dst = (bf16*)(ws + WS_WIN0); dld = D; }
            else if ((r -= I_WIN) < I_WIN) { src = IN(2) + (size_t)D * PIN; ldw = PIN; nblocks = 99; ncols = PIN; dst = (bf16*)(ws + WS_WIN1); dld = D; }
            else if ((r -= I_WIN) < I_VD) { src = IN(21); ldw = 8; nblocks = 1; ncols = 8; dst = (bf16*)(ws + WS_WIN1); dld = D; rowoff = PIN; }
            else if ((r -= I_VD) < I_SQ) { src = IN(3); ldw = D; nblocks = 32; ncols = D; dst = (bf16*)(ws + WS_WOUT0); dld = D; }
            else if ((r -= I_SQ) < I_SQ) { src = IN(3) + (size_t)D * D; ldw = D; nblocks = 32; ncols = D; dst = (bf16*)(ws + WS_WOUT1); dld = D; }
            else if ((r -= I_SQ) < I_SQ) { src = IN(37); ldw = D; nblocks = 32; ncols = D; dst = (bf16*)(ws + WS_PG0); dld = D; }
            else if ((r -= I_SQ) < I_SQ) { src = IN(37) + (size_t)D * D; ldw = D; nblocks = 32; ncols = D; dst = (bf16*)(ws + WS_PG1); dld = D; }
            else if ((r -= I_SQ) < I_FG) { src = IN(29); ldw = DFF; nblocks = 88; ncols = DFF; dst = (bf16*)(ws + WS_FGU); dld = D; il = 1; }
            else if ((r -= I_FG) < I_FG) { src = IN(30); ldw = DFF; nblocks = 88; ncols = DFF; dst = (bf16*)(ws + WS_FGU); dld = D; il = 1; rowoff = 128; }
            else if ((r -= I_FG) < I_FD) { src = IN(31); ldw = D; nblocks = 32; ncols = D; dst = (bf16*)(ws + WS_FD); dld = DFF; }
            else if ((r -= I_FD) < I_PP) { src = IN(36); ldw = D; nblocks = 32; ncols = D; dst = (bf16*)(ws + WS_PP0); dld = 256; }
            else { r -= I_PP; src = IN(36) + (size_t)256 * D; ldw = D; nblocks = 32; ncols = D; dst = (bf16*)(ws + WS_PP1); dld = 256; }
            tr_job(src, ldw, nblocks, ncols, dst, dld, il, rowoff, r, scr, lane);
        }
        moe_weights_half(IN(33), IN(34), IN(35), Wmoegu, Wmoed, 0, gw, NGW, scr, lane);
        const size_t gtid = (size_t)vcu * (NWAVES * 64) + tid, nth = (size_t)G * NWAVES * 64;
        for (size_t i = gtid * 8; i < (size_t)(ZLD - PIN) * D; i += nth * 8) *(GAS v4u*)((bf16*)(ws + WS_WIN0) + (size_t)PIN * D + i) = (v4u){0u, 0u, 0u, 0u};
        for (size_t i = gtid * 8; i < (size_t)(ZLD - PIN - 8) * D; i += nth * 8) *(GAS v4u*)((bf16*)(ws + WS_WIN1) + (size_t)(PIN + 8) * D + i) = (v4u){0u, 0u, 0u, 0u};
        cvt_rows(IN(0), (bf16*)(ws + WS_XB0), (size_t)T * D, gtid, nth);
        cvt_rows(IN(1), (bf16*)(ws + WS_PB0), (size_t)T * 256, gtid, nth);
        cvt_rows(IN(1) + (size_t)T * 256, (bf16*)(ws + WS_PB1), (size_t)T * 256, gtid, nth);
        {
            float* PW = (float*)(ws + WS_MISC + MS_PARAMS);
#define CPY(idx, off, n) do { const float* _s = IN(idx); for (int _i = (int)gtid; _i < (n); _i += (int)nth) PW[(off) + _i] = _s[_i]; } while (0)
            CPY(4, P_GKUP, 4096); CPY(5, P_GKB, 256); CPY(6, P_GNW, 128); CPY(7, P_HLB, 512); CPY(8, P_HNW, 128); CPY(9, P_SINK, 8); CPY(10, P_MU, 1664); CPY(11, P_W0, 512);
            CPY(12, P_WUP, 8192); CPY(13, P_A0, 512); CPY(14, P_AUP, 8192); CPY(15, P_GUP, 16384); CPY(16, P_KK, 512); CPY(17, P_KA, 512); CPY(18, P_RK, 512); CPY(19, P_LNXW, 512);
            CPY(20, P_LNXB, 512); CPY(22, P_VMU, 8); CPY(23, P_V0, 256); CPY(24, P_VUP, 2048); CPY(25, P_LN1G, 2048); CPY(26, P_LN1B, 2048); CPY(27, P_LN2G, 2048); CPY(28, P_LN2B, 2048);
            CPY(32, P_ROUTER, 8192);
#undef CPY
            if (bx == 0 && tid < 256) { const float* hl = IN(7); const float a = hl[tid], b = hl[256 + tid]; const float m = fmaxf(a, b); const float ea = __expf(a - m), eb = __expf(b - m); PW[P_LBS + tid] = 0.f; PW[P_LBS + 256 + tid] = eb / (ea + eb); }
        }
        for (int i = (int)gtid; i < MOE_MAXROWS; i += (int)nth) row_tok[i] = 0;
    }
    GRID_BAR();

    }
    layer_body<0, true, true, true>(args, lds, bar, tid, lane, wave, G, bx, vcu, gw, NGW);
    GRID_BAR();
    layer_body<1, true, true, true>(args, lds, bar, tid, lane, wave, G, bx, vcu, gw, NGW);
}
#undef IN


extern "C" void kernel_launch(void* const* d_in, const int* in_sizes, int n_in, void* d_out, int out_size, void* d_ws, size_t ws_size, hipStream_t stream) {
    static int grid = 0;
    if (grid == 0) {
        if (n_in != 38 || in_sizes[0] != T * D || out_size != T * D || ws_size < WS_END) { fprintf(stderr, "kernel_launch: unexpected problem (n_in %d, in0 %d, out %d, ws %zu < %zu)\n", n_in, n_in > 0 ? in_sizes[0] : -1, out_size, ws_size, (size_t)WS_END); grid = -1; return; }
        int dev = 0, cus = 0, per_cu = 0;
        if (hipGetDevice(&dev) != hipSuccess || hipDeviceGetAttribute(&cus, hipDeviceAttributeMultiprocessorCount, dev) != hipSuccess) { grid = -1; return; }
        if (hipFuncSetAttribute((const void*)mega_fwd, hipFuncAttributeMaxDynamicSharedMemorySize, LDS_BYTES) != hipSuccess) { fprintf(stderr, "kernel_launch: hipFuncSetAttribute failed\n"); grid = -1; return; }
        if (hipOccupancyMaxActiveBlocksPerMultiprocessor(&per_cu, (const void*)mega_fwd, NWAVES * 64, LDS_BYTES) != hipSuccess || per_cu < 1) { fprintf(stderr, "kernel_launch: occupancy query says %d\n", per_cu); per_cu = 1; }
        (void)hipGetLastError();
        grid = cus;
    }
    if (grid < 0) return;
    if (hipMemsetAsync((char*)d_ws + WS_CTL, 0, CTL_BYTES, stream) != hipSuccess) { fprintf(stderr, "kernel_launch: memset failed\n"); return; }
    Args a{};
    for (int i = 0; i < 38; ++i) a.in[i] = (const float*)d_in[i];
    a.out = (float*)d_out; a.ws = (unsigned char*)d_ws;
    int seg = -1; void* kargs[] = {&a, &seg};
    hipError_t e = hipLaunchCooperativeKernel((const void*)mega_fwd, dim3(grid), dim3(NWAVES * 64), kargs, LDS_BYTES, stream);
    if (e != hipSuccess) fprintf(stderr, "kernel_launch: cooperative launch failed: %s (grid %d)\n", hipGetErrorString(e), grid);
}
```

```cpp
#define DUP_PHASE -1
#define DUP_N 1
#include <hip/hip_runtime.h>
#include <cstdio>
#include <cstdint>
namespace pg8 {
#define PG8_LAS __attribute__((address_space(3)))
typedef unsigned short bf16_t;
typedef short bf16x8 __attribute__((ext_vector_type(8)));
typedef float f32x4 __attribute__((ext_vector_type(4)));
typedef unsigned u32x4 __attribute__((ext_vector_type(4)));
constexpr int BM = 256, BK = 64, HALF = 128, HTB = HALF * BK * 2  , STAGE_BYTES = 8 * HTB, NXCD = 8, WGM = 8;

__host__ __device__ __forceinline__ int lds_byte(int r, int c) { const int st = (r >> 4) * 2 + (c >> 5), rr = r & 15, cc = c & 31, ob = rr * 64 + cc * 2; return st * 1024 + (ob ^ (((ob >> 9) & 1) << 5)); }
__host__ __device__ __forceinline__ void stage_rc(int b, int& R, int& C) { const int st = b / 1024, sb = b % 1024, swz = sb ^ (((sb >> 9) & 1) << 5); R = (st >> 1) * 16 + swz / 64; C = (st & 1) * 32 + (swz % 64) / 2; }
__host__ __device__ __forceinline__ int perm32(int rho) { const int n = rho >> 4, i = rho & 15; return 8 * (i >> 2) + 4 * n + (i & 3); }

struct Unit { int pm, pn, on; };
struct Gemm { const bf16_t* A; const bf16_t* Bt; int M, N, K; };

struct StaticOrder {
    int nM, nN, nwg, G, c;
    __host__ __device__ void init(int M, int N, int G_, int c_) { nM = M / BM; nN = N / BM; nwg = nM * nN; G = G_; c = c_; }
    __host__ __device__ bool next(int i, Unit& u) const {
        const long L = (long)i * G + c; if (L >= nwg) return false;
        int wgid = (int)L; { const int q = nwg / NXCD, r = nwg % NXCD, xcd = wgid % NXCD, off = wgid / NXCD; wgid = (xcd < r ? xcd * (q + 1) : r * (q + 1) + (xcd - r) * q) + off; }
        const int nig = WGM * nN, gid = wgid / nig, fm = gid * WGM, gsz = (nM - fm) < WGM ? (nM - fm) : WGM;
        u.pm = fm + ((wgid % nig) % gsz); u.pn = (wgid % nig) / gsz; u.on = u.pn; return true;
    }
    __device__ __forceinline__ void a_ready(const Unit&) const {}
    __device__ __forceinline__ void done(const Unit&) const {}
};

typedef __bf16 bf16v2_t __attribute__((ext_vector_type(2)));
__device__ __forceinline__ unsigned cvt_pk_bf16(float lo, float hi) { bf16v2_t v; v[0] = (__bf16)lo; v[1] = (__bf16)hi; return __builtin_bit_cast(unsigned, v); }
__device__ __forceinline__ float fast_sigmoid(float x) { return __builtin_amdgcn_rcpf(1.f + __expf(-x)); }
struct EpiStoreBf16 {
    static constexpr bool PERM = true, AFTER_DRAIN = false;
    bf16_t* O; int ldc;
    __device__ __forceinline__ void operator()(const f32x4 (&acc)[2][2][4][2], const Unit& u, int wr, int wc, int fr, int fq) const {
        const int row0 = u.pm * BM + wr * 64 + fr, col0 = u.on * BM + wc * 32 + 8 * fq;
#pragma unroll
        for (int ai = 0; ai < 2; ++ai)
#pragma unroll
            for (int m = 0; m < 4; ++m) { bf16_t* rowp = O + (size_t)(row0 + ai * HALF + m * 16) * ldc + col0;
#pragma unroll
                for (int bj = 0; bj < 2; ++bj) { const f32x4 v0 = acc[ai][bj][m][0], v1 = acc[ai][bj][m][1];
                    u32x4 w; w.x = cvt_pk_bf16(v0[0], v0[1]); w.y = cvt_pk_bf16(v0[2], v0[3]); w.z = cvt_pk_bf16(v1[0], v1[1]); w.w = cvt_pk_bf16(v1[2], v1[3]);
                    *(u32x4*)(rowp + bj * HALF) = w; } }
    }
};
struct EpiResF32 {
    static constexpr bool PERM = false, AFTER_DRAIN = false;
    const float* res; float* out; int ldc; float alpha;
    __device__ __forceinline__ void operator()(const f32x4 (&acc)[2][2][4][2], const Unit& u, int wr, int wc, int fr, int fq) const {
        const int row0 = u.pm * BM + wr * 64 + fr, col0 = u.on * BM + wc * 32 + 4 * fq;
#pragma unroll
        for (int ai = 0; ai < 2; ++ai)
#pragma unroll
            for (int m = 0; m < 4; ++m) { const size_t off = (size_t)(row0 + ai * HALF + m * 16) * ldc + col0;
#pragma unroll
                for (int bj = 0; bj < 2; ++bj)
#pragma unroll
                    for (int n = 0; n < 2; ++n) { const f32x4 r = *(const f32x4*)(res + off + bj * HALF + n * 16); *(f32x4*)(out + off + bj * HALF + n * 16) = r * alpha + acc[ai][bj][m][n]; }
                asm volatile("" ::: "memory"); }
    }
};
struct EpiSwiglu {
    static constexpr bool PERM = true, AFTER_DRAIN = false;
    bf16_t* H; int ldc;
    __device__ __forceinline__ void operator()(const f32x4 (&acc)[2][2][4][2], const Unit& u, int wr, int wc, int fr, int fq) const {
        const int row0 = u.pm * BM + wr * 64 + fr, col0 = u.on * HALF + wc * 32 + 8 * fq;
#pragma unroll
        for (int ai = 0; ai < 2; ++ai)
#pragma unroll
            for (int m = 0; m < 4; ++m) {
                f32x4 h[2];
#pragma unroll
                for (int n = 0; n < 2; ++n) { const f32x4 g = acc[ai][0][m][n], up = acc[ai][1][m][n];
#pragma unroll
                    for (int i = 0; i < 4; ++i) h[n][i] = g[i] * fast_sigmoid(g[i]) * up[i]; }
                u32x4 w; w.x = cvt_pk_bf16(h[0][0], h[0][1]); w.y = cvt_pk_bf16(h[0][2], h[0][3]); w.z = cvt_pk_bf16(h[1][0], h[1][1]); w.w = cvt_pk_bf16(h[1][2], h[1][3]);
                *(u32x4*)(H + (size_t)(row0 + ai * HALF + m * 16) * ldc + col0) = w; }
    }
};
struct EpiPle {
    static constexpr bool PERM = false, AFTER_DRAIN = false;
    float* x; const bf16_t* pp; bf16_t* xbo; int ldc; float oscale;
    __device__ __forceinline__ void operator()(const f32x4 (&acc)[2][2][4][2], const Unit& u, int wr, int wc, int fr, int fq) const {
        typedef unsigned u32x2v __attribute__((ext_vector_type(2)));
        const int row0 = u.pm * BM + wr * 64 + fr, col0 = u.on * BM + wc * 32 + 4 * fq;
#pragma unroll
        for (int ai = 0; ai < 2; ++ai)
#pragma unroll
            for (int m = 0; m < 4; ++m) { const size_t off = (size_t)(row0 + ai * HALF + m * 16) * ldc + col0;
#pragma unroll
                for (int bj = 0; bj < 2; ++bj)
#pragma unroll
                    for (int n = 0; n < 2; ++n) { const size_t o = off + bj * HALF + n * 16;
                        const f32x4 xv = *(const f32x4*)(x + o); const u32x2v pw = *(const u32x2v*)(pp + o); const f32x4 a = acc[ai][bj][m][n];
                        f32x4 pv; pv[0] = __uint_as_float(pw.x << 16); pv[1] = __uint_as_float(pw.x & 0xffff0000u); pv[2] = __uint_as_float(pw.y << 16); pv[3] = __uint_as_float(pw.y & 0xffff0000u);
                        f32x4 xn;
#pragma unroll
                        for (int i = 0; i < 4; ++i) xn[i] = (xv[i] + fast_sigmoid(a[i]) * pv[i]) * oscale;
                        *(f32x4*)(x + o) = xn; u32x2v w; w.x = cvt_pk_bf16(xn[0], xn[1]); w.y = cvt_pk_bf16(xn[2], xn[3]); *(u32x2v*)(xbo + o) = w; }
                asm volatile("" ::: "memory"); }
    }
};
struct MoeOrder {
    const int* tile_e; int nrt, ncol, G, c;
    __device__ __forceinline__ bool next(int i, Unit& u) const {
        const int L = i * G + c; if (L >= nrt * ncol) return false;
        const int rt = L / ncol, cn = L - rt * ncol; const int e = tile_e[rt];
        u.pm = rt; u.pn = e * ncol + cn; u.on = cn; return true;
    }
    __device__ __forceinline__ void a_ready(const Unit&) const {}
    __device__ __forceinline__ void done(const Unit&) const {}
};

template <class Epi, class Sched, bool ALIGN_EPI = false, bool SP2 = false>
__device__ __forceinline__ void gemm_phase(PG8_LAS unsigned char* lds, const Gemm g, const Sched& S, const Epi& E) {
    int tid_ = threadIdx.x; asm volatile("" : "+v"(tid_));
    const int tid = tid_, wid = __builtin_amdgcn_readfirstlane(tid >> 6), lane = tid & 63, wr = wid >> 2, wc = wid & 3, fr = lane & 15, fq = lane >> 4;
    const int K = g.K, nt = K / BK;
    unsigned voffA[2], voffB[2];
#pragma unroll
    for (int i = 0; i < 2; ++i) { int R, C; stage_rc(tid * 16 + i * 8192, R, C); const int Rb = Epi::PERM ? ((R & ~31) + perm32(R & 31)) : R;
        voffA[i] = (unsigned)(R * K + C) * 2u; voffB[i] = (unsigned)(Rb * K + C) * 2u; }
    const size_t kstep = (size_t)(BK * 2);
    const size_t hstep = (size_t)HALF * K * 2;
    const size_t tstep = 2 * hstep;
    const unsigned ldsw = (unsigned)wid * 1024u;
    const int aoff = lds_byte(wr * 64 + fr, fq * 8), boff = lds_byte(wc * 32 + fr, fq * 8);
#define PG8_SA(b, h) (((b) * 2 + (h)) * HTB)
#define PG8_SB(b, h) ((4 + (b) * 2 + (h)) * HTB)
#define PG8_STAGE(bufoff, gbase, voff) do { _Pragma("unroll") for (int _i = 0; _i < 2; ++_i) \
        __builtin_amdgcn_global_load_lds((const unsigned*)((const char*)(gbase) + (voff)[_i]), (PG8_LAS unsigned*)(lds + (bufoff) + ldsw + _i * 8192), 16, 0, 0); } while (0)
#define PG8_LDA(dst, b, h) do { _Pragma("unroll") for (int m = 0; m < 4; ++m) _Pragma("unroll") for (int k = 0; k < 2; ++k) dst[m][k] = *(const PG8_LAS bf16x8*)(lds + PG8_SA(b, h) + aoff + m * 2048 + k * 1024); } while (0)
#define PG8_LDB(dst, b, h) do { _Pragma("unroll") for (int n = 0; n < 2; ++n) _Pragma("unroll") for (int k = 0; k < 2; ++k) dst[n][k] = *(const PG8_LAS bf16x8*)(lds + PG8_SB(b, h) + boff + n * 2048 + k * 1024); } while (0)
#define PG8_MMA(ai, bj, At, Bt) do { __builtin_amdgcn_s_setprio(1); _Pragma("unroll") for (int m = 0; m < 4; ++m) _Pragma("unroll") for (int n = 0; n < 2; ++n) _Pragma("unroll") for (int k = 0; k < 2; ++k) \
        acc[ai][bj][m][n] = __builtin_amdgcn_mfma_f32_16x16x32_bf16(Bt[n][k], At[m][k], acc[ai][bj][m][n], 0, 0, 0); __builtin_amdgcn_s_setprio(0); } while (0)
#define PG8_WAIT_V(n) asm volatile("s_waitcnt vmcnt(" #n ")" ::: "memory")
#define PG8_WAIT_L(n) asm volatile("s_waitcnt lgkmcnt(" #n ")" ::: "memory")
#define PG8_BAR __builtin_amdgcn_s_barrier()
#define PG8_SCHED __builtin_amdgcn_sched_barrier(0)
    Unit cur, nxt; int ui = 0;
    if (!S.next(0, cur)) return;
    f32x4 acc[2][2][4][2];
#pragma unroll
    for (int a = 0; a < 2; ++a)
#pragma unroll
        for (int b = 0; b < 2; ++b)
#pragma unroll
            for (int m = 0; m < 4; ++m)
#pragma unroll
                for (int n = 0; n < 2; ++n) acc[a][b][m][n] = (f32x4){0.f, 0.f, 0.f, 0.f};
    bf16x8 At[4][2], B0[2][2], B1[2][2];
    const char* cA = (const char*)g.A + (size_t)cur.pm * tstep; const char* cB = (const char*)g.Bt + (size_t)cur.pn * tstep;
    S.a_ready(cur);
    if constexpr (SP2) {
        PG8_STAGE(PG8_SB(0, 0), cB, voffB); PG8_STAGE(PG8_SB(0, 1), cB + hstep, voffB); PG8_STAGE(PG8_SA(0, 0), cA, voffA); PG8_STAGE(PG8_SA(0, 1), cA + hstep, voffA);
        if (wr == 1) PG8_BAR;
        PG8_WAIT_V(2); PG8_BAR;
        PG8_STAGE(PG8_SB(1, 0), cB + kstep, voffB); PG8_STAGE(PG8_SA(1, 0), cA + kstep, voffA); PG8_STAGE(PG8_SB(1, 1), cB + hstep + kstep, voffB);
        PG8_WAIT_V(6); PG8_BAR;
    } else {
        PG8_STAGE(PG8_SB(0, 0), cB, voffB); PG8_STAGE(PG8_SA(0, 0), cA, voffA); PG8_STAGE(PG8_SB(0, 1), cB + hstep, voffB); PG8_STAGE(PG8_SA(0, 1), cA + hstep, voffA);
        if (wr == 1) PG8_BAR;
        PG8_WAIT_V(4); PG8_BAR;
        PG8_STAGE(PG8_SB(1, 0), cB + kstep, voffB); PG8_STAGE(PG8_SA(1, 0), cA + kstep, voffA); PG8_STAGE(PG8_SB(1, 1), cB + hstep + kstep, voffB);
        PG8_WAIT_V(6); PG8_BAR;
    }
    for (;;) {
        const bool has_next = S.next(ui + 1, nxt);
        const char* nA = has_next ? (const char*)g.A + (size_t)nxt.pm * tstep : cA; const char* nB = has_next ? (const char*)g.Bt + (size_t)nxt.pn * tstep : cB;
        for (int t = 0; t < nt; t += 2) {
            const bool last = (t == nt - 2);
            const char* a1 = cA + (size_t)(t + 1) * kstep;
            const char* a2 = last ? nA : cA + (size_t)(t + 2) * kstep; const char* b2 = last ? nB : cB + (size_t)(t + 2) * kstep;
            const char* a3 = a2 + kstep; const char* b3 = b2 + kstep;
            if (last && has_next) S.a_ready(nxt);
            if constexpr (SP2) {
            PG8_LDB(B0, 0, 0); PG8_LDB(B1, 0, 1); PG8_SCHED; PG8_LDA(At, 0, 0); PG8_STAGE(PG8_SA(1, 1), a1 + hstep, voffA);
            PG8_WAIT_V(8); PG8_WAIT_L(0); PG8_BAR; PG8_MMA(0, 0, At, B0); PG8_MMA(0, 1, At, B1); PG8_BAR; PG8_SCHED;
            PG8_LDA(At, 0, 1); PG8_STAGE(PG8_SB(0, 0), b2, voffB); PG8_STAGE(PG8_SB(0, 1), b2 + hstep, voffB); PG8_STAGE(PG8_SA(0, 0), a2, voffA);
            PG8_WAIT_V(8); PG8_WAIT_L(0); PG8_BAR; PG8_MMA(1, 0, At, B0); PG8_MMA(1, 1, At, B1); PG8_BAR; PG8_SCHED;
            PG8_LDB(B0, 1, 0); PG8_LDB(B1, 1, 1); PG8_SCHED; PG8_LDA(At, 1, 0); PG8_STAGE(PG8_SA(0, 1), a2 + hstep, voffA);
            PG8_WAIT_V(8); PG8_WAIT_L(0); PG8_BAR; PG8_MMA(0, 0, At, B0); PG8_MMA(0, 1, At, B1); PG8_BAR; PG8_SCHED;
            PG8_LDA(At, 1, 1); PG8_STAGE(PG8_SB(1, 0), b3, voffB); PG8_STAGE(PG8_SB(1, 1), b3 + hstep, voffB); PG8_STAGE(PG8_SA(1, 0), a3, voffA);
            PG8_WAIT_V(8); PG8_WAIT_L(0); PG8_BAR; PG8_MMA(1, 0, At, B0); PG8_MMA(1, 1, At, B1); PG8_BAR; PG8_SCHED;
            } else {
            PG8_LDB(B0, 0, 0); PG8_SCHED; PG8_LDA(At, 0, 0); PG8_STAGE(PG8_SA(1, 1), a1 + hstep, voffA);
            PG8_WAIT_L(8); PG8_BAR; PG8_WAIT_L(0); PG8_MMA(0, 0, At, B0); PG8_BAR; PG8_SCHED;
            PG8_LDB(B1, 0, 1); PG8_STAGE(PG8_SB(0, 0), b2, voffB);
            PG8_BAR; PG8_WAIT_L(0); PG8_MMA(0, 1, At, B1); PG8_BAR;
            PG8_LDA(At, 0, 1); PG8_STAGE(PG8_SA(0, 0), a2, voffA);
            PG8_BAR; PG8_WAIT_L(0); PG8_MMA(1, 0, At, B0); PG8_BAR; PG8_SCHED;
            PG8_STAGE(PG8_SB(0, 1), b2 + hstep, voffB);
            PG8_WAIT_V(6); PG8_BAR; PG8_MMA(1, 1, At, B1); PG8_BAR;
            PG8_LDB(B0, 1, 0); PG8_SCHED; PG8_LDA(At, 1, 0); PG8_STAGE(PG8_SA(0, 1), a2 + hstep, voffA);
            PG8_WAIT_L(8); PG8_BAR; PG8_WAIT_L(0); PG8_MMA(0, 0, At, B0); PG8_BAR; PG8_SCHED;
            PG8_LDB(B1, 1, 1); PG8_STAGE(PG8_SB(1, 0), b3, voffB);
            PG8_BAR; PG8_WAIT_L(0); PG8_MMA(0, 1, At, B1); PG8_BAR;
            PG8_LDA(At, 1, 1); PG8_STAGE(PG8_SA(1, 0), a3, voffA);
            PG8_BAR; PG8_WAIT_L(0); PG8_MMA(1, 0, At, B0); PG8_BAR; PG8_SCHED;
            PG8_STAGE(PG8_SB(1, 1), b3 + hstep, voffB);
            PG8_WAIT_V(6); PG8_BAR; PG8_MMA(1, 1, At, B1); PG8_BAR;
            }
        }
        if constexpr (ALIGN_EPI) { if (wr == 0) PG8_BAR; }
        if constexpr (!Epi::AFTER_DRAIN) { E(acc, cur, wr, wc, fr, fq); S.done(cur); }
        if (!has_next) break;
#pragma unroll
        for (int a = 0; a < 2; ++a)
#pragma unroll
            for (int b = 0; b < 2; ++b)
#pragma unroll
                for (int m = 0; m < 4; ++m)
#pragma unroll
                    for (int n = 0; n < 2; ++n) acc[a][b][m][n] = (f32x4){0.f, 0.f, 0.f, 0.f};
        cur = nxt; cA = nA; cB = nB; ++ui;
        if constexpr (ALIGN_EPI) { if (wr == 1) PG8_BAR; }
    }
    PG8_WAIT_V(0);
    if constexpr (!ALIGN_EPI) { if (wr == 0) PG8_BAR; }
    PG8_BAR;
    if constexpr (Epi::AFTER_DRAIN) { E.fused(acc, cur, wr, wc, fr, fq, lds, wid, lane); S.done(cur); }
#undef PG8_SA
#undef PG8_SB
#undef PG8_STAGE
#undef PG8_LDA
#undef PG8_LDB
#undef PG8_MMA
#undef PG8_WAIT_V
#undef PG8_WAIT_L
#undef PG8_BAR
#undef PG8_SCHED
}
}

#ifndef MEGA_ALL
#define MEGA_ALL 0
#endif
#define PG8_SP2 true
#define PG8_ALIGN true
constexpr int NWAVES = 8;
constexpr int T = 16384, D = 1024, GW = 256, PIN = 3152, ZLD = 3328;
constexpr int DFF = 2816, NE = 8, DFE = 3584, DFH = 1792;
constexpr int MOE_MAXTILES = 136, MOE_MAXROWS = MOE_MAXTILES * 256;
constexpr float LN_EPS = 1e-5f, RMS_EPS = 1e-6f, GN_EPS = 64e-5f;
constexpr float ALPHA = 1.4142135623730951f;
constexpr int Z_GQ = 0, Z_GK = 128, Z_GV = 256, Z_GG = 512, Z_GGK = 768, Z_HQ = 784, Z_HF = 1040, Z_HI = 1296, Z_HG = 1552,
              Z_SQ = 1808, Z_SK = 2064, Z_SV = 2192, Z_RZ = 2320, Z_VD = 3152;
constexpr size_t MiB = 1u << 20;
constexpr size_t WS_MOEGU = 0, WS_MOED = 56 * MiB;
constexpr size_t WS_WIN0 = 84 * MiB, WS_WIN1 = WS_WIN0 + (size_t)ZLD * D * 2, WS_WOUT0 = 97 * MiB, WS_WOUT1 = 99 * MiB, WS_FGU = 101 * MiB, WS_FD = 112 * MiB,
                 WS_PG0 = 117 * MiB + 512 * 1024, WS_PG1 = WS_PG0 + 2 * MiB, WS_PP0 = WS_PG1 + 2 * MiB, WS_PP1 = WS_PP0 + 512 * 1024;
constexpr size_t WS_XB0 = 123 * MiB, WS_XB1 = 155 * MiB, WS_VFIRST = 187 * MiB, WS_PB0 = 203 * MiB, WS_PB1 = 211 * MiB, WS_MISC = 219 * MiB, WS_CTL = 222 * MiB, CTL_BYTES = 1 * MiB;
constexpr size_t WS_R = 224 * MiB;
constexpr size_t WS_Z = WS_R, WS_MIX = WS_R + 104 * MiB, WS_PREP = WS_R + 136 * MiB, WS_PRELN = WS_R + 136 * MiB;
constexpr size_t WS_HD = WS_R, WS_HM = WS_R, WS_XG = WS_R + 119 * MiB, WS_Y1 = WS_R + 187 * MiB, WS_PPO = WS_R;
constexpr size_t WS_RWPACK = WS_XB0;
constexpr size_t WS_GLPACK = WS_PREP, WS_HGPACK = WS_PREP + 28 * MiB, WS_RAW = WS_PREP + 68 * MiB, WS_GOUT = WS_PREP + 116 * MiB, WS_VOUT = WS_PREP + 124 * MiB, WS_BC = WS_PREP + 132 * MiB;
constexpr size_t WS_SST = WS_PREP + 133 * MiB, WS_MT = WS_PREP + 145 * MiB;
constexpr size_t MS_DSC = 1536 * 1024;
constexpr size_t WS_END = 480 * MiB + 27 * MiB;
static_assert(WS_MT + 2 * MiB <= WS_END && MS_DSC + 131072 <= 3 * MiB, "scan map");
static_assert(WS_XB1 == WS_XB0 + 32 * MiB && WS_VFIRST == WS_XB1 + 32 * MiB && WS_BC + 1 * MiB <= WS_END, "mixer scratch map");
static_assert(WS_WIN1 + (size_t)ZLD * D * 2 <= WS_WOUT0 && WS_PP1 + 512 * 1024 <= WS_XB0, "weights map");
static_assert(WS_HM + (size_t)MOE_MAXROWS * DFH * 2 <= WS_XG && WS_XG + (size_t)MOE_MAXROWS * D * 2 <= WS_Y1 && WS_Y1 + (size_t)MOE_MAXROWS * D * 2 <= WS_END, "moe map");
static_assert(WS_PREP + 120 * MiB <= WS_END && WS_Z + (size_t)T * ZLD * 2 <= WS_MIX, "mixer map");
constexpr size_t MS_TOPE = 65536, MS_TOPG = MS_TOPE + 131072, MS_TOKROW = MS_TOPG + 131072, MS_ROWTOK = MS_TOKROW + 131072, MS_TILEE = MS_ROWTOK + 196608;
constexpr size_t MS_PARAMS = 1 * MiB;
constexpr int P_GKUP = 0, P_GKB = P_GKUP + 2 * 2048, P_GNW = P_GKB + 2 * 128, P_HLB = P_GNW + 2 * 64, P_HNW = P_HLB + 2 * 256, P_SINK = P_HNW + 2 * 64, P_MU = P_SINK + 8,
              P_W0 = P_MU + 2 * 832, P_WUP = P_W0 + 2 * 256, P_A0 = P_WUP + 2 * 4096, P_AUP = P_A0 + 2 * 256, P_GUP = P_AUP + 2 * 4096, P_KK = P_GUP + 2 * 8192, P_KA = P_KK + 2 * 256,
              P_RK = P_KA + 2 * 256, P_LNXW = P_RK + 2 * 256, P_LNXB = P_LNXW + 2 * 256, P_VMU = P_LNXB + 2 * 256, P_V0 = P_VMU + 8, P_VUP = P_V0 + 256, P_LN1G = P_VUP + 2048,
              P_LN1B = P_LN1G + 2048, P_LN2G = P_LN1B + 2048, P_LN2B = P_LN2G + 2048, P_ROUTER = P_LN2B + 2048, P_LBS = P_ROUTER + 8192, P_END = P_LBS + 512;
static_assert(P_END * 4 <= 1 * MiB, "params block");
constexpr int CW_BAR = 4096, CW_MOE = 16384;
constexpr int LDS_BYTES = 147456, RING_BYTES = 131072, MISC_OFF = RING_BYTES + 320;

#define GAS __attribute__((address_space(1)))
#define LAS __attribute__((address_space(3)))
typedef unsigned short bf16;
typedef unsigned v4u __attribute__((ext_vector_type(4)));
typedef unsigned v2u __attribute__((ext_vector_type(2)));
typedef float f32x4 __attribute__((ext_vector_type(4)));
typedef short bf16x8 __attribute__((ext_vector_type(8)));
typedef GAS unsigned gu32;
#define RLX_AGENT __ATOMIC_RELAXED, __HIP_MEMORY_SCOPE_AGENT
#define LDS_WAIT() asm volatile("s_waitcnt lgkmcnt(0)" ::: "memory")
#define VM_WAIT() asm volatile("s_waitcnt vmcnt(0)" ::: "memory")
__device__ __forceinline__ unsigned f2bf(float f) { unsigned u = __builtin_bit_cast(unsigned, f); return (u + 0x7fffu + ((u >> 16) & 1u)) >> 16; }
__device__ __forceinline__ unsigned pk2(float lo, float hi) { return f2bf(lo) | (f2bf(hi) << 16); }
__device__ __forceinline__ float bf2f(unsigned short b) { return __uint_as_float(((unsigned)b) << 16); }
__device__ __forceinline__ float rcpf_(float x) { return __builtin_amdgcn_rcpf(x); }
__device__ __forceinline__ float sigmoidf_(float x) { return rcpf_(1.f + __expf(-x)); }
__device__ __forceinline__ float siluf_(float x) { return x * rcpf_(1.f + __expf(-x)); }
__device__ __forceinline__ float softplusf_(float x) { return fmaxf(x, 0.f) + __logf(1.f + __expf(-fabsf(x))); }
__device__ __forceinline__ float logsigmoidf_(float x) { return -softplusf_(-x); }
__device__ __forceinline__ float tanhf_(float x) { return 1.f - 2.f * rcpf_(1.f + __expf(2.f * x)); }
template <int CTRL> __device__ __forceinline__ float dppf(float v) { return __builtin_bit_cast(float, __builtin_amdgcn_update_dpp(0, __builtin_bit_cast(int, v), CTRL, 0xf, 0xf, false)); }
__device__ __forceinline__ float wave_sum(float v) {
    v += dppf<0x128>(v); v += dppf<0x124>(v); v += dppf<0x122>(v); v += dppf<0x121>(v);
    { float a = v, b = v; asm volatile("s_nop 1\n\tv_permlane16_swap_b32 %0, %1" : "+v"(a), "+v"(b)); v = a + b; }
    { float a = v, b = v; asm volatile("s_nop 1\n\tv_permlane32_swap_b32 %0, %1" : "+v"(a), "+v"(b)); v = a + b; }
    return v;
}
__device__ __forceinline__ float wave_max(float v) {
    v = fmaxf(v, dppf<0x128>(v)); v = fmaxf(v, dppf<0x124>(v)); v = fmaxf(v, dppf<0x122>(v)); v = fmaxf(v, dppf<0x121>(v));
    { float a = v, b = v; asm volatile("s_nop 1\n\tv_permlane16_swap_b32 %0, %1" : "+v"(a), "+v"(b)); v = fmaxf(a, b); }
    { float a = v, b = v; asm volatile("s_nop 1\n\tv_permlane32_swap_b32 %0, %1" : "+v"(a), "+v"(b)); v = fmaxf(a, b); }
    return v;
}
#define XB_TMO      128
#define XB_XCNT(j)  (256  + 64 * (j))
#define XB_XSUB(j)  (1280 + 64 * (j))
#define XB_XGEN(j)  (2304 + 64 * (j))
#define XB_TOP      3328
#define XB_TOPGEN   3392
#define XCD_BAR_WORDS 3456
#define XB_SPIN_CAP (1u << 27)

__device__ __forceinline__ unsigned xb_ld(unsigned* p)              { return __hip_atomic_load(p, __ATOMIC_RELAXED, __HIP_MEMORY_SCOPE_AGENT); }
__device__ __forceinline__ unsigned xb_add(unsigned* p, unsigned v) { return __hip_atomic_fetch_add(p, v, __ATOMIC_RELAXED, __HIP_MEMORY_SCOPE_AGENT); }
__device__ __forceinline__ unsigned xb_xcc_id() { return (unsigned)__builtin_amdgcn_s_getreg((3 << 11) | 20) & 0xFu; }
#define XB_SPIN(cond, bar) do { unsigned _sp = 0; while (cond) { __builtin_amdgcn_s_sleep(1); \
    if ((++_sp & 255u) == 0u) { if (xb_ld(&(bar)[XB_TMO])) break; if (_sp > XB_SPIN_CAP) { atomicAdd(&(bar)[XB_TMO], 1u); break; } } } } while (0)

struct XcdBarrier {
    unsigned* bar; unsigned x;
    volatile LAS unsigned* st;
};

__device__ __forceinline__ XcdBarrier xcd_barrier_post(unsigned* bar, volatile LAS unsigned* st) {
    XcdBarrier b; b.bar = bar; b.x = xb_xcc_id(); b.st = st;
    if (threadIdx.x == 0) (void)xb_add(&bar[XB_XCNT(b.x)], 1u);
    return b;
}
__device__ __forceinline__ void xcd_barrier_complete(unsigned* bar, unsigned x, unsigned& nloc, unsigned& nx) {
    const unsigned G = gridDim.x * gridDim.y * gridDim.z;
    unsigned sum, cnt, mine, sp = 0u;
    for (;;) {
        sum = 0u; cnt = 0u; mine = 0u;
#pragma unroll
        for (unsigned j = 0; j < 16; ++j) { const unsigned c = xb_ld(&bar[XB_XCNT(j)]); sum += c; cnt += (c > 0u) ? 1u : 0u; }
        if (sum == G) break;
        __builtin_amdgcn_s_sleep(1);
        if ((++sp & 255u) == 0u) { if (xb_ld(&bar[XB_TMO])) break; if (sp > XB_SPIN_CAP) { atomicAdd(&bar[XB_TMO], 1u); break; } }
    }
    mine = xb_ld(&bar[XB_XCNT(x)]);
    nloc = mine > 0u ? mine : 1u; nx = cnt > 0u ? cnt : 1u;
}

__device__ __forceinline__ void xcd_barrier(const XcdBarrier& b) {
    asm volatile("s_waitcnt vmcnt(0)" ::: "memory");
    __syncthreads();
    if (threadIdx.x == 0) {
        unsigned* bar = b.bar;
        __builtin_amdgcn_s_waitcnt(0);
        unsigned nloc = b.st[0], nx = b.st[1];
        if (nloc == 0u) { xcd_barrier_complete(bar, b.x, nloc, nx); b.st[0] = nloc; b.st[1] = nx; }
        const unsigned old = xb_add(&bar[XB_XSUB(b.x)], 1u);
        const unsigned gen = old / nloc;
        if (old + 1u == (gen + 1u) * nloc) {
            __builtin_amdgcn_fence(__ATOMIC_RELEASE, "agent");
            asm volatile("s_waitcnt vmcnt(0)" ::: "memory");
            const unsigned og = xb_add(&bar[XB_TOP], 1u);
            const unsigned tg = og / nx;
            if (og + 1u == (tg + 1u) * nx) xb_add(&bar[XB_TOPGEN], 1u);
            else XB_SPIN(xb_ld(&bar[XB_TOPGEN]) == tg, bar);
            __builtin_amdgcn_fence(__ATOMIC_ACQUIRE, "agent");
            xb_add(&bar[XB_XGEN(b.x)], 1u);
            asm volatile("s_waitcnt vmcnt(0)" ::: "memory");
        } else {
            XB_SPIN(xb_ld(&bar[XB_XGEN(b.x)]) == gen, bar);
            __builtin_amdgcn_fence(__ATOMIC_ACQUIRE, "agent");
            asm volatile("s_waitcnt vmcnt(0)" ::: "memory");
        }
    }
    __syncthreads();
}

constexpr int RW_PACK = 16384;
constexpr int RW_AHAT = 0, RW_W2 = 2048, RW_S2A = 6144, RW_V = 10240, RW_R = 12288, RW_ARK = 14336, RW_P = 15360;
constexpr int RWL_BYTES = 21504;
typedef __bf16 bf16v2_t __attribute__((ext_vector_type(2)));
__device__ __forceinline__ unsigned cvt_pk(float lo, float hi) { bf16v2_t v; v[0] = (__bf16)lo; v[1] = (__bf16)hi; return __builtin_bit_cast(unsigned, v); }
__device__ __forceinline__ bf16x8 pack8(const f32x4& a, const f32x4& b) { v4u p; p.x = cvt_pk(a[0], a[1]); p.y = cvt_pk(a[2], a[3]); p.z = cvt_pk(b[0], b[1]); p.w = cvt_pk(b[2], b[3]); return __builtin_bit_cast(bf16x8, p); }
__device__ __forceinline__ bf16x8 pack8u(const f32x4& a, v2u vb) { v4u p; p.x = cvt_pk(a[0], a[1]); p.y = cvt_pk(a[2], a[3]); p.z = vb.x; p.w = vb.y; return __builtin_bit_cast(bf16x8, p); }
__device__ __forceinline__ bf16x8 frag2(v2u a, v2u b) { v4u p; p.x = a.x; p.y = a.y; p.z = b.x; p.w = b.y; return __builtin_bit_cast(bf16x8, p); }
#define MFMA16(a, b, c) __builtin_amdgcn_mfma_f32_16x16x32_bf16((a), (b), (c), 0, 0, 0)

struct RwkvPrepArgs { const bf16* z; const float* P; bf16* vfirst; unsigned char* pack; bf16* gout; bf16* vout; float* bcout; };
template <int L>
__device__ __forceinline__ void rwkv_prep_wave(const RwkvPrepArgs& A, int hd, int c0, int cstride, int cend, LAS unsigned char* wl, int lane) {
    const int col = hd * 64 + lane, lo = lane & 15, h = lane >> 4;
    const float* P = A.P;
    float wup[16], aup[16], vup[8];
#pragma unroll
    for (int i = 0; i < 16; ++i) { wup[i] = P[P_WUP + L * 4096 + i * 256 + col]; aup[i] = P[P_AUP + L * 4096 + i * 256 + col]; }
#pragma unroll
    for (int i = 0; i < 8; ++i) vup[i] = (L > 0) ? P[P_VUP + i * 256 + col] : 0.f;
    const float w0 = P[P_W0 + L * 256 + col], a0 = P[P_A0 + L * 256 + col], kkp = P[P_KK + L * 256 + col], kap = P[P_KA + L * 256 + col], rkp = P[P_RK + L * 256 + col];
    const float v0p = (L > 0) ? P[P_V0 + col] : 0.f;
    const float mur = P[P_MU + L * 832 + col], muk = P[P_MU + L * 832 + 256 + col], muv = P[P_MU + L * 832 + 512 + col];
    LAS bf16* atX = (LAS bf16*)(wl + 0); LAS bf16* rtX = (LAS bf16*)(wl + 2048); LAS bf16* btX = (LAS bf16*)(wl + 4096); LAS bf16* ktX = (LAS bf16*)(wl + 6144);
    LAS bf16* atT = (LAS bf16*)(wl + 8192); LAS bf16* pbT = (LAS bf16*)(wl + 10240); LAS bf16* pkT = (LAS bf16*)(wl + 12288); LAS bf16* vT = (LAS bf16*)(wl + 14336);
    LAS float* LR = (LAS float*)(wl + 16384); asm volatile("" : "+v"(LR));
    LAS float* Lm = (LAS float*)(wl + 16384); asm volatile("" : "+v"(Lm)); LAS bf16* Tb = (LAS bf16*)(wl + 17472);
    LAS bf16* Gak = (LAS bf16*)(wl + 17984); LAS bf16* Grb = (LAS bf16*)(wl + 18496); LAS bf16* Grk = (LAS bf16*)(wl + 19008);
    const f32x4 z4 = (f32x4){0.f, 0.f, 0.f, 0.f}; const bf16x8 z8 = (bf16x8){0, 0, 0, 0, 0, 0, 0, 0};
    const __amdgpu_buffer_rsrc_t zsrd = __builtin_amdgcn_make_buffer_rsrc((void*)A.z, 0, T * ZLD * 2, 0x00020000);
    const __amdgpu_buffer_rsrc_t vsrd = __builtin_amdgcn_make_buffer_rsrc((void*)A.vfirst, 0, T * 256 * 2, 0x00020000);
    const __amdgpu_buffer_rsrc_t gsrd = __builtin_amdgcn_make_buffer_rsrc((void*)A.gout, 0, T * 256 * 2, 0x00020000);
    LAS bf16* LRraw = (LAS bf16*)(wl + 10240);
    for (int c = c0; c < cend; c += cstride) {
        const int t0 = c * 16;
        int ln = lane; asm volatile("" : "+v"(ln));
        const unsigned zo = (unsigned)((t0 - 1) * ZLD + Z_RZ + col) * 2u;
        {
            bf16 rawv[20];
#pragma unroll
            for (int q = 0; q < 20; ++q) { const int e = ln + 64 * q; const int t = e / 72, i = e - t * 72;
                const int zc = (i < 64) ? (Z_RZ + 768 + i) : (Z_VD + i - 64);
                const unsigned bo = (e < 17 * 72 && (i < 64 || L > 0)) ? (unsigned)((t0 + t - 1) * ZLD + zc) * 2u : 0xfffffff0u;
                rawv[q] = (bf16)__builtin_amdgcn_raw_buffer_load_b16(zsrd, bo, 0, 0); }
#pragma unroll
            for (int q = 0; q < 20; ++q) { const int e = ln + 64 * q; if (e < 17 * 72) LRraw[e] = rawv[q]; }
        }
        LDS_WAIT(); asm volatile("" ::: "memory");
#pragma unroll 2
        for (int q = 0; q < 18; ++q) {
            const int e = ln + 64 * q, t = e / 72, i = e - t * 72;
            const float cur = bf2f(LRraw[e + 72]), prev = bf2f(LRraw[e]);
            const float m = (i < 64) ? P[P_MU + L * 832 + 768 + i] : P[P_VMU + i - 64];
            float val = cur + (prev - cur) * m;
            if (i < 16) val = tanhf_(val); else if (i >= 32 && i < 64) val = sigmoidf_(val);
            LR[e] = val;
        }
        LDS_WAIT(); asm volatile("" ::: "memory");
        {
            float sg[16];
#pragma unroll
            for (int t = 0; t < 16; ++t) sg[t] = 0.f;
            const float* gp = P + P_GUP + L * 8192 + col;
#pragma unroll 4
            for (int i = 0; i < 32; ++i) { const float w = gp[i * 256];
#pragma unroll
                for (int t = 0; t < 16; ++t) sg[t] += LR[t * 72 + 32 + i] * w; }
#pragma unroll
            for (int t = 0; t < 16; ++t) __builtin_amdgcn_raw_buffer_store_b16((short)f2bf(sg[t]), gsrd, (unsigned)((t0 + t) * 256 + col) * 2u, 0, 0);
        }
        float cum = 0.f, bcv = 0.f;
        const size_t ob = (size_t)t0 * 256 + col;
#define RW_LD3(dst, tt) do { const unsigned o_ = zo + (unsigned)(tt) * (ZLD * 2); dst[0] = (bf16)__builtin_amdgcn_raw_buffer_load_b16(zsrd, o_, 0, 0); dst[1] = (bf16)__builtin_amdgcn_raw_buffer_load_b16(zsrd, o_ + 512, 0, 0); \
            dst[2] = (bf16)__builtin_amdgcn_raw_buffer_load_b16(zsrd, o_ + 1024, 0, 0); dst[3] = (L > 0) ? (bf16)__builtin_amdgcn_raw_buffer_load_b16(vsrd, (unsigned)((t0 + (tt) - 1) * 256 + col) * 2u, 0, 0) : (bf16)0; } while (0)
        bf16 w0_[4], w1_[4], w2_[4], w3_[4], w4_[4];
        RW_LD3(w0_, 0); RW_LD3(w1_, 1); RW_LD3(w2_, 2); RW_LD3(w3_, 3); RW_LD3(w4_, 4);
#pragma unroll 1
        for (int t = 0; t < 16; ++t) {
            const float cr = bf2f(w1_[0]), ck = bf2f(w1_[1]), cv = bf2f(w1_[2]);
            const float rr = cr + (bf2f(w0_[0]) - cr) * mur, kk0 = ck + (bf2f(w0_[1]) - ck) * muk; float vv = cv + (bf2f(w0_[2]) - cv) * muv;
            const float vfv = bf2f(w1_[3]);
#pragma unroll
            for (int i = 0; i < 4; ++i) { w0_[i] = w1_[i]; w1_[i] = w2_[i]; w2_[i] = w3_[i]; w3_[i] = w4_[i]; }
            { const int tn = (t + 5 < 17) ? t + 5 : 16; RW_LD3(w4_, tn); }
            const LAS float* lr = LR + t * 72;
            float sw = w0, sa = a0;
#pragma unroll
            for (int i = 0; i < 16; ++i) { sw += lr[i] * wup[i]; sa += lr[16 + i] * aup[i]; }
            const float wlog = -softplusf_(-sw) - 0.5f;
            const float lw = -__expf(wlog);
            const float av = sigmoidf_(sa);
            if (L > 0) { float sv = v0p;
#pragma unroll
                for (int i = 0; i < 8; ++i) sv += lr[64 + i] * vup[i];
                vv = vv + (vfv - vv) * sigmoidf_(sv); }
            float kk = kk0 * kkp; const float ss = wave_sum(kk * kk); kk = kk * rsqrtf(fmaxf(ss, 1e-24f));
            const float k2 = kk0 * (1.f + (av - 1.f) * kap);
            const float bc = wave_sum(rr * k2 * rkp);
            bcv = (ln == t) ? bc : bcv;
            const float ea = __expf(cum); cum += lw; const float e = __expf(cum), ei = __expf(-cum);
            const float at = -kk * ea, bt = kk * av * ei, kt = k2 * ei, rt = rr * e;
            atX[t * 64 + lane] = (bf16)f2bf(at); rtX[t * 64 + lane] = (bf16)f2bf(rt); btX[t * 64 + lane] = (bf16)f2bf(bt); ktX[t * 64 + lane] = (bf16)f2bf(kt);
            atT[lane * 16 + t] = (bf16)f2bf(at); vT[lane * 16 + t] = (bf16)f2bf(vv);
        }
#undef RW_LD3
        if (ln < 16) A.bcout[(size_t)(t0 + ln) * 4 + hd] = bcv;
        const float PC = __expf(cum);
        LDS_WAIT(); asm volatile("" ::: "memory");
#pragma unroll 1
        for (int t = 0; t < 16; ++t) { const bf16 vb16 = vT[lane * 16 + t]; A.vout[ob + (size_t)t * 256] = vb16; if (L == 0) A.vfirst[ob + (size_t)t * 256] = vb16; }
#pragma unroll 4
        for (int t = 0; t < 16; ++t) { pbT[lane * 16 + t] = (bf16)f2bf(bf2f(btX[t * 64 + lane]) * PC); pkT[lane * 16 + t] = (bf16)f2bf(bf2f(ktX[t * 64 + lane]) * PC); }
        unsigned char* pk_ = A.pack + ((size_t)c * 4 + hd) * RW_PACK;
        *(float*)(pk_ + RW_P + lane * 4) = PC;
        LDS_WAIT(); asm volatile("" ::: "memory");
        f32x4 Gab, Gak_, Grb_, Grk_;
        {
            bf16x8 af[2], rf[2], bq[2], kq[2];
#pragma unroll
            for (int s = 0; s < 2; ++s) { af[s] = *(const LAS bf16x8*)(atX + lo * 64 + 32 * s + 8 * h); rf[s] = *(const LAS bf16x8*)(rtX + lo * 64 + 32 * s + 8 * h);
                bq[s] = *(const LAS bf16x8*)(btX + lo * 64 + 32 * s + 8 * h); kq[s] = *(const LAS bf16x8*)(ktX + lo * 64 + 32 * s + 8 * h); }
            Gab = MFMA16(af[0], bq[0], z4); Gab = MFMA16(af[1], bq[1], Gab);
            Gak_ = MFMA16(af[0], kq[0], z4); Gak_ = MFMA16(af[1], kq[1], Gak_);
            Grb_ = MFMA16(rf[0], bq[0], z4); Grb_ = MFMA16(rf[1], bq[1], Grb_);
            Grk_ = MFMA16(rf[0], kq[0], z4); Grk_ = MFMA16(rf[1], kq[1], Grk_);
        }
#pragma unroll
        for (int r = 0; r < 4; ++r) { const int t = 4 * h + r; const bool sl = lo < t, sle = lo <= t;
            Lm[t * 17 + lo] = sl ? Gab[r] : 0.f; Gak[t * 16 + lo] = (bf16)f2bf(sl ? Gak_[r] : 0.f); Grb[t * 16 + lo] = (bf16)f2bf(sle ? Grb_[r] : 0.f); Grk[t * 16 + lo] = (bf16)f2bf(sle ? Grk_[r] : 0.f); }
        LDS_WAIT(); asm volatile("" ::: "memory");
        {
            float Tc[16];
            const int lo_i = ln & 15;
#pragma unroll
            for (int t = 0; t < 16; ++t) { float acc = (t == lo_i) ? 1.f : 0.f;
#pragma unroll
                for (int s = 0; s < t; ++s) acc += Lm[t * 17 + s] * Tc[s];
                Tc[t] = acc; }
#pragma unroll
            for (int t = 0; t < 16; ++t) Tb[t * 16 + lo] = (bf16)f2bf(Tc[t]);
        }
        LDS_WAIT(); asm volatile("" ::: "memory");
        {
            const bf16x8 Tfr = (h < 2) ? *(const LAS bf16x8*)(Tb + lo * 16 + 8 * h) : z8;
            f32x4 Cm[4];
#pragma unroll
            for (int m = 0; m < 4; ++m) { const bf16x8 Afr = (h < 2) ? *(const LAS bf16x8*)(atT + (16 * m + lo) * 16 + 8 * h) : z8;
                Cm[m] = MFMA16(Afr, Tfr, z4); }
            *(bf16x8*)(pk_ + RW_AHAT + 0 * 1024 + lane * 16) = pack8(Cm[0], Cm[1]);
            *(bf16x8*)(pk_ + RW_AHAT + 1 * 1024 + lane * 16) = pack8(Cm[2], Cm[3]);
        }
        {
            const bf16x8 Gfr = (h < 2) ? *(const LAS bf16x8*)(Gak + lo * 16 + 8 * h) : z8;
            const v2u t4 = *(const LAS v2u*)(Tb + lo * 16 + 4 * h); const bf16x8 T2 = frag2(t4, (v2u){0u, 0u});
#pragma unroll
            for (int vb = 0; vb < 4; ++vb) {
                const bf16x8 Vn = (h < 2) ? *(const LAS bf16x8*)(vT + (16 * vb + lo) * 16 + 8 * h) : z8;
                const f32x4 X = MFMA16(Gfr, Vn, z4);
                const f32x4 W2 = MFMA16(T2, pack8(X, z4), z4);
                *(f32x4*)(pk_ + RW_W2 + vb * 1024 + lane * 16) = W2;
                *(v2u*)(pk_ + RW_V + vb * 512 + lane * 8) = *(const LAS v2u*)(vT + (16 * vb + lo) * 16 + 4 * h);
            }
        }
#pragma unroll
        for (int m = 0; m < 4; ++m) *(bf16x8*)(pk_ + RW_S2A + m * 1024 + lane * 16) = frag2(*(const LAS v2u*)(pbT + (16 * m + lo) * 16 + 4 * h), *(const LAS v2u*)(pkT + (16 * m + lo) * 16 + 4 * h));
#pragma unroll
        for (int s = 0; s < 2; ++s) *(bf16x8*)(pk_ + RW_R + s * 1024 + lane * 16) = frag2(*(const LAS v2u*)(rtX + lo * 64 + 32 * s + 4 * h), *(const LAS v2u*)(rtX + lo * 64 + 32 * s + 16 + 4 * h));
        *(bf16x8*)(pk_ + RW_ARK + lane * 16) = frag2(*(const LAS v2u*)(Grb + lo * 16 + 4 * h), *(const LAS v2u*)(Grk + lo * 16 + 4 * h));
        LDS_WAIT(); asm volatile("" ::: "memory");
    }
}

struct RwkvSeqArgs { const unsigned char* pack; float* raw; };
struct RwkvOps { bf16x8 Ah0, Ah1, S2A[4], R0, R1, ARK; f32x4 W2, Pm[4]; v2u Vf; };
template <int MODE>
__device__ __forceinline__ void rwkv_load_ops(RwkvOps& o, const unsigned char* pk_, int vb, int lane) {
    const int h = lane >> 4;
    o.Ah0 = *(const bf16x8*)(pk_ + RW_AHAT + lane * 16); o.Ah1 = *(const bf16x8*)(pk_ + RW_AHAT + 1024 + lane * 16);
#pragma unroll
    for (int m = 0; m < 4; ++m) { o.S2A[m] = *(const bf16x8*)(pk_ + RW_S2A + m * 1024 + lane * 16); o.Pm[m] = *(const f32x4*)(pk_ + RW_P + (16 * m + 4 * h) * 4); }
    if (MODE != 1) { o.W2 = *(const f32x4*)(pk_ + RW_W2 + vb * 1024 + lane * 16); o.Vf = *(const v2u*)(pk_ + RW_V + vb * 512 + lane * 8); }
    if (MODE == 2) { o.R0 = *(const bf16x8*)(pk_ + RW_R + lane * 16); o.R1 = *(const bf16x8*)(pk_ + RW_R + 1024 + lane * 16); o.ARK = *(const bf16x8*)(pk_ + RW_ARK + lane * 16); }
}
template <int MODE>
__device__ __forceinline__ void rwkv_seq_wave(const RwkvSeqArgs& A, int hd, int vb, int cb, int ce, f32x4 (&St)[4], int lane) {
    const int lo = lane & 15, h = lane >> 4; const f32x4 zz = (f32x4){0.f, 0.f, 0.f, 0.f};
    RwkvOps cur, nxt;
    rwkv_load_ops<MODE>(cur, A.pack + ((size_t)cb * 4 + hd) * RW_PACK, vb, lane);
    for (int c = cb; c < ce; ++c) {
        const int cn = (c + 1 < ce) ? c + 1 : c;
        rwkv_load_ops<MODE>(nxt, A.pack + ((size_t)cn * 4 + hd) * RW_PACK, vb, lane);
        const bf16x8 B0 = pack8(St[0], St[1]), B1 = pack8(St[2], St[3]);
        f32x4 U = MFMA16(cur.Ah0, B0, (MODE == 1) ? zz : cur.W2); U = MFMA16(cur.Ah1, B1, U);
        const bf16x8 BU = (MODE == 1) ? pack8(U, zz) : pack8u(U, cur.Vf);
        if (MODE == 2) {
            f32x4 y = MFMA16(cur.R0, B0, zz); y = MFMA16(cur.R1, B1, y); y = MFMA16(cur.ARK, BU, y);
#pragma unroll
            for (int r = 0; r < 4; ++r) A.raw[(size_t)(c * 16 + 4 * h + r) * 768 + 512 + hd * 64 + vb * 16 + lo] = y[r];
        }
#pragma unroll
        for (int m = 0; m < 4; ++m) St[m] = MFMA16(cur.S2A[m], BU, St[m] * cur.Pm[m]);
        cur = nxt;
    }
}
template <int MT> struct GLP { static constexpr int DK = MT ? 64 : 32, Q = 0, AV = DK / 32 * 1024, KH = AV + 1024, V = KH + DK / 16 * 1024, G = V + 2048, PACK = MT ? 10240 : 7168; };
constexpr int GLL_BYTES = 10240;
struct GlaPrepArgs { const bf16* z; const float* P; unsigned char* pack; };
template <int L, int MT>
__device__ __forceinline__ void gla_prep_wave(const GlaPrepArgs& A, int hd, int c0, int cstride, int cend, LAS unsigned char* wl, int lane) {
    constexpr int DK = MT ? 64 : 32;
    const int ch = lane & (DK - 1), lo = lane & 15, h = lane >> 4;
    const float* P = A.P;
    float gku[16]; float gkb = 0.f, lb = 0.f;
    if (MT == 0) {
#pragma unroll
        for (int i = 0; i < 16; ++i) gku[i] = P[P_GKUP + L * 2048 + i * 128 + hd * 32 + ch];
        gkb = P[P_GKB + L * 128 + hd * 32 + ch];
    } else lb = P[P_LBS + L * 256 + hd * 64 + ch];
    LAS bf16* qX = (LAS bf16*)(wl + 0); LAS bf16* ktX = (LAS bf16*)(wl + 2048); LAS bf16* khT = (LAS bf16*)(wl + 4096); LAS bf16* vT = (LAS bf16*)(wl + 6144);
    LAS bf16* Aimg = (LAS bf16*)(wl + 8192); LAS float* LR = (LAS float*)(wl + 8704); asm volatile("" : "+v"(LR));
    const f32x4 z4 = (f32x4){0.f, 0.f, 0.f, 0.f};
    const __amdgpu_buffer_rsrc_t zsrd = __builtin_amdgcn_make_buffer_rsrc((void*)A.z, 0, T * ZLD * 2, 0x00020000);
    for (int c = c0; c < cend; c += cstride) {
        const int t0 = c * 16;
        const unsigned qo = (unsigned)(t0 * ZLD + (MT ? Z_HQ + hd * 64 : Z_GQ + hd * 32) + ch) * 2u, ko = (unsigned)(t0 * ZLD + (MT ? Z_HF + hd * 64 : Z_GK + hd * 32) + ch) * 2u, vo = (unsigned)(t0 * ZLD + (MT ? Z_HI : Z_GV) + hd * 64 + lane) * 2u;
        if (MT == 0) {
#pragma unroll
            for (int q = 0; q < 4; ++q) { const int e = lane + 64 * q; LR[e] = bf2f(A.z[(size_t)(t0 + (e >> 4)) * ZLD + Z_GGK + (e & 15)]); }
            LDS_WAIT(); asm volatile("" ::: "memory");
        }
        float cum = 0.f;
#define GL_LD3(dst, tt) do { const unsigned s_ = (unsigned)(tt) * (ZLD * 2); dst[0] = (bf16)__builtin_amdgcn_raw_buffer_load_b16(zsrd, qo + s_, 0, 0); dst[1] = (bf16)__builtin_amdgcn_raw_buffer_load_b16(zsrd, ko + s_, 0, 0); \
            dst[2] = (bf16)__builtin_amdgcn_raw_buffer_load_b16(zsrd, vo + s_, 0, 0); } while (0)
        bf16 w0_[3], w1_[3], w2_[3], w3_[3];
        GL_LD3(w0_, 0); GL_LD3(w1_, 1); GL_LD3(w2_, 2); GL_LD3(w3_, 3);
#pragma unroll 1
        for (int t = 0; t < 16; ++t) {
            const bf16 zq = w0_[0], zk2 = w0_[1], zvv = w0_[2];
#pragma unroll
            for (int i = 0; i < 3; ++i) { w0_[i] = w1_[i]; w1_[i] = w2_[i]; w2_[i] = w3_[i]; }
            { const int tn = (t + 4 < 16) ? t + 4 : 15; GL_LD3(w3_, tn); }
            float q, k, lf;
            if (MT == 0) {
                q = bf2f(zq) * 0.17677669529663687f; k = bf2f(zk2);
                float s = gkb;
#pragma unroll
                for (int i = 0; i < 16; ++i) s += LR[t * 16 + i] * gku[i];
                lf = logsigmoidf_(s) * (1.f / 16.f);
            } else {
                const float fq = bf2f(zq), ff = bf2f(zk2);
                q = siluf_(fq); k = (1.f - lb) * sigmoidf_(-ff);
                lf = (lb == 0.f) ? logsigmoidf_(ff) : __logf(lb + (1.f - lb) * sigmoidf_(ff));
            }
            cum += lf;
            qX[t * 64 + ch] = (bf16)f2bf(q * __expf(cum)); ktX[t * 64 + ch] = (bf16)f2bf(k * __expf(-cum));
            vT[lane * 16 + t] = zvv;
        }
#undef GL_LD3
        LDS_WAIT(); asm volatile("" ::: "memory");
        { const float gch = __expf(cum);
#pragma unroll 4
          for (int t = 0; t < 16; ++t) khT[ch * 16 + t] = (bf16)f2bf(bf2f(ktX[t * 64 + ch]) * gch); }
        unsigned char* pk_ = A.pack + ((size_t)c * 4 + hd) * GLP<MT>::PACK;
        if (lane < DK) *(float*)(pk_ + GLP<MT>::G + ch * 4) = __expf(cum);
        LDS_WAIT(); asm volatile("" ::: "memory");
        f32x4 Am = z4;
#pragma unroll
        for (int s = 0; s < DK / 32; ++s) Am = MFMA16(*(const LAS bf16x8*)(qX + lo * 64 + 32 * s + 8 * h), *(const LAS bf16x8*)(ktX + lo * 64 + 32 * s + 8 * h), Am);
#pragma unroll
        for (int r = 0; r < 4; ++r) { const int t = 4 * h + r; Aimg[t * 16 + lo] = (bf16)f2bf(lo <= t ? Am[r] : 0.f); }
        LDS_WAIT(); asm volatile("" ::: "memory");
#pragma unroll
        for (int s = 0; s < DK / 32; ++s) *(bf16x8*)(pk_ + GLP<MT>::Q + s * 1024 + lane * 16) = frag2(*(const LAS v2u*)(qX + lo * 64 + 32 * s + 4 * h), *(const LAS v2u*)(qX + lo * 64 + 32 * s + 16 + 4 * h));
        *(bf16x8*)(pk_ + GLP<MT>::AV + lane * 16) = frag2(*(const LAS v2u*)(Aimg + lo * 16 + 4 * h), (v2u){0u, 0u});
#pragma unroll
        for (int m = 0; m < DK / 16; ++m) *(bf16x8*)(pk_ + GLP<MT>::KH + m * 1024 + lane * 16) = frag2(*(const LAS v2u*)(khT + (16 * m + lo) * 16 + 4 * h), (v2u){0u, 0u});
#pragma unroll
        for (int vb = 0; vb < 4; ++vb) *(v2u*)(pk_ + GLP<MT>::V + vb * 512 + lane * 8) = *(const LAS v2u*)(vT + (16 * vb + lo) * 16 + 4 * h);
        LDS_WAIT(); asm volatile("" ::: "memory");
    }
}
struct GlaSeqArgs { const unsigned char* pack; float* raw; };
template <int MT> struct GlaOps { bf16x8 Q[2], AV, KH[4]; f32x4 Gm[4]; v2u Vf; };
template <int MT, bool OUT>
__device__ __forceinline__ void gla_load_ops(GlaOps<MT>& o, const unsigned char* pk_, int vb, int lane) {
    constexpr int DK = MT ? 64 : 32; const int h = lane >> 4;
#pragma unroll
    for (int m = 0; m < DK / 16; ++m) { o.KH[m] = *(const bf16x8*)(pk_ + GLP<MT>::KH + m * 1024 + lane * 16); o.Gm[m] = *(const f32x4*)(pk_ + GLP<MT>::G + (16 * m + 4 * h) * 4); }
    o.Vf = *(const v2u*)(pk_ + GLP<MT>::V + vb * 512 + lane * 8);
    if (OUT) {
#pragma unroll
        for (int s = 0; s < DK / 32; ++s) o.Q[s] = *(const bf16x8*)(pk_ + GLP<MT>::Q + s * 1024 + lane * 16);
        o.AV = *(const bf16x8*)(pk_ + GLP<MT>::AV + lane * 16);
    }
}
template <int MT, bool OUT>
__device__ __forceinline__ void gla_seq_wave(const GlaSeqArgs& A, int hd, int vb, int cb, int ce, f32x4 (&S)[4], f32x4 (&Dp)[4], int lane) {
    constexpr int DK = MT ? 64 : 32;
    const int lo = lane & 15, h = lane >> 4; const f32x4 z4 = (f32x4){0.f, 0.f, 0.f, 0.f};
    GlaOps<MT> cur, nxt;
    gla_load_ops<MT, OUT>(cur, A.pack + ((size_t)cb * 4 + hd) * GLP<MT>::PACK, vb, lane);
    for (int c = cb; c < ce; ++c) {
        const int cn = (c + 1 < ce) ? c + 1 : c;
        gla_load_ops<MT, OUT>(nxt, A.pack + ((size_t)cn * 4 + hd) * GLP<MT>::PACK, vb, lane);
        const bf16x8 BV = frag2(cur.Vf, (v2u){0u, 0u});
        if (OUT) {
            f32x4 o = MFMA16(cur.AV, BV, z4);
#pragma unroll
            for (int s = 0; s < DK / 32; ++s) o = MFMA16(cur.Q[s], pack8(S[2 * s], S[2 * s + 1]), o);
#pragma unroll
            for (int r = 0; r < 4; ++r) A.raw[(size_t)(c * 16 + 4 * h + r) * 768 + MT * 256 + hd * 64 + vb * 16 + lo] = o[r];
        }
#pragma unroll
        for (int m = 0; m < DK / 16; ++m) { S[m] = MFMA16(cur.KH[m], BV, S[m] * cur.Gm[m]); if (!OUT) Dp[m] = Dp[m] * cur.Gm[m]; }
        cur = nxt;
    }
}
struct MixPostArgs { const float* raw; const bf16* z; const float* P; const bf16* g; const bf16* v; const float* bc; bf16* mix; int layer; int pad; };
__device__ __forceinline__ void mix_post_items(const MixPostArgs& A, int w0, int NW, int lane) {
    constexpr int U = 4;
    for (int item0 = w0 * U; item0 < T * 12; item0 += NW * U) {
        float o[U], gj[U], aux[U], bcv[U];
#pragma unroll
        for (int u = 0; u < U; ++u) {
            const int item = item0 + u, t = item / 12, mh = item - t * 12, mt = mh >> 2, hd = mh & 3;
            o[u] = A.raw[(size_t)t * 768 + mh * 64 + lane];
            if (mt < 2) { gj[u] = bf2f(A.z[(size_t)t * ZLD + (mt ? Z_HG : Z_GG) + hd * 64 + lane]); aux[u] = 0.f; bcv[u] = 0.f; }
            else { const int col = hd * 64 + lane; gj[u] = bf2f(A.g[(size_t)t * 256 + col]); aux[u] = bf2f(A.v[(size_t)t * 256 + col]); bcv[u] = A.bc[(size_t)t * 4 + hd]; }
        }
#pragma unroll
        for (int u = 0; u < U; ++u) {
            const int item = item0 + u, t = item / 12, mh = item - t * 12, mt = mh >> 2, hd = mh & 3;
            float res;
            if (mt < 2) {
                const float ms = wave_sum(o[u] * o[u]) * (1.f / 64.f);
                const float nw = A.P[(mt ? P_HNW : P_GNW) + A.layer * 64 + lane];
                res = o[u] * rsqrtf(ms + RMS_EPS) * nw * siluf_(gj[u]);
            } else {
                const int col = hd * 64 + lane;
                const float mu = wave_sum(o[u]) * (1.f / 64.f); const float d = o[u] - mu; const float var = wave_sum(d * d) * (1.f / 64.f);
                const float yn = d * rsqrtf(var + GN_EPS) * A.P[P_LNXW + A.layer * 256 + col] + A.P[P_LNXB + A.layer * 256 + col];
                res = (yn + bcv[u] * aux[u]) * gj[u];
            }
            A.mix[(size_t)t * D + (mt < 2 ? mt * 256 : 768) + hd * 64 + lane] = (bf16)f2bf(res);
        }
    }
}
constexpr int SW_KLD = 72, SW_VLD = 264, SW_PLD = 40;
constexpr int SW_K = 0, SW_V = 256 * SW_KLD * 2, SW_P = SW_V + 64 * SW_VLD * 2, SW_PW = 32 * SW_PLD * 2, SW_LDS = SW_P + 8 * SW_PW;
typedef float f32x16 __attribute__((ext_vector_type(16)));
#define MFMA32(a, b, c) __builtin_amdgcn_mfma_f32_32x32x16_bf16((a), (b), (c), 0, 0, 0)
__device__ __forceinline__ void swa_items(const bf16* z, const float* sinks, bf16* mix, int i0, int istride, LAS unsigned char* lds, int tid) {
    const int lane = tid & 63, wave = tid >> 6, l31 = lane & 31, hh = lane >> 5;
    LAS bf16* Ks = (LAS bf16*)(lds + SW_K); LAS bf16* Vt = (LAS bf16*)(lds + SW_V); LAS bf16* Pw = (LAS bf16*)(lds + SW_P + wave * SW_PW);
    for (int item = i0; item < (T / 128) * 2; item += istride) {
        const int nb = item >> 1, kvh = item & 1, tk0 = nb * 128 - 128;
        __syncthreads();
#pragma unroll
        for (int q = 0; q < 4; ++q) {
            const int e = tid + 512 * q, key = e >> 3, ch = e & 7; int tok = tk0 + key; tok = tok < 0 ? 0 : tok;
            const v4u kv = *(const GAS v4u*)(z + (size_t)tok * ZLD + Z_SK + kvh * 64 + ch * 8);
            *(LAS v4u*)(Ks + key * SW_KLD + ch * 8) = kv;
            const v4u vv = *(const GAS v4u*)(z + (size_t)tok * ZLD + Z_SV + kvh * 64 + ch * 8);
#pragma unroll
            for (int j = 0; j < 4; ++j) { Vt[(ch * 8 + 2 * j) * SW_VLD + key] = (bf16)(vv[j] & 0xffffu); Vt[(ch * 8 + 2 * j + 1) * SW_VLD + key] = (bf16)(vv[j] >> 16); }
        }
        __syncthreads();
        const int g = wave >> 2, qh = kvh * 2 + g, q0 = (wave & 3) * 32, kt0 = wave & 3;
        const float sink = sinks[qh];
        bf16x8 Qf[4];
        { const bf16* qp = z + (size_t)(nb * 128 + q0 + l31) * ZLD + Z_SQ + qh * 64 + 8 * hh;
#pragma unroll
          for (int s = 0; s < 4; ++s) Qf[s] = *(const GAS bf16x8*)(qp + 16 * s); }
        f32x16 Sc[5];
#pragma unroll
        for (int kt = 0; kt < 5; ++kt) {
            f32x16 acc;
#pragma unroll
            for (int i = 0; i < 16; ++i) acc[i] = 0.f;
            const LAS bf16* kp = Ks + ((kt0 + kt) * 32 + l31) * SW_KLD + 8 * hh;
#pragma unroll
            for (int s = 0; s < 4; ++s) acc = MFMA32(Qf[s], *(const LAS bf16x8*)(kp + 16 * s), acc);
            Sc[kt] = acc;
        }
        int l31o = l31, hho = hh; asm volatile("" : "+v"(l31o), "+v"(hho));
        float mx[16];
#pragma unroll
        for (int r = 0; r < 16; ++r) {
            const int ro = (r & 3) + 8 * (r >> 2) + 4 * hho;
            const bool lowv = l31o > ro;
            float m = -INFINITY;
#pragma unroll
            for (int kt = 0; kt < 5; ++kt) { bool vis = (kt == 0) ? lowv : ((kt == 4) ? !lowv : true); if (nb == 0 && kt0 + kt < 4) vis = false;
                const float sv = vis ? Sc[kt][r] * 0.125f : -INFINITY; Sc[kt][r] = sv; m = fmaxf(m, sv); }
#pragma unroll
            for (int o = 1; o < 32; o <<= 1) m = fmaxf(m, __shfl_xor(m, o));
            mx[r] = fmaxf(m, sink);
        }
        float inv[16];
#pragma unroll
        for (int r = 0; r < 16; ++r) {
            float s = 0.f;
#pragma unroll
            for (int kt = 0; kt < 5; ++kt) { const float p = __expf(Sc[kt][r] - mx[r]); Sc[kt][r] = p; s += p; }
#pragma unroll
            for (int o = 1; o < 32; o <<= 1) s += __shfl_xor(s, o);
            inv[r] = 1.f / (s + __expf(sink - mx[r]));
        }
        f32x16 O0, O1;
#pragma unroll
        for (int i = 0; i < 16; ++i) { O0[i] = 0.f; O1[i] = 0.f; }
#pragma unroll
        for (int kt = 0; kt < 5; ++kt) {
#pragma unroll
            for (int r = 0; r < 16; ++r) Pw[((r & 3) + 8 * (r >> 2) + 4 * hh) * SW_PLD + l31] = (bf16)f2bf(Sc[kt][r] * inv[r]);
            LDS_WAIT(); asm volatile("" ::: "memory");
#pragma unroll
            for (int s = 0; s < 2; ++s) {
                const bf16x8 Pf = *(const LAS bf16x8*)(Pw + l31 * SW_PLD + 16 * s + 8 * hh);
                const int kb = (kt0 + kt) * 32 + 16 * s + 8 * hh;
                O0 = MFMA32(Pf, *(const LAS bf16x8*)(Vt + l31 * SW_VLD + kb), O0);
                O1 = MFMA32(Pf, *(const LAS bf16x8*)(Vt + (32 + l31) * SW_VLD + kb), O1);
            }
            LDS_WAIT(); asm volatile("" ::: "memory");
        }
#pragma unroll
        for (int r = 0; r < 16; ++r) { const int qi = q0 + (r & 3) + 8 * (r >> 2) + 4 * hh; bf16* op = mix + (size_t)(nb * 128 + qi) * D + 512 + qh * 64 + l31;
            op[0] = (bf16)f2bf(O0[r]); op[32] = (bf16)f2bf(O1[r]); }
    }
}
__device__ __forceinline__ void tr_item(const float* src, int ldw, int nvalid, bf16* dst, int dld, LAS float* scr, int lane) {
    const int nl = lane & 31;
    float tv[32];
#pragma unroll
    for (int i = 0; i < 32; ++i) { const int kk = 2 * i + (lane >> 5); tv[i] = (nl < nvalid) ? src[(size_t)kk * ldw + nl] : 0.f; }
#pragma unroll
    for (int i = 0; i < 32; ++i) { const int kk = 2 * i + (lane >> 5); scr[kk * 33 + nl] = tv[i]; }
    LDS_WAIT(); asm volatile("" ::: "memory");
    const int c = lane & 7;
#pragma unroll
    for (int j = 0; j < 4; ++j) { const int n = (lane >> 3) + 8 * j; const LAS float* s = scr + (8 * c) * 33 + n;
        v4u o; o.x = pk2(s[0 * 33], s[1 * 33]); o.y = pk2(s[2 * 33], s[3 * 33]); o.z = pk2(s[4 * 33], s[5 * 33]); o.w = pk2(s[6 * 33], s[7 * 33]);
        if (n < nvalid) *(GAS v4u*)(dst + (size_t)n * dld + 8 * c) = o; }
    LDS_WAIT(); asm volatile("" ::: "memory");
}
__device__ __forceinline__ void tr_job(const float* src, int ldw, int nblocks, int ncols, bf16* dst, int dld, int il, int rowoff, int it, LAS float* scr, int lane) {
    const int kb = it / nblocks, nb = it - kb * nblocks, n0 = nb * 32; const int nv = (ncols - n0) < 32 ? (ncols - n0) : 32;
    const int row = il ? ((n0 >> 7) * 256 + (n0 & 127) + rowoff) : (n0 + rowoff);
    tr_item(src + (size_t)kb * 64 * ldw + n0, ldw, nv, dst + (size_t)row * dld + kb * 64, dld, scr, lane);
}
__device__ __forceinline__ void moe_weights_half(const float* wg, const float* wu, const float* wd, bf16* gu, bf16* dn, int hh, int gw, int NGW, LAS float* scr, int lane) {
    constexpr int PER = 896, PE = 3 * PER;
    for (int it = gw; it < NE * PE; it += NGW) {
        const int e = it / PE, r = it - e * PE, which = r / PER, idx = r - which * PER;
        const float* src; int ldw, nblocks, ncols, dld, il, rowoff; bf16* dst;
        if (which == 0) { src = wg + (size_t)e * D * DFE + hh * DFH; ldw = DFE; nblocks = 56; ncols = DFH; dst = gu + (size_t)e * 3584 * D; dld = D; il = 1; rowoff = 0; }
        else if (which == 1) { src = wu + (size_t)e * D * DFE + hh * DFH; ldw = DFE; nblocks = 56; ncols = DFH; dst = gu + (size_t)e * 3584 * D; dld = D; il = 1; rowoff = 128; }
        else { src = wd + (size_t)e * DFE * D + (size_t)hh * DFH * D; ldw = D; nblocks = 32; ncols = D; dst = dn + (size_t)e * D * DFH; dld = DFH; il = 0; rowoff = 0; }
        tr_job(src, ldw, nblocks, ncols, dst, dld, il, rowoff, idx, scr, lane);
    }
}
__device__ __forceinline__ void cvt_rows(const float* src, bf16* dst, size_t n, size_t gtid, size_t nthreads) {
    for (size_t i = gtid * 8; i < n; i += nthreads * 8) { const f32x4 a = *(const GAS f32x4*)(src + i), b = *(const GAS f32x4*)(src + i + 4);
        v4u o; o.x = pk2(a[0], a[1]); o.y = pk2(a[2], a[3]); o.z = pk2(b[0], b[1]); o.w = pk2(b[2], b[3]); *(GAS v4u*)(dst + i) = o; }
}

struct LnArgs { const float* src; const float* gam; const float* bet; float* xout; bf16* xb; int mode; const bf16* Y1; const bf16* Y2; const int* tok_row; const float* top_g;
                int route; const float* router; int* top_e; float* top_gw; gu32* cnt; };
__device__ __forceinline__ void ln_rows(const LnArgs& a, int gw, int NGW, int lane) {
    for (int row = gw; row < T; row += NGW) {
        f32x4 v[4]; float s = 0.f;
        if (a.mode == 0) {
#pragma unroll
            for (int j = 0; j < 4; ++j) v[j] = *((const GAS f32x4*)(a.src + (size_t)row * D) + lane + 64 * j);
        } else {
            const int r0 = a.tok_row[row * 2], r1 = a.tok_row[row * 2 + 1]; const float g0 = a.top_g[row * 2], g1 = a.top_g[row * 2 + 1];
#pragma unroll
            for (int j = 0; j < 4; ++j) {
                const f32x4 xv = *((const GAS f32x4*)(a.xout + (size_t)row * D) + lane + 64 * j);
                const v2u a0 = *((const GAS v2u*)(a.Y1 + (size_t)r0 * D) + lane + 64 * j), b0 = *((const GAS v2u*)(a.Y2 + (size_t)r0 * D) + lane + 64 * j);
                const v2u a1 = *((const GAS v2u*)(a.Y1 + (size_t)r1 * D) + lane + 64 * j), b1 = *((const GAS v2u*)(a.Y2 + (size_t)r1 * D) + lane + 64 * j);
                f32x4 y0, y1;
                y0[0] = __uint_as_float(a0.x << 16) + __uint_as_float(b0.x << 16); y0[1] = __uint_as_float(a0.x & 0xffff0000u) + __uint_as_float(b0.x & 0xffff0000u);
                y0[2] = __uint_as_float(a0.y << 16) + __uint_as_float(b0.y << 16); y0[3] = __uint_as_float(a0.y & 0xffff0000u) + __uint_as_float(b0.y & 0xffff0000u);
                y1[0] = __uint_as_float(a1.x << 16) + __uint_as_float(b1.x << 16); y1[1] = __uint_as_float(a1.x & 0xffff0000u) + __uint_as_float(b1.x & 0xffff0000u);
                y1[2] = __uint_as_float(a1.y << 16) + __uint_as_float(b1.y << 16); y1[3] = __uint_as_float(a1.y & 0xffff0000u) + __uint_as_float(b1.y & 0xffff0000u);
                v[j] = xv * ALPHA + y0 * g0 + y1 * g1;
            }
        }
#pragma unroll
        for (int j = 0; j < 4; ++j) s += (v[j][0] + v[j][1]) + (v[j][2] + v[j][3]);
        const float mean = wave_sum(s) * (1.f / D); float q = 0.f;
#pragma unroll
        for (int j = 0; j < 4; ++j) { v[j] = v[j] - mean; q += (v[j][0] * v[j][0] + v[j][1] * v[j][1]) + (v[j][2] * v[j][2] + v[j][3] * v[j][3]); }
        const float rstd = rsqrtf(wave_sum(q) * (1.f / D) + LN_EPS);
#pragma unroll
        for (int j = 0; j < 4; ++j) {
            const f32x4 gg = *((const GAS f32x4*)a.gam + lane + 64 * j), bb = *((const GAS f32x4*)a.bet + lane + 64 * j);
            v[j] = v[j] * rstd * gg + bb;
            *((GAS f32x4*)(a.xout + (size_t)row * D) + lane + 64 * j) = v[j];
            v2u w; w.x = pk2(v[j][0], v[j][1]); w.y = pk2(v[j][2], v[j][3]);
            *((GAS v2u*)(a.xb + (size_t)row * D) + lane + 64 * j) = w;
        }
        if (a.route) {
            float lg[8];
#pragma unroll
            for (int e = 0; e < 8; ++e) lg[e] = 0.f;
#pragma unroll
            for (int j = 0; j < 4; ++j)
#pragma unroll
                for (int i = 0; i < 4; ++i) { const int d = 4 * lane + 256 * j + i; const f32x4 r0 = *(const GAS f32x4*)(a.router + d * 8), r1 = *(const GAS f32x4*)(a.router + d * 8 + 4); const float xv = v[j][i];
                    lg[0] += xv * r0[0]; lg[1] += xv * r0[1]; lg[2] += xv * r0[2]; lg[3] += xv * r0[3]; lg[4] += xv * r1[0]; lg[5] += xv * r1[1]; lg[6] += xv * r1[2]; lg[7] += xv * r1[3]; }
#pragma unroll
            for (int e = 0; e < 8; ++e) lg[e] = wave_sum(lg[e]);
            if (lane == 0) {
                int e0 = 0; float l0 = lg[0];
#pragma unroll
                for (int e = 1; e < 8; ++e) if (lg[e] > l0) { l0 = lg[e]; e0 = e; }
                int e1 = 0; float l1 = -INFINITY;
#pragma unroll
                for (int e = 0; e < 8; ++e) if (e != e0 && lg[e] > l1) { l1 = lg[e]; e1 = e; }
                const float g1 = __expf(l1 - l0), den = 1.f + g1;
                a.top_e[row * 2] = e0; a.top_e[row * 2 + 1] = e1; a.top_gw[row * 2] = 1.f / den; a.top_gw[row * 2 + 1] = g1 / den;
                __hip_atomic_fetch_add(a.cnt + e0, 1u, RLX_AGENT); __hip_atomic_fetch_add(a.cnt + e1, 1u, RLX_AGENT);
            }
        }
    }
}

struct Args { const float* in[38]; float* out; unsigned char* ws; };
template <int I> __device__ __forceinline__ const float* in_ptr() {
    unsigned long long v; auto kp = __builtin_amdgcn_kernarg_segment_ptr();
    asm volatile("s_load_dwordx2 %0, %1, %2\n\ts_waitcnt lgkmcnt(0)" : "=s"(v) : "s"(kp), "n"(I * 8));
    return (const float*)v;
}
#define IN(i) in_ptr<(i)>()
#ifndef DIAG_A
#define DIAG_A -1
#define DIAG_B -1
#define DIAG_DIV 100000.f
#endif
#define PHASE_IDS() int tid = threadIdx.x; asm volatile("" : "+v"(tid)); const int lane = tid & 63; (void)lane
#ifndef DUP_PHASE
#define DUP_PHASE -1
#define DUP_N 5
#endif
#define DUP_BEGIN(id) _Pragma("unroll") for (int rep_ = 0; rep_ < ((DUP_PHASE == (id)) ? DUP_N : 1); ++rep_) {
#define DUP_END() GRID_BAR(); }
#define DUP_END2() }
#define GRID_BAR() do { xcd_barrier(bar); if (DIAG_A >= -1 && DIAG_B >= 0) { if (bx == 0 && threadIdx.x == 0) ((GAS unsigned long long*)(args.ws + WS_CTL + 262144))[nst] = __builtin_amdgcn_s_memrealtime(); ++nst; } } while (0)
template <int L, bool DO_IN, bool DO_MIX, bool DO_POST>
__device__ __forceinline__ void layer_body(const Args& args, LAS unsigned char* lds, const XcdBarrier& bar, int tid0, int lane0, int wave, int G, int bx, int vcu, int gw, int NGW, int& nst) {
    (void)tid0; (void)lane0;
    unsigned char* ws = args.ws;
    gu32* ctl = (gu32*)(ws + WS_CTL);
    bf16* Wmoegu = (bf16*)(ws + WS_MOEGU); bf16* Wmoed = (bf16*)(ws + WS_MOED);
    bf16* vfirst = (bf16*)(ws + WS_VFIRST);
    bf16* zb = (bf16*)(ws + WS_Z); bf16* mix = (bf16*)(ws + WS_MIX); float* preln = (float*)(ws + WS_PRELN);
    float* gla_logf = (float*)(ws + WS_PREP); float* rwb = (float*)(ws + WS_PREP + 8 * MiB);
    const float* PB = (const float*)(ws + WS_MISC + MS_PARAMS); int* top_e = (int*)(ws + WS_MISC + MS_TOPE); float* top_g = (float*)(ws + WS_MISC + MS_TOPG);
    int* tok_row = (int*)(ws + WS_MISC + MS_TOKROW); int* row_tok = (int*)(ws + WS_MISC + MS_ROWTOK); int* tile_e = (int*)(ws + WS_MISC + MS_TILEE);
    float* xf = args.out;

        bf16* xb_in = (bf16*)(ws + (L == 0 ? WS_XB0 : WS_XB1)); bf16* xb_out = (bf16*)(ws + (L == 0 ? WS_XB1 : WS_XB0));
        const float* xres = (L == 0) ? IN(0) : xf;
        if constexpr (DO_IN) {
        DUP_BEGIN(L * 100 + 1)
        {
            pg8::Gemm g{xb_in, (const bf16*)(ws + (L == 0 ? WS_WIN0 : WS_WIN1)), T, ZLD, D}; pg8::StaticOrder S; S.init(T, ZLD, G, bx);
            pg8::EpiStoreBf16 E{zb, ZLD};
            pg8::gemm_phase<pg8::EpiStoreBf16, pg8::StaticOrder, PG8_ALIGN, PG8_SP2>(lds, g, S, E);
        }
        DUP_END();
        }
        if constexpr (DO_MIX) {
        float* sst = (float*)(ws + WS_SST); bf16* mtb = (bf16*)(ws + WS_MT); float* dsc = (float*)(ws + WS_MISC + MS_DSC); float* raw = (float*)(ws + WS_RAW);
        DUP_BEGIN(L * 100 + 3)
        DUP_BEGIN(L * 100 + 2)
        {
            PHASE_IDS(); const int lo = lane & 15, h = lane >> 4;
            const int j = vcu >> 2, hd = vcu & 3, cb = 16 * j, ce = cb + 16;
            DUP_BEGIN(L * 100 + 20)
            if (wave < 4) { RwkvPrepArgs rp; rp.z = zb; rp.P = PB; rp.vfirst = vfirst; rp.pack = ws + WS_RWPACK; rp.gout = (bf16*)(ws + WS_GOUT); rp.vout = (bf16*)(ws + WS_VOUT); rp.bcout = (float*)(ws + WS_BC);
                rwkv_prep_wave<L>(rp, hd, cb + wave, 4, ce, lds + wave * RWL_BYTES, lane); }
            else { GlaPrepArgs g0; g0.z = zb; g0.P = PB; g0.pack = ws + WS_GLPACK; GlaPrepArgs g1 = g0; g1.pack = ws + WS_HGPACK;
                gla_prep_wave<L, 0>(g0, hd, cb + wave - 4, 4, ce, lds + 4 * RWL_BYTES + (wave - 4) * GLL_BYTES, lane);
                gla_prep_wave<L, 1>(g1, hd, cb + wave - 4, 4, ce, lds + 4 * RWL_BYTES + (wave - 4) * GLL_BYTES, lane); }
            DUP_END2()
            VM_WAIT(); __syncthreads();
            DUP_BEGIN(L * 100 + 21)
            {
                RwkvSeqArgs sa; sa.pack = ws + WS_RWPACK; sa.raw = raw; f32x4 St[4];
                if (wave < 4) {
#pragma unroll
                    for (int m = 0; m < 4; ++m) St[m] = (f32x4){0.f, 0.f, 0.f, 0.f};
                    rwkv_seq_wave<0>(sa, hd, wave, cb, ce, St, lane);
                    float* o = sst + ((size_t)((8 + hd) * 64 + j)) * 4096 + (wave * 4 * 64 + lane) * 4;
#pragma unroll
                    for (int m = 0; m < 4; ++m) *(GAS f32x4*)(o + m * 256) = St[m];
                } else {
                    const int pb = wave - 4;
#pragma unroll
                    for (int m = 0; m < 4; ++m)
#pragma unroll
                        for (int r = 0; r < 4; ++r) St[m][r] = (16 * m + 4 * h + r == 16 * pb + lo) ? 1.f : 0.f;
                    rwkv_seq_wave<1>(sa, hd, pb, cb, ce, St, lane);
                    bf16* o = mtb + ((size_t)(hd * 64 + j)) * 4096 + 16 * pb + lo;
#pragma unroll
                    for (int m = 0; m < 4; ++m)
#pragma unroll
                        for (int r = 0; r < 4; ++r) o[(16 * m + 4 * h + r) * 64] = (bf16)f2bf(St[m][r]);
                }
            }
            DUP_END2()
            DUP_BEGIN(L * 100 + 22)
            {
                f32x4 S[4], Dp[4];
#pragma unroll
                for (int m = 0; m < 4; ++m) { S[m] = (f32x4){0.f, 0.f, 0.f, 0.f}; Dp[m] = (f32x4){1.f, 1.f, 1.f, 1.f}; }
                const int vb = wave & 3, mt = wave >> 2, mh = mt * 4 + hd;
                GlaSeqArgs sa; sa.pack = ws + (mt ? WS_HGPACK : WS_GLPACK); sa.raw = raw;
                if (mt == 0) gla_seq_wave<0, false>(sa, hd, vb, cb, ce, S, Dp, lane); else gla_seq_wave<1, false>(sa, hd, vb, cb, ce, S, Dp, lane);
                float* o = sst + ((size_t)(mh * 64 + j)) * 4096 + (vb * 4 * 64 + lane) * 4;
#pragma unroll
                for (int m = 0; m < 4; ++m) if (mt || m < 2) *(GAS f32x4*)(o + m * 256) = S[m];
                if (vb == 0 && lo == 0) {
#pragma unroll
                    for (int m = 0; m < 4; ++m) if (mt || m < 2) *(GAS f32x4*)(dsc + ((size_t)(mh * 64 + j)) * 64 + 16 * m + 4 * h) = Dp[m]; }
            }
            DUP_END2()
        }
        DUP_END();
        {
            PHASE_IDS(); const int lo = lane & 15, h = lane >> 4;
            if (bx < 48) {
                const int gt = bx * (NWAVES * 64) + tid; int mh, e, mm;
                if (gt < 8192) { mh = gt >> 11; e = gt & 2047; mm = (e >> 8) & 1; e = ((e >> 9) * 4 + mm) * 256 + (e & 255); }
                else { const int g2 = gt - 8192; mh = 4 + (g2 >> 12); e = g2 & 4095; mm = (e >> 8) & 3; }
                const int k = 16 * mm + 4 * ((e & 255) >> 6) + (e & 3);
                float* sp = sst + (size_t)mh * 64 * 4096 + e; const float* dp = dsc + (size_t)mh * 64 * 64 + k;
                float S = 0.f;
#pragma unroll 1
                for (int j0 = 0; j0 < 64; j0 += 8) {
                    float sl[8], dd[8];
#pragma unroll
                    for (int u = 0; u < 8; ++u) { sl[u] = sp[(size_t)(j0 + u) * 4096]; dd[u] = dp[(j0 + u) * 64]; }
#pragma unroll
                    for (int u = 0; u < 8; ++u) { sp[(size_t)(j0 + u) * 4096] = S; S = dd[u] * S + sl[u]; }
                }
            } else if (bx < 52) {
                if (wave < 4) {
                    const int hd = bx - 48, vb = wave;
                    f32x4 St[4], Nt[4], Nn[4]; bf16x8 Af[4][2], An[4][2];
#pragma unroll
                    for (int m = 0; m < 4; ++m) St[m] = (f32x4){0.f, 0.f, 0.f, 0.f};
                    float* sp = sst + ((size_t)(8 + hd) * 64) * 4096 + (vb * 4 * 64 + lane) * 4; const bf16* mp = mtb + ((size_t)hd * 64) * 4096 + lo * 64 + 4 * h;
#define RW_SCAN_LOAD(N_, A_, jj) do { _Pragma("unroll") for (int m = 0; m < 4; ++m) { N_[m] = *(const GAS f32x4*)(sp + (size_t)(jj) * 4096 + m * 256); \
                        _Pragma("unroll") for (int s2 = 0; s2 < 2; ++s2) A_[m][s2] = frag2(*(const GAS v2u*)(mp + (size_t)(jj) * 4096 + (16 * m) * 64 + 32 * s2), *(const GAS v2u*)(mp + (size_t)(jj) * 4096 + (16 * m) * 64 + 32 * s2 + 16)); } } while (0)
                    RW_SCAN_LOAD(Nt, Af, 0);
#pragma unroll 1
                    for (int j = 0; j < 64; ++j) {
                        const int jn = j < 63 ? j + 1 : j;
                        RW_SCAN_LOAD(Nn, An, jn);
                        const bf16x8 B0 = pack8(St[0], St[1]), B1 = pack8(St[2], St[3]);
#pragma unroll
                        for (int m = 0; m < 4; ++m) { *(GAS f32x4*)(sp + (size_t)j * 4096 + m * 256) = St[m]; }
#pragma unroll
                        for (int m = 0; m < 4; ++m) { f32x4 a = MFMA16(Af[m][0], B0, Nt[m]); St[m] = MFMA16(Af[m][1], B1, a); }
#pragma unroll
                        for (int m = 0; m < 4; ++m) { Nt[m] = Nn[m]; Af[m][0] = An[m][0]; Af[m][1] = An[m][1]; }
                    }
#undef RW_SCAN_LOAD
                }
            } else swa_items(zb, PB + P_SINK + L * 4, mix, bx - 52, G - 52, lds, tid);
        }
        DUP_END();
        DUP_BEGIN(L * 100 + 4)
        {
            PHASE_IDS();
            const int j = vcu >> 2, hd = vcu & 3, cb = 16 * j, ce = cb + 16;
            if (wave < 4) {
                RwkvSeqArgs sa; sa.pack = ws + WS_RWPACK; sa.raw = raw; f32x4 St[4];
                const float* o = sst + ((size_t)((8 + hd) * 64 + j)) * 4096 + (wave * 4 * 64 + lane) * 4;
#pragma unroll
                for (int m = 0; m < 4; ++m) St[m] = *(const GAS f32x4*)(o + m * 256);
                rwkv_seq_wave<2>(sa, hd, wave, cb, ce, St, lane);
            } else {
                const int vb = wave - 4; f32x4 S[4], Dp[4];
                {
                    GlaSeqArgs sa; sa.pack = ws + WS_GLPACK; sa.raw = raw; const float* o = sst + ((size_t)(hd * 64 + j)) * 4096 + (vb * 4 * 64 + lane) * 4;
#pragma unroll
                    for (int m = 0; m < 4; ++m) { S[m] = (m < 2) ? *(const GAS f32x4*)(o + m * 256) : (f32x4){0.f, 0.f, 0.f, 0.f}; Dp[m] = S[m]; }
                    gla_seq_wave<0, true>(sa, hd, vb, cb, ce, S, Dp, lane);
                }
                {
                    GlaSeqArgs sa; sa.pack = ws + WS_HGPACK; sa.raw = raw; const float* o = sst + ((size_t)((4 + hd) * 64 + j)) * 4096 + (vb * 4 * 64 + lane) * 4;
#pragma unroll
                    for (int m = 0; m < 4; ++m) { S[m] = *(const GAS f32x4*)(o + m * 256); Dp[m] = S[m]; }
                    gla_seq_wave<1, true>(sa, hd, vb, cb, ce, S, Dp, lane);
                }
            }
        }
        DUP_END();
        DUP_BEGIN(L * 100 + 5)
        {
            PHASE_IDS(); MixPostArgs mp; mp.raw = (const float*)(ws + WS_RAW); mp.z = zb; mp.P = PB; mp.g = (const bf16*)(ws + WS_GOUT); mp.v = (const bf16*)(ws + WS_VOUT); mp.bc = (const float*)(ws + WS_BC); mp.mix = mix; mp.layer = L; mp.pad = 0;
            mix_post_items(mp, gw, NGW, lane);
        }
        DUP_END();
        }
        if constexpr (DO_POST) {
        DUP_BEGIN(L * 100 + 6)
        {
            pg8::Gemm g{mix, (const bf16*)(ws + (L == 0 ? WS_WOUT0 : WS_WOUT1)), T, D, D}; pg8::StaticOrder S; S.init(T, D, G, bx);
            pg8::EpiResF32 E{xres, preln, D, ALPHA};
            pg8::gemm_phase<pg8::EpiResF32, pg8::StaticOrder, PG8_ALIGN, PG8_SP2>(lds, g, S, E);
        }
        DUP_END();
        DUP_BEGIN(L == 0 ? 7 : -77)
        {
            PHASE_IDS(); LnArgs la{}; la.src = preln; la.gam = PB + P_LN1G + L * D; la.bet = PB + P_LN1B + L * D; la.xout = xf; la.xb = xb_in; la.mode = 0;
            la.route = (L == 1); la.router = PB + P_ROUTER; la.top_e = top_e; la.top_gw = top_g; la.cnt = ctl + CW_MOE;
            ln_rows(la, gw, NGW, lane);
        }
        DUP_END();
        if constexpr (L == 0) {
        DUP_BEGIN(L * 100 + 8)
            {
                pg8::Gemm g{xb_in, (const bf16*)(ws + WS_FGU), T, 2 * DFF, D}; pg8::StaticOrder S; S.init(T, 2 * DFF, G, bx);
                pg8::EpiSwiglu E{(bf16*)(ws + WS_HD), DFF};
                pg8::gemm_phase<pg8::EpiSwiglu, pg8::StaticOrder, PG8_ALIGN, PG8_SP2>(lds, g, S, E);
            }
            DUP_END();
        DUP_BEGIN(L * 100 + 9)
            {
                pg8::Gemm g{(const bf16*)(ws + WS_HD), (const bf16*)(ws + WS_FD), T, D, DFF}; pg8::StaticOrder S; S.init(T, D, G, bx);
                pg8::EpiResF32 E{xf, preln, D, ALPHA};
                pg8::gemm_phase<pg8::EpiResF32, pg8::StaticOrder, PG8_ALIGN, PG8_SP2>(lds, g, S, E);
            }
            DUP_END();
            {
                PHASE_IDS(); LnArgs la{}; la.src = preln; la.gam = PB + P_LN2G + L * D; la.bet = PB + P_LN2B + L * D; la.xout = xf; la.xb = xb_in; la.mode = 0; la.route = 0;
                ln_rows(la, gw, NGW, lane);
            }
        } else {
            int start[NE + 1]; int nrt;
            {
                PHASE_IDS();
                int off = 0;
#pragma unroll
                for (int e = 0; e < NE; ++e) { start[e] = off; const int c = (int)__hip_atomic_load(ctl + CW_MOE + e, RLX_AGENT); off += (c + 255) / 256 * 256; }
                start[NE] = off; nrt = off / 256;
                if (bx == 0 && tid < MOE_MAXTILES) { int e = 0;
#pragma unroll
                    for (int q = 1; q < NE; ++q) if (tid * 256 >= start[q]) e = q;
                    tile_e[tid] = e; }
                const int gtid = vcu * (NWAVES * 64) + tid, nth = G * NWAVES * 64;
                for (int i = gtid; i < T * 2; i += nth) { const int e = top_e[i]; const int pos = (int)__hip_atomic_fetch_add(ctl + CW_MOE + 64 + e, 1u, RLX_AGENT);
                    int st = 0;
#pragma unroll
                    for (int q = 0; q < NE; ++q) st = (e == q) ? start[q] : st;
                    const int dest = st + pos; row_tok[dest] = i >> 1; tok_row[i] = dest; }
            }
            GRID_BAR();
            DUP_BEGIN(121)
            {
                PHASE_IDS(); bf16* xg = (bf16*)(ws + WS_XG);
                for (int row = gw; row < nrt * 256; row += NGW) { const int t = row_tok[row];
                    const v4u a = *((const GAS v4u*)(xb_in + (size_t)t * D) + lane), b = *((const GAS v4u*)(xb_in + (size_t)t * D) + 64 + lane);
                    *((GAS v4u*)(xg + (size_t)row * D) + lane) = a; *((GAS v4u*)(xg + (size_t)row * D) + 64 + lane) = b; }
            }
            DUP_END();
#pragma unroll
            for (int hh = 0; hh < 2; ++hh) {
                if (hh == 1) { DUP_BEGIN(125) PHASE_IDS(); moe_weights_half(IN(33), IN(34), IN(35), Wmoegu, Wmoed, 1, gw, NGW, (LAS float*)(lds + wave * 16384), lane); DUP_END(); }
                DUP_BEGIN(122 + 4 * hh)
                {
                    pg8::Gemm g{(const bf16*)(ws + WS_XG), Wmoegu, MOE_MAXROWS, 0, D}; pg8::MoeOrder S{tile_e, nrt, 14, G, bx};
                    pg8::EpiSwiglu E{(bf16*)(ws + WS_HM), DFH};
                    pg8::gemm_phase<pg8::EpiSwiglu, pg8::MoeOrder, PG8_ALIGN, PG8_SP2>(lds, g, S, E);
                }
                DUP_END();
                DUP_BEGIN(123 + 4 * hh)
                {
                    pg8::Gemm g{(const bf16*)(ws + WS_HM), Wmoed, MOE_MAXROWS, 0, DFH}; pg8::MoeOrder S{tile_e, nrt, 4, G, bx};
                    pg8::EpiStoreBf16 E{(bf16*)(ws + (hh == 0 ? WS_Y1 : WS_XG)), D};
                    pg8::gemm_phase<pg8::EpiStoreBf16, pg8::MoeOrder, PG8_ALIGN, PG8_SP2>(lds, g, S, E);
                }
                DUP_END();
            }
            {
                PHASE_IDS(); LnArgs la{}; la.gam = PB + P_LN2G + L * D; la.bet = PB + P_LN2B + L * D; la.xout = xf; la.xb = xb_in; la.mode = 1; la.Y1 = (const bf16*)(ws + WS_Y1); la.Y2 = (const bf16*)(ws + WS_XG);
                la.tok_row = tok_row; la.top_g = top_g; la.route = 0;
                ln_rows(la, gw, NGW, lane);
            }
        }
        GRID_BAR();
        DUP_BEGIN(L * 100 + 11)
        {
            pg8::Gemm g{(const bf16*)(ws + (L == 0 ? WS_PB0 : WS_PB1)), (const bf16*)(ws + (L == 0 ? WS_PP0 : WS_PP1)), T, D, 256}; pg8::StaticOrder S; S.init(T, D, G, bx);
            pg8::EpiStoreBf16 E{(bf16*)(ws + WS_PPO), D};
            pg8::gemm_phase<pg8::EpiStoreBf16, pg8::StaticOrder, PG8_ALIGN, PG8_SP2>(lds, g, S, E);
        }
        DUP_END();
        {
            pg8::Gemm g{xb_in, (const bf16*)(ws + (L == 0 ? WS_PG0 : WS_PG1)), T, D, D}; pg8::StaticOrder S; S.init(T, D, G, bx);
            float osc = 1.f;
            if (DIAG_B >= 0 && L == 1) { const GAS unsigned long long* tsb = (const GAS unsigned long long*)(args.ws + WS_CTL + 262144); const unsigned long long ta = tsb[DIAG_A < 0 ? 63 : DIAG_A], tb = tsb[DIAG_B]; osc = 1.f + (float)(tb - ta) / DIAG_DIV; }
            pg8::EpiPle E{xf, (const bf16*)(ws + WS_PPO), xb_out, D, osc};
            pg8::gemm_phase<pg8::EpiPle, pg8::StaticOrder, PG8_ALIGN, PG8_SP2>(lds, g, S, E);
        }
        }
}
__global__ void __launch_bounds__(NWAVES * 64, 2) mega_fwd(Args args, int seg) {
    extern __shared__ __attribute__((aligned(16))) unsigned char lds_raw[];
    LAS unsigned char* lds = (LAS unsigned char*)lds_raw;
    volatile LAS unsigned* MISC = (volatile LAS unsigned*)(lds + MISC_OFF);
    const int tid = threadIdx.x, lane = tid & 63, wave = __builtin_amdgcn_readfirstlane(tid >> 6);
    const int G = gridDim.x, bx = blockIdx.x; const int vcu = (G % 8 == 0) ? (bx % 8) * (G / 8) + bx / 8 : bx;
    const int gw = vcu * NWAVES + wave, NGW = G * NWAVES;
    unsigned char* ws = args.ws;
    gu32* ctl = (gu32*)(ws + WS_CTL);
    for (int u = tid; u < (LDS_BYTES - RING_BYTES) / 4; u += NWAVES * 64) ((LAS unsigned*)(lds + RING_BYTES))[u] = 0u;
    __syncthreads();
    int nst = 0; if (DIAG_B >= 0 && bx == 0 && tid == 0) ((GAS unsigned long long*)(args.ws + WS_CTL + 262144))[63] = __builtin_amdgcn_s_memrealtime();
    XcdBarrier bar = xcd_barrier_post((unsigned*)(ctl + CW_BAR) + (seg < 0 ? 0 : seg) * XCD_BAR_WORDS, MISC + 8);
    bf16* Wmoegu = (bf16*)(ws + WS_MOEGU); bf16* Wmoed = (bf16*)(ws + WS_MOED);
    bf16* vfirst = (bf16*)(ws + WS_VFIRST);
    bf16* zb = (bf16*)(ws + WS_Z); bf16* mix = (bf16*)(ws + WS_MIX); float* preln = (float*)(ws + WS_PRELN);
    float* gla_logf = (float*)(ws + WS_PREP); float* rwb = (float*)(ws + WS_PREP + 8 * MiB);
    const float* PB = (const float*)(ws + WS_MISC + MS_PARAMS); int* top_e = (int*)(ws + WS_MISC + MS_TOPE); float* top_g = (float*)(ws + WS_MISC + MS_TOPG);
    int* tok_row = (int*)(ws + WS_MISC + MS_TOKROW); int* row_tok = (int*)(ws + WS_MISC + MS_ROWTOK); int* tile_e = (int*)(ws + WS_MISC + MS_TILEE);
    float* xf = args.out;

    {
    DUP_BEGIN(0)
    {
        PHASE_IDS(); LAS float* scr = (LAS float*)(lds + wave * 16384);
        constexpr int I_WIN = 16 * 99, I_VD = 16, I_SQ = 16 * 32, I_FG = 16 * 88, I_FD = 44 * 32, I_PP = 4 * 32;
        constexpr int NIT = 2 * I_WIN + I_VD + 4 * I_SQ + 2 * I_FG + I_FD + 2 * I_PP;
        for (int it = gw; it < NIT; it += NGW) {
            int r = it; const float* src; int ldw, nblocks, ncols, dld, il = 0, rowoff = 0; bf16* dst;
            if (r < I_WIN) { src = IN(2); ldw = PIN; nblocks = 99; ncols = PIN; dst = (bf16*)(ws + WS_WIN0); dld = D; }
            else if ((r -= I_WIN) < I_WIN) { src = IN(2) + (size_t)D * PIN; ldw = PIN; nblocks = 99; ncols = PIN; dst = (bf16*)(ws + WS_WIN1); dld = D; }
            else if ((r -= I_WIN) < I_VD) { src = IN(21); ldw = 8; nblocks = 1; ncols = 8; dst = (bf16*)(ws + WS_WIN1); dld = D; rowoff = PIN; }
            else if ((r -= I_VD) < I_SQ) { src = IN(3); ldw = D; nblocks = 32; ncols = D; dst = (bf16*)(ws + WS_WOUT0); dld = D; }
            else if ((r -= I_SQ) < I_SQ) { src = IN(3) + (size_t)D * D; ldw = D; nblocks = 32; ncols = D; dst = (bf16*)(ws + WS_WOUT1); dld = D; }
            else if ((r -= I_SQ) < I_SQ) { src = IN(37); ldw = D; nblocks = 32; ncols = D; dst = (bf16*)(ws + WS_PG0); dld = D; }
            else if ((r -= I_SQ) < I_SQ) { src = IN(37) + (size_t)D * D; ldw = D; nblocks = 32; ncols = D; dst = (bf16*)(ws + WS_PG1); dld = D; }
            else if ((r -= I_SQ) < I_FG) { src = IN(29); ldw = DFF; nblocks = 88; ncols = DFF; dst = (bf16*)(ws + WS_FGU); dld = D; il = 1; }
            else if ((r -= I_FG) < I_FG) { src = IN(30); ldw = DFF; nblocks = 88; ncols = DFF; dst = (bf16*)(ws + WS_FGU); dld = D; il = 1; rowoff = 128; }
            else if ((r -= I_FG) < I_FD) { src = IN(31); ldw = D; nblocks = 32; ncols = D; dst = (bf16*)(ws + WS_FD); dld = DFF; }
            else if ((r -= I_FD) < I_PP) { src = IN(36); ldw = D; nblocks = 32; ncols = D; dst = (bf16*)(ws + WS_PP0); dld = 256; }
            else { r -= I_PP; src = IN(36) + (size_t)256 * D; ldw = D; nblocks = 32; ncols = D; dst = (bf16*)(ws + WS_PP1); dld = 256; }
            tr_job(src, ldw, nblocks, ncols, dst, dld, il, rowoff, r, scr, lane);
        }
        moe_weights_half(IN(33), IN(34), IN(35), Wmoegu, Wmoed, 0, gw, NGW, scr, lane);
        const size_t gtid = (size_t)vcu * (NWAVES * 64) + tid, nth = (size_t)G * NWAVES * 64;
        for (size_t i = gtid * 8; i < (size_t)(ZLD - PIN) * D; i += nth * 8) *(GAS v4u*)((bf16*)(ws + WS_WIN0) + (size_t)PIN * D + i) = (v4u){0u, 0u, 0u, 0u};
        for (size_t i = gtid * 8; i < (size_t)(ZLD - PIN - 8) * D; i += nth * 8) *(GAS v4u*)((bf16*)(ws + WS_WIN1) + (size_t)(PIN + 8) * D + i) = (v4u){0u, 0u, 0u, 0u};
        cvt_rows(IN(0), (bf16*)(ws + WS_XB0), (size_t)T * D, gtid, nth);
        cvt_rows(IN(1), (bf16*)(ws + WS_PB0), (size_t)T * 256, gtid, nth);
        cvt_rows(IN(1) + (size_t)T * 256, (bf16*)(ws + WS_PB1), (size_t)T * 256, gtid, nth);
        {
            float* PW = (float*)(ws + WS_MISC + MS_PARAMS);
#define CPY(idx, off, n) do { const float* _s = IN(idx); for (int _i = (int)gtid; _i < (n); _i += (int)nth) PW[(off) + _i] = _s[_i]; } while (0)
            CPY(4, P_GKUP, 4096); CPY(5, P_GKB, 256); CPY(6, P_GNW, 128); CPY(7, P_HLB, 512); CPY(8, P_HNW, 128); CPY(9, P_SINK, 8); CPY(10, P_MU, 1664); CPY(11, P_W0, 512);
            CPY(12, P_WUP, 8192); CPY(13, P_A0, 512); CPY(14, P_AUP, 8192); CPY(15, P_GUP, 16384); CPY(16, P_KK, 512); CPY(17, P_KA, 512); CPY(18, P_RK, 512); CPY(19, P_LNXW, 512);
            CPY(20, P_LNXB, 512); CPY(22, P_VMU, 8); CPY(23, P_V0, 256); CPY(24, P_VUP, 2048); CPY(25, P_LN1G, 2048); CPY(26, P_LN1B, 2048); CPY(27, P_LN2G, 2048); CPY(28, P_LN2B, 2048);
            CPY(32, P_ROUTER, 8192);
#undef CPY
            if (bx == 0 && tid < 256) { const float* hl = IN(7); const float a = hl[tid], b = hl[256 + tid]; const float m = fmaxf(a, b); const float ea = __expf(a - m), eb = __expf(b - m); PW[P_LBS + tid] = 0.f; PW[P_LBS + 256 + tid] = eb / (ea + eb); }
        }
        for (int i = (int)gtid; i < MOE_MAXROWS; i += (int)nth) row_tok[i] = 0;
    }
    DUP_END();

    }
    layer_body<0, true, true, true>(args, lds, bar, tid, lane, wave, G, bx, vcu, gw, NGW, nst);
    GRID_BAR();
    layer_body<1, true, true, true>(args, lds, bar, tid, lane, wave, G, bx, vcu, gw, NGW, nst);
}
#undef IN


extern "C" void kernel_launch(void* const* d_in, const int* in_sizes, int n_in, void* d_out, int out_size, void* d_ws, size_t ws_size, hipStream_t stream) {
    static int grid = 0;
    if (grid == 0) {
        if (n_in != 38 || in_sizes[0] != T * D || out_size != T * D || ws_size < WS_END) { fprintf(stderr, "kernel_launch: unexpected problem (n_in %d, in0 %d, out %d, ws %zu < %zu)\n", n_in, n_in > 0 ? in_sizes[0] : -1, out_size, ws_size, (size_t)WS_END); grid = -1; return; }
        int dev = 0, cus = 0, per_cu = 0;
        if (hipGetDevice(&dev) != hipSuccess || hipDeviceGetAttribute(&cus, hipDeviceAttributeMultiprocessorCount, dev) != hipSuccess) { grid = -1; return; }
        if (hipFuncSetAttribute((const void*)mega_fwd, hipFuncAttributeMaxDynamicSharedMemorySize, LDS_BYTES) != hipSuccess) { fprintf(stderr, "kernel_launch: hipFuncSetAttribute failed\n"); grid = -1; return; }
        if (hipOccupancyMaxActiveBlocksPerMultiprocessor(&per_cu, (const void*)mega_fwd, NWAVES * 64, LDS_BYTES) != hipSuccess || per_cu < 1) { fprintf(stderr, "kernel_launch: occupancy query says %d\n", per_cu); per_cu = 1; }
        (void)hipGetLastError();
        grid = cus;
    }
    if (grid < 0) return;
    if (hipMemsetAsync((char*)d_ws + WS_CTL, 0, CTL_BYTES, stream) != hipSuccess) { fprintf(stderr, "kernel_launch: memset failed\n"); return; }
    Args a{};
    for (int i = 0; i < 38; ++i) a.in[i] = (const float*)d_in[i];
    a.out = (float*)d_out; a.ws = (unsigned char*)d_ws;
    int seg = -1; void* kargs[] = {&a, &seg};
    hipError_t e = hipLaunchCooperativeKernel((const void*)mega_fwd, dim3(grid), dim3(NWAVES * 64), kargs, LDS_BYTES, stream);
    if (e != hipSuccess) fprintf(stderr, "kernel_launch: cooperative launch failed: %s (grid %d)\n", hipGetErrorString(e), grid);
}
```

```cpp
#define SUBDUP 0
#define SUBDUP_N 1
#include <hip/hip_runtime.h>
#include <cstdio>
#include <cstdint>
namespace pg8 {
#define PG8_LAS __attribute__((address_space(3)))
typedef unsigned short bf16_t;
typedef short bf16x8 __attribute__((ext_vector_type(8)));
typedef float f32x4 __attribute__((ext_vector_type(4)));
typedef unsigned u32x4 __attribute__((ext_vector_type(4)));
constexpr int BM = 256, BK = 64, HALF = 128, HTB = HALF * BK * 2  , STAGE_BYTES = 8 * HTB, NXCD = 8, WGM = 8;

__host__ __device__ __forceinline__ int lds_byte(int r, int c) { const int st = (r >> 4) * 2 + (c >> 5), rr = r & 15, cc = c & 31, ob = rr * 64 + cc * 2; return st * 1024 + (ob ^ (((ob >> 9) & 1) << 5)); }
__host__ __device__ __forceinline__ void stage_rc(int b, int& R, int& C) { const int st = b / 1024, sb = b % 1024, swz = sb ^ (((sb >> 9) & 1) << 5); R = (st >> 1) * 16 + swz / 64; C = (st & 1) * 32 + (swz % 64) / 2; }
__host__ __device__ __forceinline__ int perm32(int rho) { const int n = rho >> 4, i = rho & 15; return 8 * (i >> 2) + 4 * n + (i & 3); }

struct Unit { int pm, pn, on; };
struct Gemm { const bf16_t* A; const bf16_t* Bt; int M, N, K; };

struct StaticOrder {
    int nM, nN, nwg, G, c;
    __host__ __device__ void init(int M, int N, int G_, int c_) { nM = M / BM; nN = N / BM; nwg = nM * nN; G = G_; c = c_; }
    __host__ __device__ bool next(int i, Unit& u) const {
        const long L = (long)i * G + c; if (L >= nwg) return false;
        int wgid = (int)L; { const int q = nwg / NXCD, r = nwg % NXCD, xcd = wgid % NXCD, off = wgid / NXCD; wgid = (xcd < r ? xcd * (q + 1) : r * (q + 1) + (xcd - r) * q) + off; }
        const int nig = WGM * nN, gid = wgid / nig, fm = gid * WGM, gsz = (nM - fm) < WGM ? (nM - fm) : WGM;
        u.pm = fm + ((wgid % nig) % gsz); u.pn = (wgid % nig) / gsz; u.on = u.pn; return true;
    }
    __device__ __forceinline__ void a_ready(const Unit&) const {}
    __device__ __forceinline__ void done(const Unit&) const {}
};

typedef __bf16 bf16v2_t __attribute__((ext_vector_type(2)));
__device__ __forceinline__ unsigned cvt_pk_bf16(float lo, float hi) { bf16v2_t v; v[0] = (__bf16)lo; v[1] = (__bf16)hi; return __builtin_bit_cast(unsigned, v); }
__device__ __forceinline__ float fast_sigmoid(float x) { return __builtin_amdgcn_rcpf(1.f + __expf(-x)); }
struct EpiStoreBf16 {
    static constexpr bool PERM = true, AFTER_DRAIN = false;
    bf16_t* O; int ldc;
    __device__ __forceinline__ void operator()(const f32x4 (&acc)[2][2][4][2], const Unit& u, int wr, int wc, int fr, int fq) const {
        const int row0 = u.pm * BM + wr * 64 + fr, col0 = u.on * BM + wc * 32 + 8 * fq;
#pragma unroll
        for (int ai = 0; ai < 2; ++ai)
#pragma unroll
            for (int m = 0; m < 4; ++m) { bf16_t* rowp = O + (size_t)(row0 + ai * HALF + m * 16) * ldc + col0;
#pragma unroll
                for (int bj = 0; bj < 2; ++bj) { const f32x4 v0 = acc[ai][bj][m][0], v1 = acc[ai][bj][m][1];
                    u32x4 w; w.x = cvt_pk_bf16(v0[0], v0[1]); w.y = cvt_pk_bf16(v0[2], v0[3]); w.z = cvt_pk_bf16(v1[0], v1[1]); w.w = cvt_pk_bf16(v1[2], v1[3]);
                    *(u32x4*)(rowp + bj * HALF) = w; } }
    }
};
struct EpiResF32 {
    static constexpr bool PERM = false, AFTER_DRAIN = false;
    const float* res; float* out; int ldc; float alpha;
    __device__ __forceinline__ void operator()(const f32x4 (&acc)[2][2][4][2], const Unit& u, int wr, int wc, int fr, int fq) const {
        const int row0 = u.pm * BM + wr * 64 + fr, col0 = u.on * BM + wc * 32 + 4 * fq;
#pragma unroll
        for (int ai = 0; ai < 2; ++ai)
#pragma unroll
            for (int m = 0; m < 4; ++m) { const size_t off = (size_t)(row0 + ai * HALF + m * 16) * ldc + col0;
#pragma unroll
                for (int bj = 0; bj < 2; ++bj)
#pragma unroll
                    for (int n = 0; n < 2; ++n) { const f32x4 r = *(const f32x4*)(res + off + bj * HALF + n * 16); *(f32x4*)(out + off + bj * HALF + n * 16) = r * alpha + acc[ai][bj][m][n]; }
                asm volatile("" ::: "memory"); }
    }
};
struct EpiResBf16 {
    static constexpr bool PERM = true, AFTER_DRAIN = false;
    const float* res; bf16_t* out; int ldc; float alpha;
    __device__ __forceinline__ void operator()(const f32x4 (&acc)[2][2][4][2], const Unit& u, int wr, int wc, int fr, int fq) const {
        const int row0 = u.pm * BM + wr * 64 + fr, col0 = u.on * BM + wc * 32 + 8 * fq;
#pragma unroll
        for (int ai = 0; ai < 2; ++ai)
#pragma unroll
            for (int m = 0; m < 4; ++m) { const size_t off = (size_t)(row0 + ai * HALF + m * 16) * ldc + col0;
#pragma unroll
                for (int bj = 0; bj < 2; ++bj) { const f32x4 r0 = *(const f32x4*)(res + off + bj * HALF), r1 = *(const f32x4*)(res + off + bj * HALF + 4);
                    const f32x4 v0 = r0 * alpha + acc[ai][bj][m][0], v1 = r1 * alpha + acc[ai][bj][m][1];
                    u32x4 w; w.x = cvt_pk_bf16(v0[0], v0[1]); w.y = cvt_pk_bf16(v0[2], v0[3]); w.z = cvt_pk_bf16(v1[0], v1[1]); w.w = cvt_pk_bf16(v1[2], v1[3]);
                    *(u32x4*)(out + off + bj * HALF) = w; }
                asm volatile("" ::: "memory"); }
    }
};
struct EpiSwiglu {
    static constexpr bool PERM = true, AFTER_DRAIN = false;
    bf16_t* H; int ldc;
    __device__ __forceinline__ void operator()(const f32x4 (&acc)[2][2][4][2], const Unit& u, int wr, int wc, int fr, int fq) const {
        const int row0 = u.pm * BM + wr * 64 + fr, col0 = u.on * HALF + wc * 32 + 8 * fq;
#pragma unroll
        for (int ai = 0; ai < 2; ++ai)
#pragma unroll
            for (int m = 0; m < 4; ++m) {
                f32x4 h[2];
#pragma unroll
                for (int n = 0; n < 2; ++n) { const f32x4 g = acc[ai][0][m][n], up = acc[ai][1][m][n];
#pragma unroll
                    for (int i = 0; i < 4; ++i) h[n][i] = g[i] * fast_sigmoid(g[i]) * up[i]; }
                u32x4 w; w.x = cvt_pk_bf16(h[0][0], h[0][1]); w.y = cvt_pk_bf16(h[0][2], h[0][3]); w.z = cvt_pk_bf16(h[1][0], h[1][1]); w.w = cvt_pk_bf16(h[1][2], h[1][3]);
                *(u32x4*)(H + (size_t)(row0 + ai * HALF + m * 16) * ldc + col0) = w; }
    }
};
struct EpiPle {
    static constexpr bool PERM = false, AFTER_DRAIN = false;
    float* x; const bf16_t* pp; bf16_t* xbo; int ldc; float oscale;
    __device__ __forceinline__ void operator()(const f32x4 (&acc)[2][2][4][2], const Unit& u, int wr, int wc, int fr, int fq) const {
        typedef unsigned u32x2v __attribute__((ext_vector_type(2)));
        const int row0 = u.pm * BM + wr * 64 + fr, col0 = u.on * BM + wc * 32 + 4 * fq;
#pragma unroll
        for (int ai = 0; ai < 2; ++ai)
#pragma unroll
            for (int m = 0; m < 4; ++m) { const size_t off = (size_t)(row0 + ai * HALF + m * 16) * ldc + col0;
#pragma unroll
                for (int bj = 0; bj < 2; ++bj)
#pragma unroll
                    for (int n = 0; n < 2; ++n) { const size_t o = off + bj * HALF + n * 16;
                        const f32x4 xv = *(const f32x4*)(x + o); const u32x2v pw = *(const u32x2v*)(pp + o); const f32x4 a = acc[ai][bj][m][n];
                        f32x4 pv; pv[0] = __uint_as_float(pw.x << 16); pv[1] = __uint_as_float(pw.x & 0xffff0000u); pv[2] = __uint_as_float(pw.y << 16); pv[3] = __uint_as_float(pw.y & 0xffff0000u);
                        f32x4 xn;
#pragma unroll
                        for (int i = 0; i < 4; ++i) xn[i] = (xv[i] + fast_sigmoid(a[i]) * pv[i]) * oscale;
                        *(f32x4*)(x + o) = xn; if (xbo) { u32x2v w; w.x = cvt_pk_bf16(xn[0], xn[1]); w.y = cvt_pk_bf16(xn[2], xn[3]); *(u32x2v*)(xbo + o) = w; } }
                asm volatile("" ::: "memory"); }
    }
};
struct MoeOrder {
    const int* tile_e; int nrt, ncol, G, c;
    __device__ __forceinline__ bool next(int i, Unit& u) const {
        const int L = i * G + c; if (L >= nrt * ncol) return false;
        const int rt = L / ncol, cn = L - rt * ncol; const int e = tile_e[rt];
        u.pm = rt; u.pn = e * ncol + cn; u.on = cn; return true;
    }
    __device__ __forceinline__ void a_ready(const Unit&) const {}
    __device__ __forceinline__ void done(const Unit&) const {}
};

template <class Epi, class Sched, bool ALIGN_EPI = false, bool SP2 = false>
__device__ __forceinline__ void gemm_phase(PG8_LAS unsigned char* lds, const Gemm g, const Sched& S, const Epi& E) {
    int tid_ = threadIdx.x; asm volatile("" : "+v"(tid_));
    const int tid = tid_, wid = __builtin_amdgcn_readfirstlane(tid >> 6), lane = tid & 63, wr = wid >> 2, wc = wid & 3, fr = lane & 15, fq = lane >> 4;
    const int K = g.K, nt = K / BK;
    unsigned voffA[2], voffB[2];
#pragma unroll
    for (int i = 0; i < 2; ++i) { int R, C; stage_rc(tid * 16 + i * 8192, R, C); const int Rb = Epi::PERM ? ((R & ~31) + perm32(R & 31)) : R;
        voffA[i] = (unsigned)(R * K + C) * 2u; voffB[i] = (unsigned)(Rb * K + C) * 2u; }
    const size_t kstep = (size_t)(BK * 2);
    const size_t hstep = (size_t)HALF * K * 2;
    const size_t tstep = 2 * hstep;
    const unsigned ldsw = (unsigned)wid * 1024u;
    const int aoff = lds_byte(wr * 64 + fr, fq * 8), boff = lds_byte(wc * 32 + fr, fq * 8);
#define PG8_SA(b, h) (((b) * 2 + (h)) * HTB)
#define PG8_SB(b, h) ((4 + (b) * 2 + (h)) * HTB)
#define PG8_STAGE(bufoff, gbase, voff) do { _Pragma("unroll") for (int _i = 0; _i < 2; ++_i) \
        __builtin_amdgcn_global_load_lds((const unsigned*)((const char*)(gbase) + (voff)[_i]), (PG8_LAS unsigned*)(lds + (bufoff) + ldsw + _i * 8192), 16, 0, 0); } while (0)
#define PG8_LDA(dst, b, h) do { _Pragma("unroll") for (int m = 0; m < 4; ++m) _Pragma("unroll") for (int k = 0; k < 2; ++k) dst[m][k] = *(const PG8_LAS bf16x8*)(lds + PG8_SA(b, h) + aoff + m * 2048 + k * 1024); } while (0)
#define PG8_LDB(dst, b, h) do { _Pragma("unroll") for (int n = 0; n < 2; ++n) _Pragma("unroll") for (int k = 0; k < 2; ++k) dst[n][k] = *(const PG8_LAS bf16x8*)(lds + PG8_SB(b, h) + boff + n * 2048 + k * 1024); } while (0)
#define PG8_MMA(ai, bj, At, Bt) do { __builtin_amdgcn_s_setprio(1); _Pragma("unroll") for (int m = 0; m < 4; ++m) _Pragma("unroll") for (int n = 0; n < 2; ++n) _Pragma("unroll") for (int k = 0; k < 2; ++k) \
        acc[ai][bj][m][n] = __builtin_amdgcn_mfma_f32_16x16x32_bf16(Bt[n][k], At[m][k], acc[ai][bj][m][n], 0, 0, 0); __builtin_amdgcn_s_setprio(0); } while (0)
#define PG8_WAIT_V(n) asm volatile("s_waitcnt vmcnt(" #n ")" ::: "memory")
#define PG8_WAIT_L(n) asm volatile("s_waitcnt lgkmcnt(" #n ")" ::: "memory")
#define PG8_BAR __builtin_amdgcn_s_barrier()
#define PG8_SCHED __builtin_amdgcn_sched_barrier(0)
    Unit cur, nxt; int ui = 0;
    if (!S.next(0, cur)) return;
    f32x4 acc[2][2][4][2];
#pragma unroll
    for (int a = 0; a < 2; ++a)
#pragma unroll
        for (int b = 0; b < 2; ++b)
#pragma unroll
            for (int m = 0; m < 4; ++m)
#pragma unroll
                for (int n = 0; n < 2; ++n) acc[a][b][m][n] = (f32x4){0.f, 0.f, 0.f, 0.f};
    bf16x8 At[4][2], B0[2][2], B1[2][2];
    const char* cA = (const char*)g.A + (size_t)cur.pm * tstep; const char* cB = (const char*)g.Bt + (size_t)cur.pn * tstep;
    S.a_ready(cur);
    if constexpr (SP2) {
        PG8_STAGE(PG8_SB(0, 0), cB, voffB); PG8_STAGE(PG8_SB(0, 1), cB + hstep, voffB); PG8_STAGE(PG8_SA(0, 0), cA, voffA); PG8_STAGE(PG8_SA(0, 1), cA + hstep, voffA);
        if (wr == 1) PG8_BAR;
        PG8_WAIT_V(2); PG8_BAR;
        PG8_STAGE(PG8_SB(1, 0), cB + kstep, voffB); PG8_STAGE(PG8_SA(1, 0), cA + kstep, voffA); PG8_STAGE(PG8_SB(1, 1), cB + hstep + kstep, voffB);
        PG8_WAIT_V(6); PG8_BAR;
    } else {
        PG8_STAGE(PG8_SB(0, 0), cB, voffB); PG8_STAGE(PG8_SA(0, 0), cA, voffA); PG8_STAGE(PG8_SB(0, 1), cB + hstep, voffB); PG8_STAGE(PG8_SA(0, 1), cA + hstep, voffA);
        if (wr == 1) PG8_BAR;
        PG8_WAIT_V(4); PG8_BAR;
        PG8_STAGE(PG8_SB(1, 0), cB + kstep, voffB); PG8_STAGE(PG8_SA(1, 0), cA + kstep, voffA); PG8_STAGE(PG8_SB(1, 1), cB + hstep + kstep, voffB);
        PG8_WAIT_V(6); PG8_BAR;
    }
    for (;;) {
        const bool has_next = S.next(ui + 1, nxt);
        const char* nA = has_next ? (const char*)g.A + (size_t)nxt.pm * tstep : cA; const char* nB = has_next ? (const char*)g.Bt + (size_t)nxt.pn * tstep : cB;
        for (int t = 0; t < nt; t += 2) {
            const bool last = (t == nt - 2);
            const char* a1 = cA + (size_t)(t + 1) * kstep;
            const char* a2 = last ? nA : cA + (size_t)(t + 2) * kstep; const char* b2 = last ? nB : cB + (size_t)(t + 2) * kstep;
            const char* a3 = a2 + kstep; const char* b3 = b2 + kstep;
            if (last && has_next) S.a_ready(nxt);
            if constexpr (SP2) {
            PG8_LDB(B0, 0, 0); PG8_LDB(B1, 0, 1); PG8_SCHED; PG8_LDA(At, 0, 0); PG8_STAGE(PG8_SA(1, 1), a1 + hstep, voffA);
            PG8_WAIT_V(8); PG8_WAIT_L(0); PG8_BAR; PG8_MMA(0, 0, At, B0); PG8_MMA(0, 1, At, B1); PG8_BAR; PG8_SCHED;
            PG8_LDA(At, 0, 1); PG8_STAGE(PG8_SB(0, 0), b2, voffB); PG8_STAGE(PG8_SB(0, 1), b2 + hstep, voffB); PG8_STAGE(PG8_SA(0, 0), a2, voffA);
            PG8_WAIT_V(8); PG8_WAIT_L(0); PG8_BAR; PG8_MMA(1, 0, At, B0); PG8_MMA(1, 1, At, B1); PG8_BAR; PG8_SCHED;
            PG8_LDB(B0, 1, 0); PG8_LDB(B1, 1, 1); PG8_SCHED; PG8_LDA(At, 1, 0); PG8_STAGE(PG8_SA(0, 1), a2 + hstep, voffA);
            PG8_WAIT_V(8); PG8_WAIT_L(0); PG8_BAR; PG8_MMA(0, 0, At, B0); PG8_MMA(0, 1, At, B1); PG8_BAR; PG8_SCHED;
            PG8_LDA(At, 1, 1); PG8_STAGE(PG8_SB(1, 0), b3, voffB); PG8_STAGE(PG8_SB(1, 1), b3 + hstep, voffB); PG8_STAGE(PG8_SA(1, 0), a3, voffA);
            PG8_WAIT_V(8); PG8_WAIT_L(0); PG8_BAR; PG8_MMA(1, 0, At, B0); PG8_MMA(1, 1, At, B1); PG8_BAR; PG8_SCHED;
            } else {
            PG8_LDB(B0, 0, 0); PG8_SCHED; PG8_LDA(At, 0, 0); PG8_STAGE(PG8_SA(1, 1), a1 + hstep, voffA);
            PG8_WAIT_L(8); PG8_BAR; PG8_WAIT_L(0); PG8_MMA(0, 0, At, B0); PG8_BAR; PG8_SCHED;
            PG8_LDB(B1, 0, 1); PG8_STAGE(PG8_SB(0, 0), b2, voffB);
            PG8_BAR; PG8_WAIT_L(0); PG8_MMA(0, 1, At, B1); PG8_BAR;
            PG8_LDA(At, 0, 1); PG8_STAGE(PG8_SA(0, 0), a2, voffA);
            PG8_BAR; PG8_WAIT_L(0); PG8_MMA(1, 0, At, B0); PG8_BAR; PG8_SCHED;
            PG8_STAGE(PG8_SB(0, 1), b2 + hstep, voffB);
            PG8_WAIT_V(6); PG8_BAR; PG8_MMA(1, 1, At, B1); PG8_BAR;
            PG8_LDB(B0, 1, 0); PG8_SCHED; PG8_LDA(At, 1, 0); PG8_STAGE(PG8_SA(0, 1), a2 + hstep, voffA);
            PG8_WAIT_L(8); PG8_BAR; PG8_WAIT_L(0); PG8_MMA(0, 0, At, B0); PG8_BAR; PG8_SCHED;
            PG8_LDB(B1, 1, 1); PG8_STAGE(PG8_SB(1, 0), b3, voffB);
            PG8_BAR; PG8_WAIT_L(0); PG8_MMA(0, 1, At, B1); PG8_BAR;
            PG8_LDA(At, 1, 1); PG8_STAGE(PG8_SA(1, 0), a3, voffA);
            PG8_BAR; PG8_WAIT_L(0); PG8_MMA(1, 0, At, B0); PG8_BAR; PG8_SCHED;
            PG8_STAGE(PG8_SB(1, 1), b3 + hstep, voffB);
            PG8_WAIT_V(6); PG8_BAR; PG8_MMA(1, 1, At, B1); PG8_BAR;
            }
        }
        if constexpr (ALIGN_EPI) { if (wr == 0) PG8_BAR; }
        if constexpr (!Epi::AFTER_DRAIN) { E(acc, cur, wr, wc, fr, fq); S.done(cur); }
        if (!has_next) break;
#pragma unroll
        for (int a = 0; a < 2; ++a)
#pragma unroll
            for (int b = 0; b < 2; ++b)
#pragma unroll
                for (int m = 0; m < 4; ++m)
#pragma unroll
                    for (int n = 0; n < 2; ++n) acc[a][b][m][n] = (f32x4){0.f, 0.f, 0.f, 0.f};
        cur = nxt; cA = nA; cB = nB; ++ui;
        if constexpr (ALIGN_EPI) { if (wr == 1) PG8_BAR; }
    }
    PG8_WAIT_V(0);
    if constexpr (!ALIGN_EPI) { if (wr == 0) PG8_BAR; }
    PG8_BAR;
    if constexpr (Epi::AFTER_DRAIN) { E.fused(acc, cur, wr, wc, fr, fq, lds, wid, lane); S.done(cur); }
#undef PG8_SA
#undef PG8_SB
#undef PG8_STAGE
#undef PG8_LDA
#undef PG8_LDB
#undef PG8_MMA
#undef PG8_WAIT_V
#undef PG8_WAIT_L
#undef PG8_BAR
#undef PG8_SCHED
}
}

#ifndef MEGA_ALL
#define MEGA_ALL 0
#endif
#define PG8_SP2 true
#define PG8_ALIGN true
constexpr int NWAVES = 8;
constexpr int T = 16384, D = 1024, GW = 256, PIN = 3152, ZLD = 3328;
constexpr int DFF = 2816, NE = 8, DFE = 3584, DFH = 1792;
constexpr int MOE_MAXTILES = 136, MOE_MAXROWS = MOE_MAXTILES * 256;
constexpr float LN_EPS = 1e-5f, RMS_EPS = 1e-6f, GN_EPS = 64e-5f;
constexpr float ALPHA = 1.4142135623730951f;
constexpr int Z_GQ = 0, Z_GK = 128, Z_GV = 256, Z_GG = 512, Z_GGK = 768, Z_HQ = 784, Z_HF = 1040, Z_HI = 1296, Z_HG = 1552,
              Z_SQ = 1808, Z_SK = 2064, Z_SV = 2192, Z_RZ = 2320, Z_VD = 3152;
constexpr size_t MiB = 1u << 20;
constexpr size_t WS_MOEGU = 0, WS_MOED = 56 * MiB;
constexpr size_t WS_WIN0 = 84 * MiB, WS_WIN1 = WS_WIN0 + (size_t)ZLD * D * 2, WS_WOUT0 = 97 * MiB, WS_WOUT1 = 99 * MiB, WS_FGU = 101 * MiB, WS_FD = 112 * MiB,
                 WS_PG0 = 117 * MiB + 512 * 1024, WS_PG1 = WS_PG0 + 2 * MiB, WS_PP0 = WS_PG1 + 2 * MiB, WS_PP1 = WS_PP0 + 512 * 1024;
constexpr size_t WS_XB0 = 123 * MiB, WS_XB1 = 155 * MiB, WS_VFIRST = 187 * MiB, WS_PB0 = 203 * MiB, WS_PB1 = 211 * MiB, WS_MISC = 219 * MiB, WS_CTL = 222 * MiB, CTL_BYTES = 1 * MiB;
constexpr size_t WS_R = 224 * MiB;
constexpr size_t WS_Z = WS_R, WS_MIX = WS_R + 104 * MiB, WS_PREP = WS_R + 136 * MiB, WS_PRELN = WS_R + 136 * MiB;
constexpr size_t WS_HD = WS_R, WS_HM = WS_R, WS_XG = WS_R + 119 * MiB, WS_Y1 = WS_R + 187 * MiB, WS_PPO = WS_R;
constexpr size_t WS_RWPACK = WS_XB0;
constexpr size_t WS_GLPACK = WS_PREP, WS_HGPACK = WS_PREP + 20 * MiB, WS_RAW = WS_PREP + 68 * MiB, WS_GOUT = WS_PREP + 116 * MiB, WS_VOUT = WS_PREP + 124 * MiB, WS_BC = WS_PREP + 132 * MiB;
constexpr size_t WS_SST = WS_PREP + 133 * MiB, WS_MT = WS_PREP + 145 * MiB;
constexpr size_t MS_DSC = 1536 * 1024;
constexpr size_t WS_END = 480 * MiB + 27 * MiB;
static_assert(WS_MT + 2 * MiB <= WS_END && MS_DSC + 131072 <= 3 * MiB, "scan map");
static_assert(WS_XB1 == WS_XB0 + 32 * MiB && WS_VFIRST == WS_XB1 + 32 * MiB && WS_BC + 1 * MiB <= WS_END, "mixer scratch map");
static_assert(WS_WIN1 + (size_t)ZLD * D * 2 <= WS_WOUT0 && WS_PP1 + 512 * 1024 <= WS_XB0, "weights map");
static_assert(WS_HM + (size_t)MOE_MAXROWS * DFH * 2 <= WS_XG && WS_XG + (size_t)MOE_MAXROWS * D * 2 <= WS_Y1 && WS_Y1 + (size_t)MOE_MAXROWS * D * 2 <= WS_END, "moe map");
static_assert(WS_PREP + 120 * MiB <= WS_END && WS_Z + (size_t)T * ZLD * 2 <= WS_MIX, "mixer map");
constexpr size_t MS_TOPE = 65536, MS_TOPG = MS_TOPE + 131072, MS_TOKROW = MS_TOPG + 131072, MS_ROWTOK = MS_TOKROW + 131072, MS_TILEE = MS_ROWTOK + 196608;
constexpr size_t MS_PARAMS = 1 * MiB;
constexpr int P_GKUP = 0, P_GKB = P_GKUP + 2 * 2048, P_GNW = P_GKB + 2 * 128, P_HLB = P_GNW + 2 * 64, P_HNW = P_HLB + 2 * 256, P_SINK = P_HNW + 2 * 64, P_MU = P_SINK + 8,
              P_W0 = P_MU + 2 * 832, P_WUP = P_W0 + 2 * 256, P_A0 = P_WUP + 2 * 4096, P_AUP = P_A0 + 2 * 256, P_GUP = P_AUP + 2 * 4096, P_KK = P_GUP + 2 * 8192, P_KA = P_KK + 2 * 256,
              P_RK = P_KA + 2 * 256, P_LNXW = P_RK + 2 * 256, P_LNXB = P_LNXW + 2 * 256, P_VMU = P_LNXB + 2 * 256, P_V0 = P_VMU + 8, P_VUP = P_V0 + 256, P_LN1G = P_VUP + 2048,
              P_LN1B = P_LN1G + 2048, P_LN2G = P_LN1B + 2048, P_LN2B = P_LN2G + 2048, P_ROUTER = P_LN2B + 2048, P_LBS = P_ROUTER + 8192, P_END = P_LBS + 512;
static_assert(P_END * 4 <= 1 * MiB, "params block");
constexpr int CW_BAR = 4096, CW_MOE = 16384;
constexpr int LDS_BYTES = 147456, RING_BYTES = 131072, MISC_OFF = RING_BYTES + 320;

#define GAS __attribute__((address_space(1)))
#define LAS __attribute__((address_space(3)))
typedef unsigned short bf16;
typedef unsigned v4u __attribute__((ext_vector_type(4)));
typedef unsigned v2u __attribute__((ext_vector_type(2)));
typedef float f32x4 __attribute__((ext_vector_type(4)));
typedef short bf16x8 __attribute__((ext_vector_type(8)));
typedef GAS unsigned gu32;
#define RLX_AGENT __ATOMIC_RELAXED, __HIP_MEMORY_SCOPE_AGENT
#define LDS_WAIT() asm volatile("s_waitcnt lgkmcnt(0)" ::: "memory")
#define VM_WAIT() asm volatile("s_waitcnt vmcnt(0)" ::: "memory")
__device__ __forceinline__ unsigned f2bf(float f) { unsigned u = __builtin_bit_cast(unsigned, f); return (u + 0x7fffu + ((u >> 16) & 1u)) >> 16; }
__device__ __forceinline__ unsigned pk2(float lo, float hi) { return f2bf(lo) | (f2bf(hi) << 16); }
__device__ __forceinline__ float bf2f(unsigned short b) { return __uint_as_float(((unsigned)b) << 16); }
__device__ __forceinline__ float rcpf_(float x) { return __builtin_amdgcn_rcpf(x); }
__device__ __forceinline__ float sigmoidf_(float x) { return rcpf_(1.f + __expf(-x)); }
__device__ __forceinline__ float siluf_(float x) { return x * rcpf_(1.f + __expf(-x)); }
__device__ __forceinline__ float softplusf_(float x) { return fmaxf(x, 0.f) + __logf(1.f + __expf(-fabsf(x))); }
__device__ __forceinline__ float logsigmoidf_(float x) { return -softplusf_(-x); }
__device__ __forceinline__ float tanhf_(float x) { return 1.f - 2.f * rcpf_(1.f + __expf(2.f * x)); }
template <int CTRL> __device__ __forceinline__ float dppf(float v) { return __builtin_bit_cast(float, __builtin_amdgcn_update_dpp(0, __builtin_bit_cast(int, v), CTRL, 0xf, 0xf, false)); }
__device__ __forceinline__ float wave_sum(float v) {
    v += dppf<0x128>(v); v += dppf<0x124>(v); v += dppf<0x122>(v); v += dppf<0x121>(v);
    { float a = v, b = v; asm("s_nop 1\n\tv_permlane16_swap_b32 %0, %1" : "+v"(a), "+v"(b)); v = a + b; }
    { float a = v, b = v; asm("s_nop 1\n\tv_permlane32_swap_b32 %0, %1" : "+v"(a), "+v"(b)); v = a + b; }
    return v;
}
__device__ __forceinline__ float wave_max(float v) {
    v = fmaxf(v, dppf<0x128>(v)); v = fmaxf(v, dppf<0x124>(v)); v = fmaxf(v, dppf<0x122>(v)); v = fmaxf(v, dppf<0x121>(v));
    { float a = v, b = v; asm("s_nop 1\n\tv_permlane16_swap_b32 %0, %1" : "+v"(a), "+v"(b)); v = fmaxf(a, b); }
    { float a = v, b = v; asm("s_nop 1\n\tv_permlane32_swap_b32 %0, %1" : "+v"(a), "+v"(b)); v = fmaxf(a, b); }
    return v;
}
#define XB_TMO      128
#define XB_XCNT(j)  (256  + 64 * (j))
#define XB_XSUB(j)  (1280 + 64 * (j))
#define XB_XGEN(j)  (2304 + 64 * (j))
#define XB_TOP      3328
#define XB_TOPGEN   3392
#define XCD_BAR_WORDS 3456
#define XB_SPIN_CAP (1u << 27)

__device__ __forceinline__ unsigned xb_ld(unsigned* p)              { return __hip_atomic_load(p, __ATOMIC_RELAXED, __HIP_MEMORY_SCOPE_AGENT); }
__device__ __forceinline__ unsigned xb_add(unsigned* p, unsigned v) { return __hip_atomic_fetch_add(p, v, __ATOMIC_RELAXED, __HIP_MEMORY_SCOPE_AGENT); }
__device__ __forceinline__ unsigned xb_xcc_id() { return (unsigned)__builtin_amdgcn_s_getreg((3 << 11) | 20) & 0xFu; }
#define XB_SPIN(cond, bar) do { unsigned _sp = 0; while (cond) { __builtin_amdgcn_s_sleep(1); \
    if ((++_sp & 255u) == 0u) { if (xb_ld(&(bar)[XB_TMO])) break; if (_sp > XB_SPIN_CAP) { atomicAdd(&(bar)[XB_TMO], 1u); break; } } } } while (0)

struct XcdBarrier {
    unsigned* bar; unsigned x;
    volatile LAS unsigned* st;
};

__device__ __forceinline__ XcdBarrier xcd_barrier_post(unsigned* bar, volatile LAS unsigned* st) {
    XcdBarrier b; b.bar = bar; b.x = xb_xcc_id(); b.st = st;
    if (threadIdx.x == 0) (void)xb_add(&bar[XB_XCNT(b.x)], 1u);
    return b;
}
__device__ __forceinline__ void xcd_barrier_complete(unsigned* bar, unsigned x, unsigned& nloc, unsigned& nx) {
    const unsigned G = gridDim.x * gridDim.y * gridDim.z;
    unsigned sum, cnt, mine, sp = 0u;
    for (;;) {
        sum = 0u; cnt = 0u; mine = 0u;
#pragma unroll
        for (unsigned j = 0; j < 16; ++j) { const unsigned c = xb_ld(&bar[XB_XCNT(j)]); sum += c; cnt += (c > 0u) ? 1u : 0u; }
        if (sum == G) break;
        __builtin_amdgcn_s_sleep(1);
        if ((++sp & 255u) == 0u) { if (xb_ld(&bar[XB_TMO])) break; if (sp > XB_SPIN_CAP) { atomicAdd(&bar[XB_TMO], 1u); break; } }
    }
    mine = xb_ld(&bar[XB_XCNT(x)]);
    nloc = mine > 0u ? mine : 1u; nx = cnt > 0u ? cnt : 1u;
}

__device__ __forceinline__ void xcd_barrier(const XcdBarrier& b) {
    asm volatile("s_waitcnt vmcnt(0)" ::: "memory");
    __syncthreads();
    if (threadIdx.x == 0) {
        unsigned* bar = b.bar;
        __builtin_amdgcn_s_waitcnt(0);
        unsigned nloc = b.st[0], nx = b.st[1];
        if (nloc == 0u) { xcd_barrier_complete(bar, b.x, nloc, nx); b.st[0] = nloc; b.st[1] = nx; }
        const unsigned old = xb_add(&bar[XB_XSUB(b.x)], 1u);
        const unsigned gen = old / nloc;
        if (old + 1u == (gen + 1u) * nloc) {
            __builtin_amdgcn_fence(__ATOMIC_RELEASE, "agent");
            asm volatile("s_waitcnt vmcnt(0)" ::: "memory");
            const unsigned og = xb_add(&bar[XB_TOP], 1u);
            const unsigned tg = og / nx;
            if (og + 1u == (tg + 1u) * nx) xb_add(&bar[XB_TOPGEN], 1u);
            else XB_SPIN(xb_ld(&bar[XB_TOPGEN]) == tg, bar);
            __builtin_amdgcn_fence(__ATOMIC_ACQUIRE, "agent");
            xb_add(&bar[XB_XGEN(b.x)], 1u);
            asm volatile("s_waitcnt vmcnt(0)" ::: "memory");
        } else {
            XB_SPIN(xb_ld(&bar[XB_XGEN(b.x)]) == gen, bar);
            __builtin_amdgcn_fence(__ATOMIC_ACQUIRE, "agent");
            asm volatile("s_waitcnt vmcnt(0)" ::: "memory");
        }
    }
    __syncthreads();
}

#ifndef SUBDUP
#define SUBDUP 0
#define SUBDUP_N 1
#endif
#define SUBREP(id) _Pragma("unroll 1") for (int srep_ = 0; srep_ < ((SUBDUP == (id)) ? SUBDUP_N : 1); ++srep_)
constexpr int RW_PACK = 14336;
constexpr int RW_AHAT = 0, RW_W2 = 2048, RW_S2A = 4096, RW_V = 8192, RW_R = 10240, RW_ARK = 12288, RW_P = 13312;
constexpr int RWL_BYTES = 21504;
typedef __bf16 bf16v2_t __attribute__((ext_vector_type(2)));
__device__ __forceinline__ unsigned cvt_pk(float lo, float hi) { bf16v2_t v; v[0] = (__bf16)lo; v[1] = (__bf16)hi; return __builtin_bit_cast(unsigned, v); }
__device__ __forceinline__ bf16x8 pack8(const f32x4& a, const f32x4& b) { v4u p; p.x = cvt_pk(a[0], a[1]); p.y = cvt_pk(a[2], a[3]); p.z = cvt_pk(b[0], b[1]); p.w = cvt_pk(b[2], b[3]); return __builtin_bit_cast(bf16x8, p); }
__device__ __forceinline__ bf16x8 pack8u(const f32x4& a, v2u vb) { v4u p; p.x = cvt_pk(a[0], a[1]); p.y = cvt_pk(a[2], a[3]); p.z = vb.x; p.w = vb.y; return __builtin_bit_cast(bf16x8, p); }
__device__ __forceinline__ bf16x8 frag2(v2u a, v2u b) { v4u p; p.x = a.x; p.y = a.y; p.z = b.x; p.w = b.y; return __builtin_bit_cast(bf16x8, p); }
#define MFMA16(a, b, c) __builtin_amdgcn_mfma_f32_16x16x32_bf16((a), (b), (c), 0, 0, 0)

struct RwkvPrepArgs { const bf16* z; const float* P; bf16* vfirst; unsigned char* pack; bf16* gout; bf16* vout; float* bcout; };
template <int L>
__device__ __forceinline__ void rwkv_prep_wave(const RwkvPrepArgs& A, int hd, int c0, int cstride, int cend, LAS unsigned char* wl, int lane) {
    const int col = hd * 64 + lane, lo = lane & 15, h = lane >> 4;
    const float* P = A.P;
    float wup[16], aup[16], vup[8];
#pragma unroll
    for (int i = 0; i < 16; ++i) { wup[i] = P[P_WUP + L * 4096 + i * 256 + col]; aup[i] = P[P_AUP + L * 4096 + i * 256 + col]; }
#pragma unroll
    for (int i = 0; i < 8; ++i) vup[i] = (L > 0) ? P[P_VUP + i * 256 + col] : 0.f;
    const float w0 = P[P_W0 + L * 256 + col], a0 = P[P_A0 + L * 256 + col], kkp = P[P_KK + L * 256 + col], kap = P[P_KA + L * 256 + col], rkp = P[P_RK + L * 256 + col];
    const float v0p = (L > 0) ? P[P_V0 + col] : 0.f;
    bf16x8 gupf[4];
#pragma unroll
    for (int n = 0; n < 4; ++n) { v4u w_;
#pragma unroll
        for (int j2 = 0; j2 < 4; ++j2) w_[j2] = pk2(P[P_GUP + L * 8192 + (8 * h + 2 * j2) * 256 + hd * 64 + 16 * n + lo], P[P_GUP + L * 8192 + (8 * h + 2 * j2 + 1) * 256 + hd * 64 + 16 * n + lo]);
        gupf[n] = __builtin_bit_cast(bf16x8, w_); }
    const float mur = P[P_MU + L * 832 + col], muk = P[P_MU + L * 832 + 256 + col], muv = P[P_MU + L * 832 + 512 + col];
    LAS bf16* atX = (LAS bf16*)(wl + 0); LAS bf16* rtX = (LAS bf16*)(wl + 2048); LAS bf16* btX = (LAS bf16*)(wl + 4096); LAS bf16* ktX = (LAS bf16*)(wl + 6144);
    LAS bf16* atT = (LAS bf16*)(wl + 8192); LAS bf16* pbT = (LAS bf16*)(wl + 10240); LAS bf16* pkT = (LAS bf16*)(wl + 12288); LAS bf16* vT = (LAS bf16*)(wl + 14336);
    LAS float* LR = (LAS float*)(wl + 16384); asm volatile("" : "+v"(LR));
    LAS float* Lm = (LAS float*)(wl + 16384); asm volatile("" : "+v"(Lm)); LAS bf16* Tb = (LAS bf16*)(wl + 17472);
    LAS bf16* Gak = (LAS bf16*)(wl + 17984); LAS bf16* Grb = (LAS bf16*)(wl + 18496); LAS bf16* Grk = (LAS bf16*)(wl + 19008);
    const f32x4 z4 = (f32x4){0.f, 0.f, 0.f, 0.f}; const bf16x8 z8 = (bf16x8){0, 0, 0, 0, 0, 0, 0, 0};
    const __amdgpu_buffer_rsrc_t zsrd = __builtin_amdgcn_make_buffer_rsrc((void*)A.z, 0, T * ZLD * 2, 0x00020000);
    const __amdgpu_buffer_rsrc_t vsrd = __builtin_amdgcn_make_buffer_rsrc((void*)A.vfirst, 0, T * 256 * 2, 0x00020000);
    const __amdgpu_buffer_rsrc_t gsrd = __builtin_amdgcn_make_buffer_rsrc((void*)A.gout, 0, T * 256 * 2, 0x00020000);
    LAS bf16* LRraw = (LAS bf16*)(wl + 10240);
    for (int c = c0; c < cend; c += cstride) {
        const int t0 = c * 16;
        int ln = lane; asm volatile("" : "+v"(ln));
        const unsigned zo = (unsigned)((t0 - 1) * ZLD + Z_RZ + col) * 2u;
        SUBREP(1) {
        {
            bf16 rawv[20];
#pragma unroll
            for (int q = 0; q < 20; ++q) { const int e = ln + 64 * q; const int t = e / 72, i = e - t * 72;
                const int zc = (i < 64) ? (Z_RZ + 768 + i) : (Z_VD + i - 64);
                const unsigned bo = (e < 17 * 72 && (i < 64 || L > 0)) ? (unsigned)((t0 + t - 1) * ZLD + zc) * 2u : 0xfffffff0u;
                rawv[q] = (bf16)__builtin_amdgcn_raw_buffer_load_b16(zsrd, bo, 0, 0); }
#pragma unroll
            for (int q = 0; q < 20; ++q) { const int e = ln + 64 * q; if (e < 17 * 72) LRraw[e] = rawv[q]; }
        }
        LDS_WAIT(); asm volatile("" ::: "memory");
#pragma unroll 2
        for (int q = 0; q < 18; ++q) {
            const int e = ln + 64 * q, t = e / 72, i = e - t * 72;
            const float cur = bf2f(LRraw[e + 72]), prev = bf2f(LRraw[e]);
            const float m = (i < 64) ? P[P_MU + L * 832 + 768 + i] : P[P_VMU + i - 64];
            float val = cur + (prev - cur) * m;
            if (i < 16) val = tanhf_(val); else if (i >= 32 && i < 64) val = sigmoidf_(val);
            LR[e] = val;
        }
        LDS_WAIT(); asm volatile("" ::: "memory");
        }
        SUBREP(2) {
            const LAS float* lg = LR + lo * 72 + 32 + 8 * h;
            v4u aw; aw.x = pk2(lg[0], lg[1]); aw.y = pk2(lg[2], lg[3]); aw.z = pk2(lg[4], lg[5]); aw.w = pk2(lg[6], lg[7]);
            const bf16x8 ga = __builtin_bit_cast(bf16x8, aw);
#pragma unroll
            for (int n = 0; n < 4; ++n) { const f32x4 gc = MFMA16(ga, gupf[n], z4);
#pragma unroll
                for (int r2 = 0; r2 < 4; ++r2) A.gout[(size_t)(t0 + 4 * h + r2) * 256 + hd * 64 + 16 * n + lo] = (bf16)f2bf(gc[r2]); }
        }
        float cum = 0.f, bcv = 0.f;
        const size_t ob = (size_t)t0 * 256 + col;
#define RW_LD3(dst, tt) do { const unsigned o_ = zo + (unsigned)(tt) * (ZLD * 2); dst[0] = (bf16)__builtin_amdgcn_raw_buffer_load_b16(zsrd, o_, 0, 0); dst[1] = (bf16)__builtin_amdgcn_raw_buffer_load_b16(zsrd, o_ + 512, 0, 0); \
            dst[2] = (bf16)__builtin_amdgcn_raw_buffer_load_b16(zsrd, o_ + 1024, 0, 0); dst[3] = (L > 0) ? (bf16)__builtin_amdgcn_raw_buffer_load_b16(vsrd, (unsigned)((t0 + (tt) - 1) * 256 + col) * 2u, 0, 0) : (bf16)0; } while (0)
        bf16 Zr[17][4];
#pragma unroll
        for (int tt = 0; tt < 17; ++tt) RW_LD3(Zr[tt], tt);
#pragma unroll
        for (int tt = 0; tt < 17; ++tt) asm volatile("" : "+v"(Zr[tt][0]), "+v"(Zr[tt][1]), "+v"(Zr[tt][2]), "+v"(Zr[tt][3]));
        float prr, prk, prv;
        SUBREP(3) { cum = 0.f; prr = bf2f(Zr[0][0]); prk = bf2f(Zr[0][1]); prv = bf2f(Zr[0][2]);
#pragma unroll
        for (int tg = 0; tg < 16; tg += 4) {
#pragma unroll
          for (int ti = 0; ti < 4; ++ti) {
            const int t = tg + ti;
            const float cr = bf2f(Zr[t + 1][0]), ck = bf2f(Zr[t + 1][1]), cv = bf2f(Zr[t + 1][2]), vfv = bf2f(Zr[t + 1][3]);
            const float rr = cr + (prr - cr) * mur, kk0 = ck + (prk - ck) * muk; float vv = cv + (prv - cv) * muv;
            prr = cr; prk = ck; prv = cv;
            const LAS float* lr = LR + t * 72;
            float sw = w0, sa = a0;
#pragma unroll
            for (int i = 0; i < 16; ++i) { sw += lr[i] * wup[i]; sa += lr[16 + i] * aup[i]; }
            const float wlog = -softplusf_(-sw) - 0.5f;
            const float lw = -__expf(wlog);
            const float av = sigmoidf_(sa);
            if (L > 0) { float sv = v0p;
#pragma unroll
                for (int i = 0; i < 8; ++i) sv += lr[64 + i] * vup[i];
                vv = vv + (vfv - vv) * sigmoidf_(sv); }
            float kk = kk0 * kkp; const float ss = wave_sum(kk * kk); kk = kk * rsqrtf(fmaxf(ss, 1e-24f));
            const float k2 = kk0 * (1.f + (av - 1.f) * kap);
            const float bc = wave_sum(rr * k2 * rkp);
            bcv = (ln == t) ? bc : bcv;
            const float ea = __expf(cum); cum += lw; const float e = __expf(cum), ei = __expf(-cum);
            const float at = -kk * ea, bt = kk * av * ei, kt = k2 * ei, rt = rr * e;
            atX[t * 64 + lane] = (bf16)f2bf(at); rtX[t * 64 + lane] = (bf16)f2bf(rt); btX[t * 64 + lane] = (bf16)f2bf(bt); ktX[t * 64 + lane] = (bf16)f2bf(kt);
            atT[lane * 16 + t] = (bf16)f2bf(at); vT[lane * 16 + t] = (bf16)f2bf(vv);
          }
        }
        }
#undef RW_LD3
        if (ln < 16) A.bcout[(size_t)(t0 + ln) * 4 + hd] = bcv;
        const float PC = __expf(cum);
        LDS_WAIT(); asm volatile("" ::: "memory");
#pragma unroll 1
        for (int t = 0; t < 16; ++t) { const bf16 vb16 = vT[lane * 16 + t]; A.vout[ob + (size_t)t * 256] = vb16; if (L == 0) A.vfirst[ob + (size_t)t * 256] = vb16; }
#pragma unroll 4
        for (int t = 0; t < 16; ++t) { pbT[lane * 16 + t] = (bf16)f2bf(bf2f(btX[t * 64 + lane]) * PC); pkT[lane * 16 + t] = (bf16)f2bf(bf2f(ktX[t * 64 + lane]) * PC); }
        unsigned char* pk_ = A.pack + ((size_t)c * 4 + hd) * RW_PACK;
        *(float*)(pk_ + RW_P + lane * 4) = PC;
        LDS_WAIT(); asm volatile("" ::: "memory");
        SUBREP(4) {
        f32x4 Gab, Gak_, Grb_, Grk_;
        {
            bf16x8 af[2], rf[2], bq[2], kq[2];
#pragma unroll
            for (int s = 0; s < 2; ++s) { af[s] = *(const LAS bf16x8*)(atX + lo * 64 + 32 * s + 8 * h); rf[s] = *(const LAS bf16x8*)(rtX + lo * 64 + 32 * s + 8 * h);
                bq[s] = *(const LAS bf16x8*)(btX + lo * 64 + 32 * s + 8 * h); kq[s] = *(const LAS bf16x8*)(ktX + lo * 64 + 32 * s + 8 * h); }
            Gab = MFMA16(af[0], bq[0], z4); Gab = MFMA16(af[1], bq[1], Gab);
            Gak_ = MFMA16(af[0], kq[0], z4); Gak_ = MFMA16(af[1], kq[1], Gak_);
            Grb_ = MFMA16(rf[0], bq[0], z4); Grb_ = MFMA16(rf[1], bq[1], Grb_);
            Grk_ = MFMA16(rf[0], kq[0], z4); Grk_ = MFMA16(rf[1], kq[1], Grk_);
        }
#pragma unroll
        for (int r = 0; r < 4; ++r) { const int t = 4 * h + r; const bool sl = lo < t, sle = lo <= t;
            Lm[t * 17 + lo] = sl ? Gab[r] : 0.f; Gak[t * 16 + lo] = (bf16)f2bf(sl ? Gak_[r] : 0.f); Grb[t * 16 + lo] = (bf16)f2bf(sle ? Grb_[r] : 0.f); Grk[t * 16 + lo] = (bf16)f2bf(sle ? Grk_[r] : 0.f); }
        LDS_WAIT(); asm volatile("" ::: "memory");
        {
            float Tc[16];
            const int lo_i = ln & 15;
#pragma unroll
            for (int t = 0; t < 16; ++t) { float acc = (t == lo_i) ? 1.f : 0.f;
#pragma unroll
                for (int s = 0; s < t; ++s) acc += Lm[t * 17 + s] * Tc[s];
                Tc[t] = acc; }
#pragma unroll
            for (int t = 0; t < 16; ++t) Tb[t * 16 + lo] = (bf16)f2bf(Tc[t]);
        }
        LDS_WAIT(); asm volatile("" ::: "memory");
        {
            const bf16x8 Tfr = (h < 2) ? *(const LAS bf16x8*)(Tb + lo * 16 + 8 * h) : z8;
            f32x4 Cm[4];
#pragma unroll
            for (int m = 0; m < 4; ++m) { const bf16x8 Afr = (h < 2) ? *(const LAS bf16x8*)(atT + (16 * m + lo) * 16 + 8 * h) : z8;
                Cm[m] = MFMA16(Afr, Tfr, z4); }
            *(bf16x8*)(pk_ + RW_AHAT + 0 * 1024 + lane * 16) = pack8(Cm[0], Cm[1]);
            *(bf16x8*)(pk_ + RW_AHAT + 1 * 1024 + lane * 16) = pack8(Cm[2], Cm[3]);
        }
        {
            const bf16x8 Gfr = (h < 2) ? *(const LAS bf16x8*)(Gak + lo * 16 + 8 * h) : z8;
            const v2u t4 = *(const LAS v2u*)(Tb + lo * 16 + 4 * h); const bf16x8 T2 = frag2(t4, (v2u){0u, 0u});
#pragma unroll
            for (int vb = 0; vb < 4; ++vb) {
                const bf16x8 Vn = (h < 2) ? *(const LAS bf16x8*)(vT + (16 * vb + lo) * 16 + 8 * h) : z8;
                const f32x4 X = MFMA16(Gfr, Vn, z4);
                const f32x4 W2 = MFMA16(T2, pack8(X, z4), z4);
                { v2u w2p; w2p.x = cvt_pk(W2[0], W2[1]); w2p.y = cvt_pk(W2[2], W2[3]); *(v2u*)(pk_ + RW_W2 + vb * 512 + lane * 8) = w2p; }
                *(v2u*)(pk_ + RW_V + vb * 512 + lane * 8) = *(const LAS v2u*)(vT + (16 * vb + lo) * 16 + 4 * h);
            }
        }
#pragma unroll
        for (int m = 0; m < 4; ++m) *(bf16x8*)(pk_ + RW_S2A + m * 1024 + lane * 16) = frag2(*(const LAS v2u*)(pbT + (16 * m + lo) * 16 + 4 * h), *(const LAS v2u*)(pkT + (16 * m + lo) * 16 + 4 * h));
#pragma unroll
        for (int s = 0; s < 2; ++s) *(bf16x8*)(pk_ + RW_R + s * 1024 + lane * 16) = frag2(*(const LAS v2u*)(rtX + lo * 64 + 32 * s + 4 * h), *(const LAS v2u*)(rtX + lo * 64 + 32 * s + 16 + 4 * h));
        *(bf16x8*)(pk_ + RW_ARK + lane * 16) = frag2(*(const LAS v2u*)(Grb + lo * 16 + 4 * h), *(const LAS v2u*)(Grk + lo * 16 + 4 * h));
        }
        LDS_WAIT(); asm volatile("" ::: "memory");
    }
}

struct PostCtx { LAS float* xbuf; volatile LAS unsigned* cnt; unsigned step; const bf16* z; const float* P; const bf16* g; const bf16* v; const float* bc; bf16* mix; int layer; };
__device__ __forceinline__ void group_sync(PostCtx& pc) {
    LDS_WAIT(); asm volatile("" ::: "memory");
    if ((threadIdx.x & 63) == 0) __hip_atomic_fetch_add((LAS unsigned*)pc.cnt, 1u, __ATOMIC_RELAXED, __HIP_MEMORY_SCOPE_WORKGROUP);
    pc.step += 1; const unsigned want = 4u * pc.step;
    while (*pc.cnt < want) __builtin_amdgcn_s_sleep(0);
    asm volatile("" ::: "memory");
}
struct RwkvSeqArgs { const unsigned char* pack; };
struct RwkvOps { bf16x8 Ah0, Ah1, S2A[4], R0, R1, ARK; f32x4 W2, Pm[4]; v2u Vf; };
template <int MODE>
__device__ __forceinline__ void rwkv_load_ops(RwkvOps& o, const unsigned char* pk_, int vb, int lane) {
    const int h = lane >> 4;
    o.Ah0 = *(const bf16x8*)(pk_ + RW_AHAT + lane * 16); o.Ah1 = *(const bf16x8*)(pk_ + RW_AHAT + 1024 + lane * 16);
#pragma unroll
    for (int m = 0; m < 4; ++m) { o.S2A[m] = *(const bf16x8*)(pk_ + RW_S2A + m * 1024 + lane * 16); o.Pm[m] = *(const f32x4*)(pk_ + RW_P + (16 * m + 4 * h) * 4); }
    if (MODE != 1) { const v2u w2p = *(const v2u*)(pk_ + RW_W2 + vb * 512 + lane * 8); o.W2[0] = __uint_as_float(w2p.x << 16); o.W2[1] = __uint_as_float(w2p.x & 0xffff0000u); o.W2[2] = __uint_as_float(w2p.y << 16); o.W2[3] = __uint_as_float(w2p.y & 0xffff0000u);
        o.Vf = *(const v2u*)(pk_ + RW_V + vb * 512 + lane * 8); }
    if (MODE == 2) { o.R0 = *(const bf16x8*)(pk_ + RW_R + lane * 16); o.R1 = *(const bf16x8*)(pk_ + RW_R + 1024 + lane * 16); o.ARK = *(const bf16x8*)(pk_ + RW_ARK + lane * 16); }
}
template <int MODE>
__device__ __forceinline__ void rwkv_seq_wave(const RwkvSeqArgs& A, int hd, int vb, int cb, int ce, f32x4 (&St)[4], int lane, PostCtx* pc) {
    const int lo = lane & 15, h = lane >> 4; const f32x4 zz = (f32x4){0.f, 0.f, 0.f, 0.f};
    RwkvOps cur, nxt;
    rwkv_load_ops<MODE>(cur, A.pack + ((size_t)cb * 4 + hd) * RW_PACK, vb, lane);
    for (int c = cb; c < ce; ++c) {
        const int cn = (c + 1 < ce) ? c + 1 : c;
        rwkv_load_ops<MODE>(nxt, A.pack + ((size_t)cn * 4 + hd) * RW_PACK, vb, lane);
        float pg[4], pv[4], pb[4];
        if (MODE == 2) {
#pragma unroll
            for (int i = 0; i < 4; ++i) { const size_t t = (size_t)c * 16 + 4 * vb + i; pg[i] = bf2f(pc->g[t * 256 + hd * 64 + lane]); pv[i] = bf2f(pc->v[t * 256 + hd * 64 + lane]); pb[i] = pc->bc[t * 4 + hd]; }
        }
        const bf16x8 B0 = pack8(St[0], St[1]), B1 = pack8(St[2], St[3]);
        f32x4 U = MFMA16(cur.Ah0, B0, (MODE == 1) ? zz : cur.W2); U = MFMA16(cur.Ah1, B1, U);
        const bf16x8 BU = (MODE == 1) ? pack8(U, zz) : pack8u(U, cur.Vf);
        if (MODE == 2) {
            f32x4 y = MFMA16(cur.R0, B0, zz); y = MFMA16(cur.R1, B1, y); y = MFMA16(cur.ARK, BU, y);
            LAS float* xb = pc->xbuf + (pc->step & 1u) * 1024;
#pragma unroll
            for (int r = 0; r < 4; ++r) xb[(4 * h + r) * 64 + vb * 16 + lo] = y[r];
        }
#pragma unroll
        for (int m = 0; m < 4; ++m) St[m] = MFMA16(cur.S2A[m], BU, St[m] * cur.Pm[m]);
        if (MODE == 2) {
            const LAS float* xb = pc->xbuf + (pc->step & 1u) * 1024;
            group_sync(*pc);
            const int col = hd * 64 + lane; const float lw = pc->P[P_LNXW + pc->layer * 256 + col], lb = pc->P[P_LNXB + pc->layer * 256 + col];
#pragma unroll
            for (int i = 0; i < 4; ++i) { const int tt = 4 * vb + i; const float o = xb[tt * 64 + lane];
                const float mu = wave_sum(o) * (1.f / 64.f); const float d = o - mu; const float var = wave_sum(d * d) * (1.f / 64.f);
                const float yn = d * rsqrtf(var + GN_EPS) * lw + lb;
                pc->mix[((size_t)c * 16 + tt) * D + 768 + col] = (bf16)f2bf((yn + pb[i] * pv[i]) * pg[i]); }
        }
        cur = nxt;
    }
}
template <int MT> struct GLP { static constexpr int DK = MT ? 64 : 32, Q = 0, AV = DK / 32 * 1024, KH = AV + 512, V = KH + DK / 16 * 512, G = V + 2048, PACK = MT ? 7168 : 5120; };
constexpr int GLL_BYTES = 10240;
struct GlaPrepArgs { const bf16* z; const float* P; unsigned char* pack; };
template <int L, int MT>
__device__ __forceinline__ void gla_prep_wave(const GlaPrepArgs& A, int hd, int c0, int cstride, int cend, LAS unsigned char* wl, int lane) {
    constexpr int DK = MT ? 64 : 32;
    const int ch = lane & (DK - 1), lo = lane & 15, h = lane >> 4;
    const float* P = A.P;
    float gku[16]; float gkb = 0.f, lb = 0.f;
    if (MT == 0) {
#pragma unroll
        for (int i = 0; i < 16; ++i) gku[i] = P[P_GKUP + L * 2048 + i * 128 + hd * 32 + ch];
        gkb = P[P_GKB + L * 128 + hd * 32 + ch];
    } else lb = P[P_LBS + L * 256 + hd * 64 + ch];
    LAS bf16* qX = (LAS bf16*)(wl + 0); LAS bf16* ktX = (LAS bf16*)(wl + 2048); LAS bf16* khT = (LAS bf16*)(wl + 4096); LAS bf16* vT = (LAS bf16*)(wl + 6144);
    LAS bf16* Aimg = (LAS bf16*)(wl + 8192); LAS float* LR = (LAS float*)(wl + 8704); asm volatile("" : "+v"(LR));
    const f32x4 z4 = (f32x4){0.f, 0.f, 0.f, 0.f};
    const __amdgpu_buffer_rsrc_t zsrd = __builtin_amdgcn_make_buffer_rsrc((void*)A.z, 0, T * ZLD * 2, 0x00020000);
    for (int c = c0; c < cend; c += cstride) SUBREP(5 + MT) {
        const int t0 = c * 16;
        const unsigned qo = (unsigned)(t0 * ZLD + (MT ? Z_HQ + hd * 64 : Z_GQ + hd * 32) + ch) * 2u, ko = (unsigned)(t0 * ZLD + (MT ? Z_HF + hd * 64 : Z_GK + hd * 32) + ch) * 2u, vo = (unsigned)(t0 * ZLD + (MT ? Z_HI : Z_GV) + hd * 64 + lane) * 2u;
        if (MT == 0) {
#pragma unroll
            for (int q = 0; q < 4; ++q) { const int e = lane + 64 * q; LR[e] = bf2f(A.z[(size_t)(t0 + (e >> 4)) * ZLD + Z_GGK + (e & 15)]); }
            LDS_WAIT(); asm volatile("" ::: "memory");
        }
        float cum = 0.f;
#define GL_LD3(dst, tt) do { const unsigned s_ = (unsigned)(tt) * (ZLD * 2); dst[0] = (bf16)__builtin_amdgcn_raw_buffer_load_b16(zsrd, qo + s_, 0, 0); dst[1] = (bf16)__builtin_amdgcn_raw_buffer_load_b16(zsrd, ko + s_, 0, 0); \
            dst[2] = (bf16)__builtin_amdgcn_raw_buffer_load_b16(zsrd, vo + s_, 0, 0); } while (0)
        bf16 Zr[16][3];
#pragma unroll
        for (int tt = 0; tt < 16; ++tt) GL_LD3(Zr[tt], tt);
#pragma unroll
        for (int tt = 0; tt < 16; ++tt) asm volatile("" : "+v"(Zr[tt][0]), "+v"(Zr[tt][1]), "+v"(Zr[tt][2]));
#pragma unroll
        for (int tg = 0; tg < 16; tg += 4) {
#pragma unroll
          for (int ti = 0; ti < 4; ++ti) {
            const int t = tg + ti;
            const bf16 zq = Zr[t][0], zk2 = Zr[t][1], zvv = Zr[t][2];
            float q, k, lf;
            if (MT == 0) {
                q = bf2f(zq) * 0.17677669529663687f; k = bf2f(zk2);
                float s = gkb;
#pragma unroll
                for (int i = 0; i < 16; ++i) s += LR[t * 16 + i] * gku[i];
                lf = logsigmoidf_(s) * (1.f / 16.f);
            } else {
                const float fq = bf2f(zq), ff = bf2f(zk2);
                q = siluf_(fq); k = (1.f - lb) * sigmoidf_(-ff);
                lf = (lb == 0.f) ? logsigmoidf_(ff) : __logf(lb + (1.f - lb) * sigmoidf_(ff));
            }
            cum += lf;
            qX[t * 64 + ch] = (bf16)f2bf(q * __expf(cum)); ktX[t * 64 + ch] = (bf16)f2bf(k * __expf(-cum));
            vT[lane * 16 + t] = zvv;
          }
        }
#undef GL_LD3
        LDS_WAIT(); asm volatile("" ::: "memory");
        { const float gch = __expf(cum);
#pragma unroll 4
          for (int t = 0; t < 16; ++t) khT[ch * 16 + t] = (bf16)f2bf(bf2f(ktX[t * 64 + ch]) * gch); }
        unsigned char* pk_ = A.pack + ((size_t)c * 4 + hd) * GLP<MT>::PACK;
        if (lane < DK) *(float*)(pk_ + GLP<MT>::G + ch * 4) = __expf(cum);
        LDS_WAIT(); asm volatile("" ::: "memory");
        f32x4 Am = z4;
#pragma unroll
        for (int s = 0; s < DK / 32; ++s) Am = MFMA16(*(const LAS bf16x8*)(qX + lo * 64 + 32 * s + 8 * h), *(const LAS bf16x8*)(ktX + lo * 64 + 32 * s + 8 * h), Am);
#pragma unroll
        for (int r = 0; r < 4; ++r) { const int t = 4 * h + r; Aimg[t * 16 + lo] = (bf16)f2bf(lo <= t ? Am[r] : 0.f); }
        LDS_WAIT(); asm volatile("" ::: "memory");
#pragma unroll
        for (int s = 0; s < DK / 32; ++s) *(bf16x8*)(pk_ + GLP<MT>::Q + s * 1024 + lane * 16) = frag2(*(const LAS v2u*)(qX + lo * 64 + 32 * s + 4 * h), *(const LAS v2u*)(qX + lo * 64 + 32 * s + 16 + 4 * h));
        *(v2u*)(pk_ + GLP<MT>::AV + lane * 8) = *(const LAS v2u*)(Aimg + lo * 16 + 4 * h);
#pragma unroll
        for (int m = 0; m < DK / 16; ++m) *(v2u*)(pk_ + GLP<MT>::KH + m * 512 + lane * 8) = *(const LAS v2u*)(khT + (16 * m + lo) * 16 + 4 * h);
#pragma unroll
        for (int vb = 0; vb < 4; ++vb) *(v2u*)(pk_ + GLP<MT>::V + vb * 512 + lane * 8) = *(const LAS v2u*)(vT + (16 * vb + lo) * 16 + 4 * h);
        LDS_WAIT(); asm volatile("" ::: "memory");
    }
}
struct GlaSeqArgs { const unsigned char* pack; };
template <int MT> struct GlaOps { bf16x8 Q[2], AV, KH[4]; f32x4 Gm[4]; v2u Vf; };
template <int MT, bool OUT>
__device__ __forceinline__ void gla_load_ops(GlaOps<MT>& o, const unsigned char* pk_, int vb, int lane) {
    constexpr int DK = MT ? 64 : 32; const int h = lane >> 4;
#pragma unroll
    for (int m = 0; m < DK / 16; ++m) { o.KH[m] = frag2(*(const v2u*)(pk_ + GLP<MT>::KH + m * 512 + lane * 8), (v2u){0u, 0u}); o.Gm[m] = *(const f32x4*)(pk_ + GLP<MT>::G + (16 * m + 4 * h) * 4); }
    o.Vf = *(const v2u*)(pk_ + GLP<MT>::V + vb * 512 + lane * 8);
    if (OUT) {
#pragma unroll
        for (int s = 0; s < DK / 32; ++s) o.Q[s] = *(const bf16x8*)(pk_ + GLP<MT>::Q + s * 1024 + lane * 16);
        o.AV = frag2(*(const v2u*)(pk_ + GLP<MT>::AV + lane * 8), (v2u){0u, 0u});
    }
}
template <int MT, bool OUT>
__device__ __forceinline__ void gla_seq_wave(const GlaSeqArgs& A, int hd, int vb, int cb, int ce, f32x4 (&S)[4], f32x4 (&Dp)[4], int lane, PostCtx* pc) {
    constexpr int DK = MT ? 64 : 32;
    const int lo = lane & 15, h = lane >> 4; const f32x4 z4 = (f32x4){0.f, 0.f, 0.f, 0.f};
    GlaOps<MT> cur, nxt;
    gla_load_ops<MT, OUT>(cur, A.pack + ((size_t)cb * 4 + hd) * GLP<MT>::PACK, vb, lane);
    for (int c = cb; c < ce; ++c) {
        const int cn = (c + 1 < ce) ? c + 1 : c;
        gla_load_ops<MT, OUT>(nxt, A.pack + ((size_t)cn * 4 + hd) * GLP<MT>::PACK, vb, lane);
        float pg[4];
        if (OUT) {
#pragma unroll
            for (int i = 0; i < 4; ++i) pg[i] = bf2f(pc->z[((size_t)c * 16 + 4 * vb + i) * ZLD + (MT ? Z_HG : Z_GG) + hd * 64 + lane]);
        }
        const bf16x8 BV = frag2(cur.Vf, (v2u){0u, 0u});
        if (OUT) {
            f32x4 o = MFMA16(cur.AV, BV, z4);
#pragma unroll
            for (int s = 0; s < DK / 32; ++s) o = MFMA16(cur.Q[s], pack8(S[2 * s], S[2 * s + 1]), o);
            LAS float* xb = pc->xbuf + (pc->step & 1u) * 1024;
#pragma unroll
            for (int r = 0; r < 4; ++r) xb[(4 * h + r) * 64 + vb * 16 + lo] = o[r];
        }
#pragma unroll
        for (int m = 0; m < DK / 16; ++m) { S[m] = MFMA16(cur.KH[m], BV, S[m] * cur.Gm[m]); if (!OUT) Dp[m] = Dp[m] * cur.Gm[m]; }
        if (OUT) {
            const LAS float* xb = pc->xbuf + (pc->step & 1u) * 1024;
            group_sync(*pc);
            const float nw = pc->P[(MT ? P_HNW : P_GNW) + pc->layer * 64 + lane];
#pragma unroll
            for (int i = 0; i < 4; ++i) { const int tt = 4 * vb + i; const float o = xb[tt * 64 + lane];
                const float ms = wave_sum(o * o) * (1.f / 64.f);
                pc->mix[((size_t)c * 16 + tt) * D + MT * 256 + hd * 64 + lane] = (bf16)f2bf(o * rsqrtf(ms + RMS_EPS) * nw * siluf_(pg[i])); }
        }
        cur = nxt;
    }
}
constexpr int SW_KLD = 72, SW_VLD = 264, SW_PLD = 40;
constexpr int SW_K = 0, SW_V = 256 * SW_KLD * 2, SW_P = SW_V + 64 * SW_VLD * 2, SW_PW = 32 * SW_PLD * 2, SW_LDS = SW_P + 8 * SW_PW;
typedef float f32x16 __attribute__((ext_vector_type(16)));
#define MFMA32(a, b, c) __builtin_amdgcn_mfma_f32_32x32x16_bf16((a), (b), (c), 0, 0, 0)
__device__ __forceinline__ void swa_items(const bf16* z, const float* sinks, bf16* mix, int i0, int istride, LAS unsigned char* lds, int tid) {
    const int lane = tid & 63, wave = tid >> 6, l31 = lane & 31, hh = lane >> 5;
    LAS bf16* Ks = (LAS bf16*)(lds + SW_K); LAS bf16* Vt = (LAS bf16*)(lds + SW_V); LAS bf16* Pw = (LAS bf16*)(lds + SW_P + wave * SW_PW);
    for (int item = i0; item < (T / 128) * 2; item += istride) {
        const int nb = item >> 1, kvh = item & 1, tk0 = nb * 128 - 128;
        __syncthreads();
#pragma unroll
        for (int q = 0; q < 4; ++q) {
            const int e = tid + 512 * q, key = e >> 3, ch = e & 7; int tok = tk0 + key; tok = tok < 0 ? 0 : tok;
            const v4u kv = *(const GAS v4u*)(z + (size_t)tok * ZLD + Z_SK + kvh * 64 + ch * 8);
            *(LAS v4u*)(Ks + key * SW_KLD + ch * 8) = kv;
            const v4u vv = *(const GAS v4u*)(z + (size_t)tok * ZLD + Z_SV + kvh * 64 + ch * 8);
#pragma unroll
            for (int j = 0; j < 4; ++j) { Vt[(ch * 8 + 2 * j) * SW_VLD + key] = (bf16)(vv[j] & 0xffffu); Vt[(ch * 8 + 2 * j + 1) * SW_VLD + key] = (bf16)(vv[j] >> 16); }
        }
        __syncthreads();
        const int g = wave >> 2, qh = kvh * 2 + g, q0 = (wave & 3) * 32, kt0 = wave & 3;
        const float sink = sinks[qh];
        bf16x8 Qf[4];
        { const bf16* qp = z + (size_t)(nb * 128 + q0 + l31) * ZLD + Z_SQ + qh * 64 + 8 * hh;
#pragma unroll
          for (int s = 0; s < 4; ++s) Qf[s] = *(const GAS bf16x8*)(qp + 16 * s); }
        f32x16 Sc[5];
#pragma unroll
        for (int kt = 0; kt < 5; ++kt) {
            f32x16 acc;
#pragma unroll
            for (int i = 0; i < 16; ++i) acc[i] = 0.f;
            const LAS bf16* kp = Ks + ((kt0 + kt) * 32 + l31) * SW_KLD + 8 * hh;
#pragma unroll
            for (int s = 0; s < 4; ++s) acc = MFMA32(Qf[s], *(const LAS bf16x8*)(kp + 16 * s), acc);
            Sc[kt] = acc;
        }
        int l31o = l31, hho = hh; asm volatile("" : "+v"(l31o), "+v"(hho));
        float mx[16];
#pragma unroll
        for (int r = 0; r < 16; ++r) {
            const int ro = (r & 3) + 8 * (r >> 2) + 4 * hho;
            const bool lowv = l31o > ro;
            float m = -INFINITY;
#pragma unroll
            for (int kt = 0; kt < 5; ++kt) { bool vis = (kt == 0) ? lowv : ((kt == 4) ? !lowv : true); if (nb == 0 && kt0 + kt < 4) vis = false;
                const float sv = vis ? Sc[kt][r] * 0.125f : -INFINITY; Sc[kt][r] = sv; m = fmaxf(m, sv); }
#pragma unroll
            for (int o = 1; o < 32; o <<= 1) m = fmaxf(m, __shfl_xor(m, o));
            mx[r] = fmaxf(m, sink);
        }
        float inv[16];
#pragma unroll
        for (int r = 0; r < 16; ++r) {
            float s = 0.f;
#pragma unroll
            for (int kt = 0; kt < 5; ++kt) { const float p = __expf(Sc[kt][r] - mx[r]); Sc[kt][r] = p; s += p; }
#pragma unroll
            for (int o = 1; o < 32; o <<= 1) s += __shfl_xor(s, o);
            inv[r] = 1.f / (s + __expf(sink - mx[r]));
        }
        f32x16 O0, O1;
#pragma unroll
        for (int i = 0; i < 16; ++i) { O0[i] = 0.f; O1[i] = 0.f; }
#pragma unroll
        for (int kt = 0; kt < 5; ++kt) {
#pragma unroll
            for (int r = 0; r < 16; ++r) Pw[((r & 3) + 8 * (r >> 2) + 4 * hh) * SW_PLD + l31] = (bf16)f2bf(Sc[kt][r] * inv[r]);
            LDS_WAIT(); asm volatile("" ::: "memory");
#pragma unroll
            for (int s = 0; s < 2; ++s) {
                const bf16x8 Pf = *(const LAS bf16x8*)(Pw + l31 * SW_PLD + 16 * s + 8 * hh);
                const int kb = (kt0 + kt) * 32 + 16 * s + 8 * hh;
                O0 = MFMA32(Pf, *(const LAS bf16x8*)(Vt + l31 * SW_VLD + kb), O0);
                O1 = MFMA32(Pf, *(const LAS bf16x8*)(Vt + (32 + l31) * SW_VLD + kb), O1);
            }
            LDS_WAIT(); asm volatile("" ::: "memory");
        }
#pragma unroll
        for (int r = 0; r < 16; ++r) { const int qi = q0 + (r & 3) + 8 * (r >> 2) + 4 * hh; bf16* op = mix + (size_t)(nb * 128 + qi) * D + 512 + qh * 64 + l31;
            op[0] = (bf16)f2bf(O0[r]); op[32] = (bf16)f2bf(O1[r]); }
    }
}
__device__ __forceinline__ void tr_item(const float* src, int ldw, int nvalid, bf16* dst, int dld, LAS float* scr, int lane) {
    const int nl = lane & 31;
    float tv[32];
#pragma unroll
    for (int i = 0; i < 32; ++i) { const int kk = 2 * i + (lane >> 5); tv[i] = (nl < nvalid) ? src[(size_t)kk * ldw + nl] : 0.f; }
#pragma unroll
    for (int i = 0; i < 32; ++i) { const int kk = 2 * i + (lane >> 5); scr[kk * 33 + nl] = tv[i]; }
    LDS_WAIT(); asm volatile("" ::: "memory");
    const int c = lane & 7;
#pragma unroll
    for (int j = 0; j < 4; ++j) { const int n = (lane >> 3) + 8 * j; const LAS float* s = scr + (8 * c) * 33 + n;
        v4u o; o.x = pk2(s[0 * 33], s[1 * 33]); o.y = pk2(s[2 * 33], s[3 * 33]); o.z = pk2(s[4 * 33], s[5 * 33]); o.w = pk2(s[6 * 33], s[7 * 33]);
        if (n < nvalid) *(GAS v4u*)(dst + (size_t)n * dld + 8 * c) = o; }
    LDS_WAIT(); asm volatile("" ::: "memory");
}
__device__ __forceinline__ void tr_job(const float* src, int ldw, int nblocks, int ncols, bf16* dst, int dld, int il, int rowoff, int it, LAS float* scr, int lane) {
    const int kb = it / nblocks, nb = it - kb * nblocks, n0 = nb * 32; const int nv = (ncols - n0) < 32 ? (ncols - n0) : 32;
    const int row = il ? ((n0 >> 7) * 256 + (n0 & 127) + rowoff) : (n0 + rowoff);
    tr_item(src + (size_t)kb * 64 * ldw + n0, ldw, nv, dst + (size_t)row * dld + kb * 64, dld, scr, lane);
}
__device__ __forceinline__ void moe_weights_half(const float* wg, const float* wu, const float* wd, bf16* gu, bf16* dn, int hh, int gw, int NGW, LAS float* scr, int lane) {
    constexpr int PER = 896, PE = 3 * PER;
    for (int it = gw; it < NE * PE; it += NGW) {
        const int e = it / PE, r = it - e * PE, which = r / PER, idx = r - which * PER;
        const float* src; int ldw, nblocks, ncols, dld, il, rowoff; bf16* dst;
        if (which == 0) { src = wg + (size_t)e * D * DFE + hh * DFH; ldw = DFE; nblocks = 56; ncols = DFH; dst = gu + (size_t)e * 3584 * D; dld = D; il = 1; rowoff = 0; }
        else if (which == 1) { src = wu + (size_t)e * D * DFE + hh * DFH; ldw = DFE; nblocks = 56; ncols = DFH; dst = gu + (size_t)e * 3584 * D; dld = D; il = 1; rowoff = 128; }
        else { src = wd + (size_t)e * DFE * D + (size_t)hh * DFH * D; ldw = D; nblocks = 32; ncols = D; dst = dn + (size_t)e * D * DFH; dld = DFH; il = 0; rowoff = 0; }
        tr_job(src, ldw, nblocks, ncols, dst, dld, il, rowoff, idx, scr, lane);
    }
}
__device__ __forceinline__ void cvt_rows(const float* src, bf16* dst, size_t n, size_t gtid, size_t nthreads) {
    for (size_t i = gtid * 8; i < n; i += nthreads * 8) { const f32x4 a = *(const GAS f32x4*)(src + i), b = *(const GAS f32x4*)(src + i + 4);
        v4u o; o.x = pk2(a[0], a[1]); o.y = pk2(a[2], a[3]); o.z = pk2(b[0], b[1]); o.w = pk2(b[2], b[3]); *(GAS v4u*)(dst + i) = o; }
}

struct LnArgs { const float* src; const float* gam; const float* bet; float* xout; bf16* xb; int mode; const bf16* Y1; const bf16* Y2; const int* tok_row; const float* top_g;
                int route; const float* router; int* top_e; float* top_gw; gu32* cnt; };
__device__ __forceinline__ void ln_rows(const LnArgs& a, int gw, int NGW, int lane) {
    for (int row = gw; row < T; row += NGW) {
        f32x4 v[4]; float s = 0.f;
        if (a.mode == 0) {
#pragma unroll
            for (int j = 0; j < 4; ++j) { const v2u w_ = *((const GAS v2u*)((const bf16*)a.src + (size_t)row * D) + lane + 64 * j);
                v[j][0] = __uint_as_float(w_.x << 16); v[j][1] = __uint_as_float(w_.x & 0xffff0000u); v[j][2] = __uint_as_float(w_.y << 16); v[j][3] = __uint_as_float(w_.y & 0xffff0000u); }
        } else {
            const int r0 = a.tok_row[row * 2], r1 = a.tok_row[row * 2 + 1]; const float g0 = a.top_g[row * 2], g1 = a.top_g[row * 2 + 1];
#pragma unroll
            for (int j = 0; j < 4; ++j) {
                const f32x4 xv = *((const GAS f32x4*)(a.xout + (size_t)row * D) + lane + 64 * j);
                const v2u a0 = *((const GAS v2u*)(a.Y1 + (size_t)r0 * D) + lane + 64 * j), b0 = *((const GAS v2u*)(a.Y2 + (size_t)r0 * D) + lane + 64 * j);
                const v2u a1 = *((const GAS v2u*)(a.Y1 + (size_t)r1 * D) + lane + 64 * j), b1 = *((const GAS v2u*)(a.Y2 + (size_t)r1 * D) + lane + 64 * j);
                f32x4 y0, y1;
                y0[0] = __uint_as_float(a0.x << 16) + __uint_as_float(b0.x << 16); y0[1] = __uint_as_float(a0.x & 0xffff0000u) + __uint_as_float(b0.x & 0xffff0000u);
                y0[2] = __uint_as_float(a0.y << 16) + __uint_as_float(b0.y << 16); y0[3] = __uint_as_float(a0.y & 0xffff0000u) + __uint_as_float(b0.y & 0xffff0000u);
                y1[0] = __uint_as_float(a1.x << 16) + __uint_as_float(b1.x << 16); y1[1] = __uint_as_float(a1.x & 0xffff0000u) + __uint_as_float(b1.x & 0xffff0000u);
                y1[2] = __uint_as_float(a1.y << 16) + __uint_as_float(b1.y << 16); y1[3] = __uint_as_float(a1.y & 0xffff0000u) + __uint_as_float(b1.y & 0xffff0000u);
                v[j] = xv * ALPHA + y0 * g0 + y1 * g1;
            }
        }
#pragma unroll
        for (int j = 0; j < 4; ++j) s += (v[j][0] + v[j][1]) + (v[j][2] + v[j][3]);
        const float mean = wave_sum(s) * (1.f / D); float q = 0.f;
#pragma unroll
        for (int j = 0; j < 4; ++j) { v[j] = v[j] - mean; q += (v[j][0] * v[j][0] + v[j][1] * v[j][1]) + (v[j][2] * v[j][2] + v[j][3] * v[j][3]); }
        const float rstd = rsqrtf(wave_sum(q) * (1.f / D) + LN_EPS);
#pragma unroll
        for (int j = 0; j < 4; ++j) {
            const f32x4 gg = *((const GAS f32x4*)a.gam + lane + 64 * j), bb = *((const GAS f32x4*)a.bet + lane + 64 * j);
            v[j] = v[j] * rstd * gg + bb;
            *((GAS f32x4*)(a.xout + (size_t)row * D) + lane + 64 * j) = v[j];
            v2u w; w.x = pk2(v[j][0], v[j][1]); w.y = pk2(v[j][2], v[j][3]);
            *((GAS v2u*)(a.xb + (size_t)row * D) + lane + 64 * j) = w;
        }
        if (a.route) {
            float lg[8];
#pragma unroll
            for (int e = 0; e < 8; ++e) lg[e] = 0.f;
#pragma unroll
            for (int j = 0; j < 4; ++j)
#pragma unroll
                for (int i = 0; i < 4; ++i) { const int d = 4 * lane + 256 * j + i; const f32x4 r0 = *(const GAS f32x4*)(a.router + d * 8), r1 = *(const GAS f32x4*)(a.router + d * 8 + 4); const float xv = v[j][i];
                    lg[0] += xv * r0[0]; lg[1] += xv * r0[1]; lg[2] += xv * r0[2]; lg[3] += xv * r0[3]; lg[4] += xv * r1[0]; lg[5] += xv * r1[1]; lg[6] += xv * r1[2]; lg[7] += xv * r1[3]; }
#pragma unroll
            for (int e = 0; e < 8; ++e) lg[e] = wave_sum(lg[e]);
            if (lane == 0) {
                int e0 = 0; float l0 = lg[0];
#pragma unroll
                for (int e = 1; e < 8; ++e) if (lg[e] > l0) { l0 = lg[e]; e0 = e; }
                int e1 = 0; float l1 = -INFINITY;
#pragma unroll
                for (int e = 0; e < 8; ++e) if (e != e0 && lg[e] > l1) { l1 = lg[e]; e1 = e; }
                const float g1 = __expf(l1 - l0), den = 1.f + g1;
                a.top_e[row * 2] = e0; a.top_e[row * 2 + 1] = e1; a.top_gw[row * 2] = 1.f / den; a.top_gw[row * 2 + 1] = g1 / den;
                __hip_atomic_fetch_add(a.cnt + e0, 1u, RLX_AGENT); __hip_atomic_fetch_add(a.cnt + e1, 1u, RLX_AGENT);
            }
        }
    }
}

struct Args { const float* in[38]; float* out; unsigned char* ws; };
template <int I> __device__ __forceinline__ const float* in_ptr() {
    unsigned long long v; auto kp = __builtin_amdgcn_kernarg_segment_ptr();
    asm volatile("s_load_dwordx2 %0, %1, %2\n\ts_waitcnt lgkmcnt(0)" : "=s"(v) : "s"(kp), "n"(I * 8));
    return (const float*)v;
}
#define IN(i) in_ptr<(i)>()
#ifndef DIAG_A
#define DIAG_A -1
#define DIAG_B -1
#define DIAG_DIV 100000.f
#endif
#define PHASE_IDS() int tid = threadIdx.x; asm volatile("" : "+v"(tid)); const int lane = tid & 63; (void)lane
#ifndef DUP_PHASE
#define DUP_PHASE -1
#define DUP_N 5
#endif
#define DUP_BEGIN(id) _Pragma("unroll") for (int rep_ = 0; rep_ < ((DUP_PHASE == (id)) ? DUP_N : 1); ++rep_) {
#define DUP_END() GRID_BAR(); }
#define DUP_END2() }
#define GRID_BAR() do { xcd_barrier(bar); if (DIAG_A >= -1 && DIAG_B >= 0) { if (bx == 0 && threadIdx.x == 0) ((GAS unsigned long long*)(args.ws + WS_CTL + 262144))[nst] = __builtin_amdgcn_s_memrealtime(); ++nst; } } while (0)
template <int L, bool DO_IN, bool DO_MIX, bool DO_POST>
__device__ __forceinline__ void layer_body(const Args& args, LAS unsigned char* lds, const XcdBarrier& bar, int tid0, int lane0, int wave, int G, int bx, int vcu, int gw, int NGW, int& nst) {
    (void)tid0; (void)lane0;
    unsigned char* ws = args.ws;
    gu32* ctl = (gu32*)(ws + WS_CTL);
    bf16* Wmoegu = (bf16*)(ws + WS_MOEGU); bf16* Wmoed = (bf16*)(ws + WS_MOED);
    bf16* vfirst = (bf16*)(ws + WS_VFIRST);
    bf16* zb = (bf16*)(ws + WS_Z); bf16* mix = (bf16*)(ws + WS_MIX); float* preln = (float*)(ws + WS_PRELN);
    float* gla_logf = (float*)(ws + WS_PREP); float* rwb = (float*)(ws + WS_PREP + 8 * MiB);
    const float* PB = (const float*)(ws + WS_MISC + MS_PARAMS); int* top_e = (int*)(ws + WS_MISC + MS_TOPE); float* top_g = (float*)(ws + WS_MISC + MS_TOPG);
    int* tok_row = (int*)(ws + WS_MISC + MS_TOKROW); int* row_tok = (int*)(ws + WS_MISC + MS_ROWTOK); int* tile_e = (int*)(ws + WS_MISC + MS_TILEE);
    float* xf = args.out;

        bf16* xb_in = (bf16*)(ws + (L == 0 ? WS_XB0 : WS_XB1)); bf16* xb_out = (bf16*)(ws + (L == 0 ? WS_XB1 : WS_XB0));
        const float* xres = (L == 0) ? IN(0) : xf;
        if constexpr (DO_IN) {
        DUP_BEGIN(L * 100 + 1)
        {
            pg8::Gemm g{xb_in, (const bf16*)(ws + (L == 0 ? WS_WIN0 : WS_WIN1)), T, ZLD, D}; pg8::StaticOrder S; S.init(T, ZLD, G, bx);
            pg8::EpiStoreBf16 E{zb, ZLD};
            pg8::gemm_phase<pg8::EpiStoreBf16, pg8::StaticOrder, PG8_ALIGN, PG8_SP2>(lds, g, S, E);
        }
        DUP_END();
        }
        if constexpr (DO_MIX) {
        float* sst = (float*)(ws + WS_SST); bf16* mtb = (bf16*)(ws + WS_MT); float* dsc = (float*)(ws + WS_MISC + MS_DSC);
        DUP_BEGIN(L * 100 + 3)
        DUP_BEGIN(L * 100 + 2)
        {
            PHASE_IDS(); const int lo = lane & 15, h = lane >> 4;
            const int j = vcu >> 2, hd = vcu & 3, cb = 16 * j, ce = cb + 16;
            DUP_BEGIN(L * 100 + 20)
            if (wave < 4) { RwkvPrepArgs rp; rp.z = zb; rp.P = PB; rp.vfirst = vfirst; rp.pack = ws + WS_RWPACK; rp.gout = (bf16*)(ws + WS_GOUT); rp.vout = (bf16*)(ws + WS_VOUT); rp.bcout = (float*)(ws + WS_BC);
                rwkv_prep_wave<L>(rp, hd, cb + wave, 4, ce, lds + wave * RWL_BYTES, lane); }
            else { GlaPrepArgs g0; g0.z = zb; g0.P = PB; g0.pack = ws + WS_GLPACK; GlaPrepArgs g1 = g0; g1.pack = ws + WS_HGPACK;
                gla_prep_wave<L, 0>(g0, hd, cb + wave - 4, 4, ce, lds + 4 * RWL_BYTES + (wave - 4) * GLL_BYTES, lane);
                gla_prep_wave<L, 1>(g1, hd, cb + wave - 4, 4, ce, lds + 4 * RWL_BYTES + (wave - 4) * GLL_BYTES, lane); }
            DUP_END2()
            VM_WAIT(); __syncthreads();
            DUP_BEGIN(L * 100 + 21)
            {
                RwkvSeqArgs sa; sa.pack = ws + WS_RWPACK; f32x4 St[4];
                if (wave < 4) {
#pragma unroll
                    for (int m = 0; m < 4; ++m) St[m] = (f32x4){0.f, 0.f, 0.f, 0.f};
                    rwkv_seq_wave<0>(sa, hd, wave, cb, ce, St, lane, nullptr);
                    float* o = sst + ((size_t)((8 + hd) * 64 + j)) * 4096 + (wave * 4 * 64 + lane) * 4;
#pragma unroll
                    for (int m = 0; m < 4; ++m) *(GAS f32x4*)(o + m * 256) = St[m];
                } else {
                    const int pb = wave - 4;
#pragma unroll
                    for (int m = 0; m < 4; ++m)
#pragma unroll
                        for (int r = 0; r < 4; ++r) St[m][r] = (16 * m + 4 * h + r == 16 * pb + lo) ? 1.f : 0.f;
                    rwkv_seq_wave<1>(sa, hd, pb, cb, ce, St, lane, nullptr);
                    bf16* o = mtb + ((size_t)(hd * 64 + j)) * 4096 + (lo & 3);
#pragma unroll
                    for (int m = 0; m < 4; ++m)
#pragma unroll
                        for (int r = 0; r < 4; ++r) o[(16 * m + 4 * h + r) * 64 + ((((16 * pb + lo) >> 2) ^ (4 * h + r)) << 2)] = (bf16)f2bf(St[m][r]);
                }
            }
            DUP_END2()
            DUP_BEGIN(L * 100 + 22)
            {
                f32x4 S[4], Dp[4];
#pragma unroll
                for (int m = 0; m < 4; ++m) { S[m] = (f32x4){0.f, 0.f, 0.f, 0.f}; Dp[m] = (f32x4){1.f, 1.f, 1.f, 1.f}; }
                const int vb = wave & 3, mt = wave >> 2, mh = mt * 4 + hd;
                GlaSeqArgs sa; sa.pack = ws + (mt ? WS_HGPACK : WS_GLPACK);
                if (mt == 0) gla_seq_wave<0, false>(sa, hd, vb, cb, ce, S, Dp, lane, nullptr); else gla_seq_wave<1, false>(sa, hd, vb, cb, ce, S, Dp, lane, nullptr);
                float* o = sst + ((size_t)(mh * 64 + j)) * 4096 + (vb * 4 * 64 + lane) * 4;
#pragma unroll
                for (int m = 0; m < 4; ++m) if (mt || m < 2) *(GAS f32x4*)(o + m * 256) = S[m];
                if (vb == 0 && lo == 0) {
#pragma unroll
                    for (int m = 0; m < 4; ++m) if (mt || m < 2) *(GAS f32x4*)(dsc + ((size_t)(mh * 64 + j)) * 64 + 16 * m + 4 * h) = Dp[m]; }
            }
            DUP_END2()
        }
        DUP_END();
        {
            PHASE_IDS(); const int lo = lane & 15, h = lane >> 4;
            if (bx < 48) {
                const int gt = bx * (NWAVES * 64) + tid; int mh, e, mm;
                if (gt < 8192) { mh = gt >> 11; e = gt & 2047; mm = (e >> 8) & 1; e = ((e >> 9) * 4 + mm) * 256 + (e & 255); }
                else { const int g2 = gt - 8192; mh = 4 + (g2 >> 12); e = g2 & 4095; mm = (e >> 8) & 3; }
                const int k = 16 * mm + 4 * ((e & 255) >> 6) + (e & 3);
                float* sp = sst + (size_t)mh * 64 * 4096 + e; const float* dp = dsc + (size_t)mh * 64 * 64 + k;
                float S = 0.f;
#pragma unroll 1
                for (int j0 = 0; j0 < 64; j0 += 8) {
                    float sl[8], dd[8];
#pragma unroll
                    for (int u = 0; u < 8; ++u) { sl[u] = sp[(size_t)(j0 + u) * 4096]; dd[u] = dp[(j0 + u) * 64]; }
#pragma unroll
                    for (int u = 0; u < 8; ++u) { sp[(size_t)(j0 + u) * 4096] = S; S = dd[u] * S + sl[u]; }
                }
            } else if (bx < 52) {
                const int hd = bx - 48, vb = wave & 3;
                f32x4 St[4], N0[4], N1[4], N2[4];
#pragma unroll
                for (int m = 0; m < 4; ++m) St[m] = (f32x4){0.f, 0.f, 0.f, 0.f};
                float* sp = sst + ((size_t)(8 + hd) * 64) * 4096 + (vb * 4 * 64 + lane) * 4;
                const unsigned char* mg = (const unsigned char*)(mtb + ((size_t)hd * 64) * 4096);
#define RW_NLOAD(N_, jj) do { _Pragma("unroll") for (int m = 0; m < 4; ++m) N_[m] = *(const GAS f32x4*)(sp + (size_t)(jj) * 4096 + m * 256); } while (0)
                if (wave < 4) { RW_NLOAD(N0, 0); RW_NLOAD(N1, 1); RW_NLOAD(N2, 2); }
#pragma unroll 1
                for (int rd = 0; rd < 4; ++rd) {
                    __syncthreads();
                    if (wave < 4) {
#pragma unroll 8
                        for (int i = 0; i < 32; ++i) { const int q = wave * 32 + i;
                            __builtin_amdgcn_global_load_lds((const unsigned*)(mg + (size_t)(16 * rd) * 8192 + (size_t)q * 1024 + lane * 16), (LAS unsigned*)(lds + q * 1024), 16, 0, 0); }
                    }
                    VM_WAIT(); __syncthreads();
                    if (wave < 4) {
#pragma unroll 1
                        for (int jj = 0; jj < 16; ++jj) {
                            const int j = 16 * rd + jj;
                            const LAS unsigned char* ms = lds + jj * 8192 + lo * 128;
                            bf16x8 Af[4][2];
#pragma unroll
                            for (int m = 0; m < 4; ++m)
#pragma unroll
                                for (int s2 = 0; s2 < 2; ++s2) Af[m][s2] = frag2(*(const LAS v2u*)(ms + m * 2048 + (((8 * s2 + h) ^ lo) << 3)), *(const LAS v2u*)(ms + m * 2048 + (((8 * s2 + 4 + h) ^ lo) << 3)));
                            const bf16x8 B0 = pack8(St[0], St[1]), B1 = pack8(St[2], St[3]);
#pragma unroll
                            for (int m = 0; m < 4; ++m) { *(GAS f32x4*)(sp + (size_t)j * 4096 + m * 256) = St[m]; }
#pragma unroll
                            for (int m = 0; m < 4; ++m) { f32x4 a = MFMA16(Af[m][0], B0, N0[m]); St[m] = MFMA16(Af[m][1], B1, a); }
#pragma unroll
                            for (int m = 0; m < 4; ++m) { N0[m] = N1[m]; N1[m] = N2[m]; }
                            { const int jn = (j + 3 < 64) ? j + 3 : 63; RW_NLOAD(N2, jn); }
                        }
                    }
                }
#undef RW_NLOAD
            } else swa_items(zb, PB + P_SINK + L * 4, mix, bx - 52, G - 52, lds, tid);
        }
        DUP_END();
        DUP_BEGIN(L * 100 + 4)
        {
            PHASE_IDS();
            const int j = vcu >> 2, hd = vcu & 3, cb = 16 * j, ce = cb + 16;
            if (tid < 2) ((LAS unsigned*)(lds + 16384))[tid * 16] = 0u;
            __syncthreads();
            PostCtx pc; pc.xbuf = (LAS float*)(lds + (wave >> 2) * 8192); pc.cnt = (volatile LAS unsigned*)(lds + 16384) + (wave >> 2) * 16; pc.step = 0u;
            pc.z = zb; pc.P = PB; pc.g = (const bf16*)(ws + WS_GOUT); pc.v = (const bf16*)(ws + WS_VOUT); pc.bc = (const float*)(ws + WS_BC); pc.mix = mix; pc.layer = L;
            if (wave < 4) {
                RwkvSeqArgs sa; sa.pack = ws + WS_RWPACK; f32x4 St[4];
                const float* o = sst + ((size_t)((8 + hd) * 64 + j)) * 4096 + (wave * 4 * 64 + lane) * 4;
#pragma unroll
                for (int m = 0; m < 4; ++m) St[m] = *(const GAS f32x4*)(o + m * 256);
                rwkv_seq_wave<2>(sa, hd, wave, cb, ce, St, lane, &pc);
            } else {
                const int vb = wave - 4; f32x4 S[4], Dp[4];
                {
                    GlaSeqArgs sa; sa.pack = ws + WS_GLPACK; const float* o = sst + ((size_t)(hd * 64 + j)) * 4096 + (vb * 4 * 64 + lane) * 4;
#pragma unroll
                    for (int m = 0; m < 4; ++m) { S[m] = (m < 2) ? *(const GAS f32x4*)(o + m * 256) : (f32x4){0.f, 0.f, 0.f, 0.f}; Dp[m] = S[m]; }
                    gla_seq_wave<0, true>(sa, hd, vb, cb, ce, S, Dp, lane, &pc);
                }
                {
                    GlaSeqArgs sa; sa.pack = ws + WS_HGPACK; const float* o = sst + ((size_t)((4 + hd) * 64 + j)) * 4096 + (vb * 4 * 64 + lane) * 4;
#pragma unroll
                    for (int m = 0; m < 4; ++m) { S[m] = *(const GAS f32x4*)(o + m * 256); Dp[m] = S[m]; }
                    gla_seq_wave<1, true>(sa, hd, vb, cb, ce, S, Dp, lane, &pc);
                }
            }
        }
        DUP_END();
        }
        if constexpr (DO_POST) {
        DUP_BEGIN(L * 100 + 99) if (rep_ == 0) continue; DUP_END();
        DUP_BEGIN(L * 100 + 6)
        {
            pg8::Gemm g{mix, (const bf16*)(ws + (L == 0 ? WS_WOUT0 : WS_WOUT1)), T, D, D}; pg8::StaticOrder S; S.init(T, D, G, bx);
            pg8::EpiResBf16 E{xres, (bf16*)preln, D, ALPHA};
            pg8::gemm_phase<pg8::EpiResBf16, pg8::StaticOrder, PG8_ALIGN, PG8_SP2>(lds, g, S, E);
        }
        DUP_END();
        DUP_BEGIN(L == 0 ? 7 : -77)
        {
            PHASE_IDS(); LnArgs la{}; la.src = preln; la.gam = PB + P_LN1G + L * D; la.bet = PB + P_LN1B + L * D; la.xout = xf; la.xb = xb_in; la.mode = 0;
            la.route = (L == 1); la.router = PB + P_ROUTER; la.top_e = top_e; la.top_gw = top_g; la.cnt = ctl + CW_MOE;
            ln_rows(la, gw, NGW, lane);
        }
        DUP_END();
        if constexpr (L == 0) {
        DUP_BEGIN(L * 100 + 8)
            {
                pg8::Gemm g{xb_in, (const bf16*)(ws + WS_FGU), T, 2 * DFF, D}; pg8::StaticOrder S; S.init(T, 2 * DFF, G, bx);
                pg8::EpiSwiglu E{(bf16*)(ws + WS_HD), DFF};
                pg8::gemm_phase<pg8::EpiSwiglu, pg8::StaticOrder, PG8_ALIGN, PG8_SP2>(lds, g, S, E);
            }
            {
                constexpr int NHEAVY = (T / 256) * (2 * DFF / 256) - 5 * 256;
                pg8::Gemm g{(const bf16*)(ws + WS_PB0), (const bf16*)(ws + WS_PP0), T, D, 256}; pg8::StaticOrder S; S.init(T, D, G - NHEAVY, bx >= NHEAVY ? bx - NHEAVY : (1 << 20));
                pg8::EpiStoreBf16 E{(bf16*)(ws + WS_MIX), D};
                pg8::gemm_phase<pg8::EpiStoreBf16, pg8::StaticOrder, PG8_ALIGN, PG8_SP2>(lds, g, S, E);
            }
            DUP_END();
        DUP_BEGIN(L * 100 + 9)
            {
                pg8::Gemm g{(const bf16*)(ws + WS_HD), (const bf16*)(ws + WS_FD), T, D, DFF}; pg8::StaticOrder S; S.init(T, D, G, bx);
                pg8::EpiResBf16 E{xf, (bf16*)preln, D, ALPHA};
                pg8::gemm_phase<pg8::EpiResBf16, pg8::StaticOrder, PG8_ALIGN, PG8_SP2>(lds, g, S, E);
            }
            DUP_END();
            {
                PHASE_IDS(); LnArgs la{}; la.src = preln; la.gam = PB + P_LN2G + L * D; la.bet = PB + P_LN2B + L * D; la.xout = xf; la.xb = xb_in; la.mode = 0; la.route = 0;
                ln_rows(la, gw, NGW, lane);
            }
        } else {
            int start[NE + 1]; int nrt;
            {
                PHASE_IDS();
                int off = 0;
#pragma unroll
                for (int e = 0; e < NE; ++e) { start[e] = off; const int c = (int)__hip_atomic_load(ctl + CW_MOE + e, RLX_AGENT); off += (c + 255) / 256 * 256; }
                start[NE] = off; nrt = off / 256;
                if (bx == 0 && tid < MOE_MAXTILES) { int e = 0;
#pragma unroll
                    for (int q = 1; q < NE; ++q) if (tid * 256 >= start[q]) e = q;
                    tile_e[tid] = e; }
                const int gtid = vcu * (NWAVES * 64) + tid, nth = G * NWAVES * 64;
                for (int i = gtid; i < T * 2; i += nth) { const int e = top_e[i]; const int pos = (int)__hip_atomic_fetch_add(ctl + CW_MOE + 64 + e, 1u, RLX_AGENT);
                    int st = 0;
#pragma unroll
                    for (int q = 0; q < NE; ++q) st = (e == q) ? start[q] : st;
                    const int dest = st + pos; row_tok[dest] = i >> 1; tok_row[i] = dest; }
            }
            GRID_BAR();
            DUP_BEGIN(121)
            {
                PHASE_IDS(); bf16* xg = (bf16*)(ws + WS_XG);
                for (int row = gw; row < nrt * 256; row += NGW) { const int t = row_tok[row];
                    const v4u a = *((const GAS v4u*)(xb_in + (size_t)t * D) + lane), b = *((const GAS v4u*)(xb_in + (size_t)t * D) + 64 + lane);
                    *((GAS v4u*)(xg + (size_t)row * D) + lane) = a; *((GAS v4u*)(xg + (size_t)row * D) + 64 + lane) = b; }
            }
            DUP_END();
#pragma unroll
            for (int hh = 0; hh < 2; ++hh) {
                if (hh == 1) { DUP_BEGIN(125) PHASE_IDS(); moe_weights_half(IN(33), IN(34), IN(35), Wmoegu, Wmoed, 1, gw, NGW, (LAS float*)(lds + wave * 16384), lane); DUP_END(); }
                DUP_BEGIN(122 + 4 * hh)
                {
                    pg8::Gemm g{(const bf16*)(ws + WS_XG), Wmoegu, MOE_MAXROWS, 0, D}; pg8::MoeOrder S{tile_e, nrt, 14, G, bx};
                    pg8::EpiSwiglu E{(bf16*)(ws + WS_HM), DFH};
                    pg8::gemm_phase<pg8::EpiSwiglu, pg8::MoeOrder, PG8_ALIGN, PG8_SP2>(lds, g, S, E);
                }
                if (hh == 0) {
                    const int nun = nrt * 14, nfull = nun / G, heavy = nun - nfull * G;
                    const int glight = G - heavy;
                    pg8::Gemm g{(const bf16*)(ws + WS_PB1), (const bf16*)(ws + WS_PP1), T, D, 256}; pg8::StaticOrder S; S.init(T, D, glight > 0 ? glight : 1, (bx >= heavy && glight > 0) ? bx - heavy : (1 << 20));
                    pg8::EpiStoreBf16 E{(bf16*)(ws + WS_XB0), D};
                    pg8::gemm_phase<pg8::EpiStoreBf16, pg8::StaticOrder, PG8_ALIGN, PG8_SP2>(lds, g, S, E);
                }
                DUP_END();
                DUP_BEGIN(123 + 4 * hh)
                {
                    pg8::Gemm g{(const bf16*)(ws + WS_HM), Wmoed, MOE_MAXROWS, 0, DFH}; pg8::MoeOrder S{tile_e, nrt, 4, G, bx};
                    pg8::EpiStoreBf16 E{(bf16*)(ws + (hh == 0 ? WS_Y1 : WS_XG)), D};
                    pg8::gemm_phase<pg8::EpiStoreBf16, pg8::MoeOrder, PG8_ALIGN, PG8_SP2>(lds, g, S, E);
                }
                DUP_END();
            }
            {
                PHASE_IDS(); LnArgs la{}; la.gam = PB + P_LN2G + L * D; la.bet = PB + P_LN2B + L * D; la.xout = xf; la.xb = xb_in; la.mode = 1; la.Y1 = (const bf16*)(ws + WS_Y1); la.Y2 = (const bf16*)(ws + WS_XG);
                la.tok_row = tok_row; la.top_g = top_g; la.route = 0;
                ln_rows(la, gw, NGW, lane);
            }
        }
        GRID_BAR();
        {
            pg8::Gemm g{xb_in, (const bf16*)(ws + (L == 0 ? WS_PG0 : WS_PG1)), T, D, D}; pg8::StaticOrder S; S.init(T, D, G, bx);
            float osc = 1.f;
            if (DIAG_B >= 0 && L == 1) { const GAS unsigned long long* tsb = (const GAS unsigned long long*)(args.ws + WS_CTL + 262144); const unsigned long long ta = tsb[DIAG_A < 0 ? 63 : DIAG_A], tb = tsb[DIAG_B]; osc = 1.f + (float)(tb - ta) / DIAG_DIV; }
            pg8::EpiPle E{xf, (const bf16*)(ws + (L == 0 ? WS_MIX : WS_XB0)), (L == 0) ? xb_out : (bf16*)nullptr, D, osc};
            pg8::gemm_phase<pg8::EpiPle, pg8::StaticOrder, PG8_ALIGN, PG8_SP2>(lds, g, S, E);
        }
        }
}
__global__ void __launch_bounds__(NWAVES * 64, 2) mega_fwd(Args args, int seg) {
    extern __shared__ __attribute__((aligned(16))) unsigned char lds_raw[];
    LAS unsigned char* lds = (LAS unsigned char*)lds_raw;
    volatile LAS unsigned* MISC = (volatile LAS unsigned*)(lds + MISC_OFF);
    const int tid = threadIdx.x, lane = tid & 63, wave = __builtin_amdgcn_readfirstlane(tid >> 6);
    const int G = gridDim.x, bx = blockIdx.x; const int vcu = (G % 8 == 0) ? (bx % 8) * (G / 8) + bx / 8 : bx;
    const int gw = vcu * NWAVES + wave, NGW = G * NWAVES;
    unsigned char* ws = args.ws;
    gu32* ctl = (gu32*)(ws + WS_CTL);
    for (int u = tid; u < (LDS_BYTES - RING_BYTES) / 4; u += NWAVES * 64) ((LAS unsigned*)(lds + RING_BYTES))[u] = 0u;
    __syncthreads();
    int nst = 0; if (DIAG_B >= 0 && bx == 0 && tid == 0) ((GAS unsigned long long*)(args.ws + WS_CTL + 262144))[63] = __builtin_amdgcn_s_memrealtime();
    XcdBarrier bar = xcd_barrier_post((unsigned*)(ctl + CW_BAR) + (seg < 0 ? 0 : seg) * XCD_BAR_WORDS, MISC + 8);
    bf16* Wmoegu = (bf16*)(ws + WS_MOEGU); bf16* Wmoed = (bf16*)(ws + WS_MOED);
    bf16* vfirst = (bf16*)(ws + WS_VFIRST);
    bf16* zb = (bf16*)(ws + WS_Z); bf16* mix = (bf16*)(ws + WS_MIX); float* preln = (float*)(ws + WS_PRELN);
    float* gla_logf = (float*)(ws + WS_PREP); float* rwb = (float*)(ws + WS_PREP + 8 * MiB);
    const float* PB = (const float*)(ws + WS_MISC + MS_PARAMS); int* top_e = (int*)(ws + WS_MISC + MS_TOPE); float* top_g = (float*)(ws + WS_MISC + MS_TOPG);
    int* tok_row = (int*)(ws + WS_MISC + MS_TOKROW); int* row_tok = (int*)(ws + WS_MISC + MS_ROWTOK); int* tile_e = (int*)(ws + WS_MISC + MS_TILEE);
    float* xf = args.out;

    {
    DUP_BEGIN(0)
    {
        PHASE_IDS(); LAS float* scr = (LAS float*)(lds + wave * 16384);
        constexpr int I_WIN = 16 * 99, I_VD = 16, I_SQ = 16 * 32, I_FG = 16 * 88, I_FD = 44 * 32, I_PP = 4 * 32;
        constexpr int NIT = 2 * I_WIN + I_VD + 4 * I_SQ + 2 * I_FG + I_FD + 2 * I_PP;
        for (int it = gw; it < NIT; it += NGW) {
            int r = it; const float* src; int ldw, nblocks, ncols, dld, il = 0, rowoff = 0; bf16* dst;
            if (r < I_WIN) { src = IN(2); ldw = PIN; nblocks = 99; ncols = PIN; dst = (bf16*)(ws + WS_WIN0); dld = D; }
            else if ((r -= I_WIN) < I_WIN) { src = IN(2) + (size_t)D * PIN; ldw = PIN; nblocks = 99; ncols = PIN; dst = (bf16*)(ws + WS_WIN1); dld = D; }
            else if ((r -= I_WIN) < I_VD) { src = IN(21); ldw = 8; nblocks = 1; ncols = 8; dst = (bf16*)(ws + WS_WIN1); dld = D; rowoff = PIN; }
            else if ((r -= I_VD) < I_SQ) { src = IN(3); ldw = D; nblocks = 32; ncols = D; dst = (bf16*)(ws + WS_WOUT0); dld = D; }
            else if ((r -= I_SQ) < I_SQ) { src = IN(3) + (size_t)D * D; ldw = D; nblocks = 32; ncols = D; dst = (bf16*)(ws + WS_WOUT1); dld = D; }
            else if ((r -= I_SQ) < I_SQ) { src = IN(37); ldw = D; nblocks = 32; ncols = D; dst = (bf16*)(ws + WS_PG0); dld = D; }
            else if ((r -= I_SQ) < I_SQ) { src = IN(37) + (size_t)D * D; ldw = D; nblocks = 32; ncols = D; dst = (bf16*)(ws + WS_PG1); dld = D; }
            else if ((r -= I_SQ) < I_FG) { src = IN(29); ldw = DFF; nblocks = 88; ncols = DFF; dst = (bf16*)(ws + WS_FGU); dld = D; il = 1; }
            else if ((r -= I_FG) < I_FG) { src = IN(30); ldw = DFF; nblocks = 88; ncols = DFF; dst = (bf16*)(ws + WS_FGU); dld = D; il = 1; rowoff = 128; }
            else if ((r -= I_FG) < I_FD) { src = IN(31); ldw = D; nblocks = 32; ncols = D; dst = (bf16*)(ws + WS_FD); dld = DFF; }
            else if ((r -= I_FD) < I_PP) { src = IN(36); ldw = D; nblocks = 32; ncols = D; dst = (bf16*)(ws + WS_PP0); dld = 256; }
            else { r -= I_PP; src = IN(36) + (size_t)256 * D; ldw = D; nblocks = 32; ncols = D; dst = (bf16*)(ws + WS_PP1); dld = 256; }
            tr_job(src, ldw, nblocks, ncols, dst, dld, il, rowoff, r, scr, lane);
        }
        moe_weights_half(IN(33), IN(34), IN(35), Wmoegu, Wmoed, 0, gw, NGW, scr, lane);
        const size_t gtid = (size_t)vcu * (NWAVES * 64) + tid, nth = (size_t)G * NWAVES * 64;
        for (size_t i = gtid * 8; i < (size_t)(ZLD - PIN) * D; i += nth * 8) *(GAS v4u*)((bf16*)(ws + WS_WIN0) + (size_t)PIN * D + i) = (v4u){0u, 0u, 0u, 0u};
        for (size_t i = gtid * 8; i < (size_t)(ZLD - PIN - 8) * D; i += nth * 8) *(GAS v4u*)((bf16*)(ws + WS_WIN1) + (size_t)(PIN + 8) * D + i) = (v4u){0u, 0u, 0u, 0u};
        cvt_rows(IN(0), (bf16*)(ws + WS_XB0), (size_t)T * D, gtid, nth);
        cvt_rows(IN(1), (bf16*)(ws + WS_PB0), (size_t)T * 256, gtid, nth);
        cvt_rows(IN(1) + (size_t)T * 256, (bf16*)(ws + WS_PB1), (size_t)T * 256, gtid, nth);
        {
            float* PW = (float*)(ws + WS_MISC + MS_PARAMS);
#define CPY(idx, off, n) do { const float* _s = IN(idx); for (int _i = (int)gtid; _i < (n); _i += (int)nth) PW[(off) + _i] = _s[_i]; } while (0)
            CPY(4, P_GKUP, 4096); CPY(5, P_GKB, 256); CPY(6, P_GNW, 128); CPY(7, P_HLB, 512); CPY(8, P_HNW, 128); CPY(9, P_SINK, 8); CPY(10, P_MU, 1664); CPY(11, P_W0, 512);
            CPY(12, P_WUP, 8192); CPY(13, P_A0, 512); CPY(14, P_AUP, 8192); CPY(15, P_GUP, 16384); CPY(16, P_KK, 512); CPY(17, P_KA, 512); CPY(18, P_RK, 512); CPY(19, P_LNXW, 512);
            CPY(20, P_LNXB, 512); CPY(22, P_VMU, 8); CPY(23, P_V0, 256); CPY(24, P_VUP, 2048); CPY(25, P_LN1G, 2048); CPY(26, P_LN1B, 2048); CPY(27, P_LN2G, 2048); CPY(28, P_LN2B, 2048);
            CPY(32, P_ROUTER, 8192);
#undef CPY
            if (bx == 0 && tid < 256) { const float* hl = IN(7); const float a = hl[tid], b = hl[256 + tid]; const float m = fmaxf(a, b); const float ea = __expf(a - m), eb = __expf(b - m); PW[P_LBS + tid] = 0.f; PW[P_LBS + 256 + tid] = eb / (ea + eb); }
        }
        for (int i = (int)gtid; i < MOE_MAXROWS; i += (int)nth) row_tok[i] = 0;
    }
    DUP_END();

    }
    layer_body<0, true, true, true>(args, lds, bar, tid, lane, wave, G, bx, vcu, gw, NGW, nst);
    GRID_BAR();
    layer_body<1, true, true, true>(args, lds, bar, tid, lane, wave, G, bx, vcu, gw, NGW, nst);
}
#undef IN


extern "C" void kernel_launch(void* const* d_in, const int* in_sizes, int n_in, void* d_out, int out_size, void* d_ws, size_t ws_size, hipStream_t stream) {
    static int grid = 0;
    if (grid == 0) {
        if (n_in != 38 || in_sizes[0] != T * D || out_size != T * D || ws_size < WS_END) { fprintf(stderr, "kernel_launch: unexpected problem (n_in %d, in0 %d, out %d, ws %zu < %zu)\n", n_in, n_in > 0 ? in_sizes[0] : -1, out_size, ws_size, (size_t)WS_END); grid = -1; return; }
        int dev = 0, cus = 0, per_cu = 0;
        if (hipGetDevice(&dev) != hipSuccess || hipDeviceGetAttribute(&cus, hipDeviceAttributeMultiprocessorCount, dev) != hipSuccess) { grid = -1; return; }
        if (hipFuncSetAttribute((const void*)mega_fwd, hipFuncAttributeMaxDynamicSharedMemorySize, LDS_BYTES) != hipSuccess) { fprintf(stderr, "kernel_launch: hipFuncSetAttribute failed\n"); grid = -1; return; }
        if (hipOccupancyMaxActiveBlocksPerMultiprocessor(&per_cu, (const void*)mega_fwd, NWAVES * 64, LDS_BYTES) != hipSuccess || per_cu < 1) { fprintf(stderr, "kernel_launch: occupancy query says %d\n", per_cu); per_cu = 1; }
        (void)hipGetLastError();
        grid = cus;
    }
    if (grid < 0) return;
    if (hipMemsetAsync((char*)d_ws + WS_CTL, 0, CTL_BYTES, stream) != hipSuccess) { fprintf(stderr, "kernel_launch: memset failed\n"); return; }
    Args a{};
    for (int i = 0; i < 38; ++i) a.in[i] = (const float*)d_in[i];
    a.out = (float*)d_out; a.ws = (unsigned char*)d_ws;
    int seg = -1; void* kargs[] = {&a, &seg};
    hipError_t e = hipLaunchCooperativeKernel((const void*)mega_fwd, dim3(grid), dim3(NWAVES * 64), kargs, LDS_BYTES, stream);
    if (e != hipSuccess) fprintf(stderr, "kernel_launch: cooperative launch failed: %s (grid %d)\n", hipGetErrorString(e), grid);
}
```

```cpp
#define SUBDUP 0
#define SUBDUP_N 1
#include <hip/hip_runtime.h>
#include <cstdio>
#include <cstdint>
namespace pg8 {
#define PG8_LAS __attribute__((address_space(3)))
typedef unsigned short bf16_t;
typedef short bf16x8 __attribute__((ext_vector_type(8)));
typedef float f32x4 __attribute__((ext_vector_type(4)));
typedef unsigned u32x4 __attribute__((ext_vector_type(4)));
constexpr int BM = 256, BK = 64, HALF = 128, HTB = HALF * BK * 2  , STAGE_BYTES = 8 * HTB, NXCD = 8, WGM = 8;

__host__ __device__ __forceinline__ int lds_byte(int r, int c) { const int st = (r >> 4) * 2 + (c >> 5), rr = r & 15, cc = c & 31, ob = rr * 64 + cc * 2; return st * 1024 + (ob ^ (((ob >> 9) & 1) << 5)); }
__host__ __device__ __forceinline__ void stage_rc(int b, int& R, int& C) { const int st = b / 1024, sb = b % 1024, swz = sb ^ (((sb >> 9) & 1) << 5); R = (st >> 1) * 16 + swz / 64; C = (st & 1) * 32 + (swz % 64) / 2; }
__host__ __device__ __forceinline__ int perm32(int rho) { const int n = rho >> 4, i = rho & 15; return 8 * (i >> 2) + 4 * n + (i & 3); }

struct Unit { int pm, pn, on; };
struct Gemm { const bf16_t* A; const bf16_t* Bt; int M, N, K; };

struct StaticOrder {
    int nM, nN, nwg, G, c;
    __host__ __device__ void init(int M, int N, int G_, int c_) { nM = M / BM; nN = N / BM; nwg = nM * nN; G = G_; c = c_; }
    __host__ __device__ bool next(int i, Unit& u) const {
        const long L = (long)i * G + c; if (L >= nwg) return false;
        int wgid = (int)L; { const int q = nwg / NXCD, r = nwg % NXCD, xcd = wgid % NXCD, off = wgid / NXCD; wgid = (xcd < r ? xcd * (q + 1) : r * (q + 1) + (xcd - r) * q) + off; }
        const int nig = WGM * nN, gid = wgid / nig, fm = gid * WGM, gsz = (nM - fm) < WGM ? (nM - fm) : WGM;
        u.pm = fm + ((wgid % nig) % gsz); u.pn = (wgid % nig) / gsz; u.on = u.pn; return true;
    }
    __device__ __forceinline__ void a_ready(const Unit&) const {}
    __device__ __forceinline__ void done(const Unit&) const {}
};

typedef __bf16 bf16v2_t __attribute__((ext_vector_type(2)));
__device__ __forceinline__ unsigned cvt_pk_bf16(float lo, float hi) { bf16v2_t v; v[0] = (__bf16)lo; v[1] = (__bf16)hi; return __builtin_bit_cast(unsigned, v); }
__device__ __forceinline__ float fast_sigmoid(float x) { return __builtin_amdgcn_rcpf(1.f + __expf(-x)); }
struct EpiStoreBf16 {
    static constexpr bool PERM = true, AFTER_DRAIN = false;
    bf16_t* O; int ldc;
    __device__ __forceinline__ void operator()(const f32x4 (&acc)[2][2][4][2], const Unit& u, int wr, int wc, int fr, int fq) const {
        const int row0 = u.pm * BM + wr * 64 + fr, col0 = u.on * BM + wc * 32 + 8 * fq;
#pragma unroll
        for (int ai = 0; ai < 2; ++ai)
#pragma unroll
            for (int m = 0; m < 4; ++m) { bf16_t* rowp = O + (size_t)(row0 + ai * HALF + m * 16) * ldc + col0;
#pragma unroll
                for (int bj = 0; bj < 2; ++bj) { const f32x4 v0 = acc[ai][bj][m][0], v1 = acc[ai][bj][m][1];
                    u32x4 w; w.x = cvt_pk_bf16(v0[0], v0[1]); w.y = cvt_pk_bf16(v0[2], v0[3]); w.z = cvt_pk_bf16(v1[0], v1[1]); w.w = cvt_pk_bf16(v1[2], v1[3]);
                    *(u32x4*)(rowp + bj * HALF) = w; } }
    }
};
struct EpiResF32 {
    static constexpr bool PERM = false, AFTER_DRAIN = false;
    const float* res; float* out; int ldc; float alpha;
    __device__ __forceinline__ void operator()(const f32x4 (&acc)[2][2][4][2], const Unit& u, int wr, int wc, int fr, int fq) const {
        const int row0 = u.pm * BM + wr * 64 + fr, col0 = u.on * BM + wc * 32 + 4 * fq;
#pragma unroll
        for (int ai = 0; ai < 2; ++ai)
#pragma unroll
            for (int m = 0; m < 4; ++m) { const size_t off = (size_t)(row0 + ai * HALF + m * 16) * ldc + col0;
#pragma unroll
                for (int bj = 0; bj < 2; ++bj)
#pragma unroll
                    for (int n = 0; n < 2; ++n) { const f32x4 r = *(const f32x4*)(res + off + bj * HALF + n * 16); *(f32x4*)(out + off + bj * HALF + n * 16) = r * alpha + acc[ai][bj][m][n]; }
                asm volatile("" ::: "memory"); }
    }
};
struct EpiResBf16 {
    static constexpr bool PERM = true, AFTER_DRAIN = false;
    const float* res; bf16_t* out; int ldc; float alpha;
    __device__ __forceinline__ void operator()(const f32x4 (&acc)[2][2][4][2], const Unit& u, int wr, int wc, int fr, int fq) const {
        const int row0 = u.pm * BM + wr * 64 + fr, col0 = u.on * BM + wc * 32 + 8 * fq;
#pragma unroll
        for (int ai = 0; ai < 2; ++ai)
#pragma unroll
            for (int m = 0; m < 4; ++m) { const size_t off = (size_t)(row0 + ai * HALF + m * 16) * ldc + col0;
#pragma unroll
                for (int bj = 0; bj < 2; ++bj) { const f32x4 r0 = *(const f32x4*)(res + off + bj * HALF), r1 = *(const f32x4*)(res + off + bj * HALF + 4);
                    const f32x4 v0 = r0 * alpha + acc[ai][bj][m][0], v1 = r1 * alpha + acc[ai][bj][m][1];
                    u32x4 w; w.x = cvt_pk_bf16(v0[0], v0[1]); w.y = cvt_pk_bf16(v0[2], v0[3]); w.z = cvt_pk_bf16(v1[0], v1[1]); w.w = cvt_pk_bf16(v1[2], v1[3]);
                    *(u32x4*)(out + off + bj * HALF) = w; }
                asm volatile("" ::: "memory"); }
    }
};
struct EpiSwiglu {
    static constexpr bool PERM = true, AFTER_DRAIN = false;
    bf16_t* H; int ldc;
    __device__ __forceinline__ void operator()(const f32x4 (&acc)[2][2][4][2], const Unit& u, int wr, int wc, int fr, int fq) const {
        const int row0 = u.pm * BM + wr * 64 + fr, col0 = u.on * HALF + wc * 32 + 8 * fq;
#pragma unroll
        for (int ai = 0; ai < 2; ++ai)
#pragma unroll
            for (int m = 0; m < 4; ++m) {
                f32x4 h[2];
#pragma unroll
                for (int n = 0; n < 2; ++n) { const f32x4 g = acc[ai][0][m][n], up = acc[ai][1][m][n];
#pragma unroll
                    for (int i = 0; i < 4; ++i) h[n][i] = g[i] * fast_sigmoid(g[i]) * up[i]; }
                u32x4 w; w.x = cvt_pk_bf16(h[0][0], h[0][1]); w.y = cvt_pk_bf16(h[0][2], h[0][3]); w.z = cvt_pk_bf16(h[1][0], h[1][1]); w.w = cvt_pk_bf16(h[1][2], h[1][3]);
                *(u32x4*)(H + (size_t)(row0 + ai * HALF + m * 16) * ldc + col0) = w; }
    }
};
struct EpiPle {
    static constexpr bool PERM = false, AFTER_DRAIN = false;
    float* x; const bf16_t* pp; bf16_t* xbo; int ldc; float oscale;
    __device__ __forceinline__ void operator()(const f32x4 (&acc)[2][2][4][2], const Unit& u, int wr, int wc, int fr, int fq) const {
        typedef unsigned u32x2v __attribute__((ext_vector_type(2)));
        const int row0 = u.pm * BM + wr * 64 + fr, col0 = u.on * BM + wc * 32 + 4 * fq;
#pragma unroll
        for (int ai = 0; ai < 2; ++ai)
#pragma unroll
            for (int m = 0; m < 4; ++m) { const size_t off = (size_t)(row0 + ai * HALF + m * 16) * ldc + col0;
#pragma unroll
                for (int bj = 0; bj < 2; ++bj)
#pragma unroll
                    for (int n = 0; n < 2; ++n) { const size_t o = off + bj * HALF + n * 16;
                        const f32x4 xv = *(const f32x4*)(x + o); const u32x2v pw = *(const u32x2v*)(pp + o); const f32x4 a = acc[ai][bj][m][n];
                        f32x4 pv; pv[0] = __uint_as_float(pw.x << 16); pv[1] = __uint_as_float(pw.x & 0xffff0000u); pv[2] = __uint_as_float(pw.y << 16); pv[3] = __uint_as_float(pw.y & 0xffff0000u);
                        f32x4 xn;
#pragma unroll
                        for (int i = 0; i < 4; ++i) xn[i] = (xv[i] + fast_sigmoid(a[i]) * pv[i]) * oscale;
                        *(f32x4*)(x + o) = xn; if (xbo) { u32x2v w; w.x = cvt_pk_bf16(xn[0], xn[1]); w.y = cvt_pk_bf16(xn[2], xn[3]); *(u32x2v*)(xbo + o) = w; } }
                asm volatile("" ::: "memory"); }
    }
};
struct MoeOrder {
    const int* tile_e; int nrt, ncol, G, c;
    __device__ __forceinline__ bool next(int i, Unit& u) const {
        const int L = i * G + c; if (L >= nrt * ncol) return false;
        const int rt = L / ncol, cn = L - rt * ncol; const int e = tile_e[rt];
        u.pm = rt; u.pn = e * ncol + cn; u.on = cn; return true;
    }
    __device__ __forceinline__ void a_ready(const Unit&) const {}
    __device__ __forceinline__ void done(const Unit&) const {}
};

template <class Epi, class Sched, bool ALIGN_EPI = false, bool SP2 = false>
__device__ __forceinline__ void gemm_phase(PG8_LAS unsigned char* lds, const Gemm g, const Sched& S, const Epi& E) {
    int tid_ = threadIdx.x; asm volatile("" : "+v"(tid_));
    const int tid = tid_, wid = __builtin_amdgcn_readfirstlane(tid >> 6), lane = tid & 63, wr = wid >> 2, wc = wid & 3, fr = lane & 15, fq = lane >> 4;
    const int K = g.K, nt = K / BK;
    unsigned voffA[2], voffB[2];
#pragma unroll
    for (int i = 0; i < 2; ++i) { int R, C; stage_rc(tid * 16 + i * 8192, R, C); const int Rb = Epi::PERM ? ((R & ~31) + perm32(R & 31)) : R;
        voffA[i] = (unsigned)(R * K + C) * 2u; voffB[i] = (unsigned)(Rb * K + C) * 2u; }
    const size_t kstep = (size_t)(BK * 2);
    const size_t hstep = (size_t)HALF * K * 2;
    const size_t tstep = 2 * hstep;
    const unsigned ldsw = (unsigned)wid * 1024u;
    const int aoff = lds_byte(wr * 64 + fr, fq * 8), boff = lds_byte(wc * 32 + fr, fq * 8);
#define PG8_SA(b, h) (((b) * 2 + (h)) * HTB)
#define PG8_SB(b, h) ((4 + (b) * 2 + (h)) * HTB)
#define PG8_STAGE(bufoff, gbase, voff) do { _Pragma("unroll") for (int _i = 0; _i < 2; ++_i) \
        __builtin_amdgcn_global_load_lds((const unsigned*)((const char*)(gbase) + (voff)[_i]), (PG8_LAS unsigned*)(lds + (bufoff) + ldsw + _i * 8192), 16, 0, 0); } while (0)
#define PG8_LDA(dst, b, h) do { _Pragma("unroll") for (int m = 0; m < 4; ++m) _Pragma("unroll") for (int k = 0; k < 2; ++k) dst[m][k] = *(const PG8_LAS bf16x8*)(lds + PG8_SA(b, h) + aoff + m * 2048 + k * 1024); } while (0)
#define PG8_LDB(dst, b, h) do { _Pragma("unroll") for (int n = 0; n < 2; ++n) _Pragma("unroll") for (int k = 0; k < 2; ++k) dst[n][k] = *(const PG8_LAS bf16x8*)(lds + PG8_SB(b, h) + boff + n * 2048 + k * 1024); } while (0)
#define PG8_MMA(ai, bj, At, Bt) do { __builtin_amdgcn_s_setprio(1); _Pragma("unroll") for (int m = 0; m < 4; ++m) _Pragma("unroll") for (int n = 0; n < 2; ++n) _Pragma("unroll") for (int k = 0; k < 2; ++k) \
        acc[ai][bj][m][n] = __builtin_amdgcn_mfma_f32_16x16x32_bf16(Bt[n][k], At[m][k], acc[ai][bj][m][n], 0, 0, 0); __builtin_amdgcn_s_setprio(0); } while (0)
#define PG8_WAIT_V(n) asm volatile("s_waitcnt vmcnt(" #n ")" ::: "memory")
#define PG8_WAIT_L(n) asm volatile("s_waitcnt lgkmcnt(" #n ")" ::: "memory")
#define PG8_BAR __builtin_amdgcn_s_barrier()
#define PG8_SCHED __builtin_amdgcn_sched_barrier(0)
    Unit cur, nxt; int ui = 0;
    if (!S.next(0, cur)) return;
    f32x4 acc[2][2][4][2];
#pragma unroll
    for (int a = 0; a < 2; ++a)
#pragma unroll
        for (int b = 0; b < 2; ++b)
#pragma unroll
            for (int m = 0; m < 4; ++m)
#pragma unroll
                for (int n = 0; n < 2; ++n) acc[a][b][m][n] = (f32x4){0.f, 0.f, 0.f, 0.f};
    bf16x8 At[4][2], B0[2][2], B1[2][2];
    const char* cA = (const char*)g.A + (size_t)cur.pm * tstep; const char* cB = (const char*)g.Bt + (size_t)cur.pn * tstep;
    S.a_ready(cur);
    if constexpr (SP2) {
        PG8_STAGE(PG8_SB(0, 0), cB, voffB); PG8_STAGE(PG8_SB(0, 1), cB + hstep, voffB); PG8_STAGE(PG8_SA(0, 0), cA, voffA); PG8_STAGE(PG8_SA(0, 1), cA + hstep, voffA);
        if (wr == 1) PG8_BAR;
        PG8_WAIT_V(2); PG8_BAR;
        PG8_STAGE(PG8_SB(1, 0), cB + kstep, voffB); PG8_STAGE(PG8_SA(1, 0), cA + kstep, voffA); PG8_STAGE(PG8_SB(1, 1), cB + hstep + kstep, voffB);
        PG8_WAIT_V(6); PG8_BAR;
    } else {
        PG8_STAGE(PG8_SB(0, 0), cB, voffB); PG8_STAGE(PG8_SA(0, 0), cA, voffA); PG8_STAGE(PG8_SB(0, 1), cB + hstep, voffB); PG8_STAGE(PG8_SA(0, 1), cA + hstep, voffA);
        if (wr == 1) PG8_BAR;
        PG8_WAIT_V(4); PG8_BAR;
        PG8_STAGE(PG8_SB(1, 0), cB + kstep, voffB); PG8_STAGE(PG8_SA(1, 0), cA + kstep, voffA); PG8_STAGE(PG8_SB(1, 1), cB + hstep + kstep, voffB);
        PG8_WAIT_V(6); PG8_BAR;
    }
    for (;;) {
        const bool has_next = S.next(ui + 1, nxt);
        const char* nA = has_next ? (const char*)g.A + (size_t)nxt.pm * tstep : cA; const char* nB = has_next ? (const char*)g.Bt + (size_t)nxt.pn * tstep : cB;
        for (int t = 0; t < nt; t += 2) {
            const bool last = (t == nt - 2);
            const char* a1 = cA + (size_t)(t + 1) * kstep;
            const char* a2 = last ? nA : cA + (size_t)(t + 2) * kstep; const char* b2 = last ? nB : cB + (size_t)(t + 2) * kstep;
            const char* a3 = a2 + kstep; const char* b3 = b2 + kstep;
            if (last && has_next) S.a_ready(nxt);
            if constexpr (SP2) {
            PG8_LDB(B0, 0, 0); PG8_LDB(B1, 0, 1); PG8_SCHED; PG8_LDA(At, 0, 0); PG8_STAGE(PG8_SA(1, 1), a1 + hstep, voffA);
            PG8_WAIT_V(8); PG8_WAIT_L(0); PG8_BAR; PG8_MMA(0, 0, At, B0); PG8_MMA(0, 1, At, B1); PG8_BAR; PG8_SCHED;
            PG8_LDA(At, 0, 1); PG8_STAGE(PG8_SB(0, 0), b2, voffB); PG8_STAGE(PG8_SB(0, 1), b2 + hstep, voffB); PG8_STAGE(PG8_SA(0, 0), a2, voffA);
            PG8_WAIT_V(8); PG8_WAIT_L(0); PG8_BAR; PG8_MMA(1, 0, At, B0); PG8_MMA(1, 1, At, B1); PG8_BAR; PG8_SCHED;
            PG8_LDB(B0, 1, 0); PG8_LDB(B1, 1, 1); PG8_SCHED; PG8_LDA(At, 1, 0); PG8_STAGE(PG8_SA(0, 1), a2 + hstep, voffA);
            PG8_WAIT_V(8); PG8_WAIT_L(0); PG8_BAR; PG8_MMA(0, 0, At, B0); PG8_MMA(0, 1, At, B1); PG8_BAR; PG8_SCHED;
            PG8_LDA(At, 1, 1); PG8_STAGE(PG8_SB(1, 0), b3, voffB); PG8_STAGE(PG8_SB(1, 1), b3 + hstep, voffB); PG8_STAGE(PG8_SA(1, 0), a3, voffA);
            PG8_WAIT_V(8); PG8_WAIT_L(0); PG8_BAR; PG8_MMA(1, 0, At, B0); PG8_MMA(1, 1, At, B1); PG8_BAR; PG8_SCHED;
            } else {
            PG8_LDB(B0, 0, 0); PG8_SCHED; PG8_LDA(At, 0, 0); PG8_STAGE(PG8_SA(1, 1), a1 + hstep, voffA);
            PG8_WAIT_L(8); PG8_BAR; PG8_WAIT_L(0); PG8_MMA(0, 0, At, B0); PG8_BAR; PG8_SCHED;
            PG8_LDB(B1, 0, 1); PG8_STAGE(PG8_SB(0, 0), b2, voffB);
            PG8_BAR; PG8_WAIT_L(0); PG8_MMA(0, 1, At, B1); PG8_BAR;
            PG8_LDA(At, 0, 1); PG8_STAGE(PG8_SA(0, 0), a2, voffA);
            PG8_BAR; PG8_WAIT_L(0); PG8_MMA(1, 0, At, B0); PG8_BAR; PG8_SCHED;
            PG8_STAGE(PG8_SB(0, 1), b2 + hstep, voffB);
            PG8_WAIT_V(6); PG8_BAR; PG8_MMA(1, 1, At, B1); PG8_BAR;
            PG8_LDB(B0, 1, 0); PG8_SCHED; PG8_LDA(At, 1, 0); PG8_STAGE(PG8_SA(0, 1), a2 + hstep, voffA);
            PG8_WAIT_L(8); PG8_BAR; PG8_WAIT_L(0); PG8_MMA(0, 0, At, B0); PG8_BAR; PG8_SCHED;
            PG8_LDB(B1, 1, 1); PG8_STAGE(PG8_SB(1, 0), b3, voffB);
            PG8_BAR; PG8_WAIT_L(0); PG8_MMA(0, 1, At, B1); PG8_BAR;
            PG8_LDA(At, 1, 1); PG8_STAGE(PG8_SA(1, 0), a3, voffA);
            PG8_BAR; PG8_WAIT_L(0); PG8_MMA(1, 0, At, B0); PG8_BAR; PG8_SCHED;
            PG8_STAGE(PG8_SB(1, 1), b3 + hstep, voffB);
            PG8_WAIT_V(6); PG8_BAR; PG8_MMA(1, 1, At, B1); PG8_BAR;
            }
        }
        if constexpr (ALIGN_EPI) { if (wr == 0) PG8_BAR; }
        if constexpr (!Epi::AFTER_DRAIN) { E(acc, cur, wr, wc, fr, fq); S.done(cur); }
        if (!has_next) break;
#pragma unroll
        for (int a = 0; a < 2; ++a)
#pragma unroll
            for (int b = 0; b < 2; ++b)
#pragma unroll
                for (int m = 0; m < 4; ++m)
#pragma unroll
                    for (int n = 0; n < 2; ++n) acc[a][b][m][n] = (f32x4){0.f, 0.f, 0.f, 0.f};
        cur = nxt; cA = nA; cB = nB; ++ui;
        if constexpr (ALIGN_EPI) { if (wr == 1) PG8_BAR; }
    }
    PG8_WAIT_V(0);
    if constexpr (!ALIGN_EPI) { if (wr == 0) PG8_BAR; }
    PG8_BAR;
    if constexpr (Epi::AFTER_DRAIN) { E.fused(acc, cur, wr, wc, fr, fq, lds, wid, lane); S.done(cur); }
#undef PG8_SA
#undef PG8_SB
#undef PG8_STAGE
#undef PG8_LDA
#undef PG8_LDB
#undef PG8_MMA
#undef PG8_WAIT_V
#undef PG8_WAIT_L
#undef PG8_BAR
#undef PG8_SCHED
}
}

#ifndef MEGA_ALL
#define MEGA_ALL 0
#endif
#define PG8_SP2 true
#define PG8_ALIGN true
constexpr int NWAVES = 8;
constexpr int T = 16384, D = 1024, GW = 256, PIN = 3152, ZLD = 3328;
constexpr int DFF = 2816, NE = 8, DFE = 3584, DFH = 1792;
constexpr int MOE_MAXTILES = 136, MOE_MAXROWS = MOE_MAXTILES * 256;
constexpr float LN_EPS = 1e-5f, RMS_EPS = 1e-6f, GN_EPS = 64e-5f;
constexpr float ALPHA = 1.4142135623730951f;
constexpr int Z_GQ = 0, Z_GK = 128, Z_GV = 256, Z_GG = 512, Z_GGK = 768, Z_HQ = 784, Z_HF = 1040, Z_HI = 1296, Z_HG = 1552,
              Z_SQ = 1808, Z_SK = 2064, Z_SV = 2192, Z_RZ = 2320, Z_VD = 3152;
constexpr size_t MiB = 1u << 20;
constexpr size_t WS_MOEGU = 0, WS_MOED = 56 * MiB;
constexpr size_t WS_WIN0 = 84 * MiB, WS_WIN1 = WS_WIN0 + (size_t)ZLD * D * 2, WS_WOUT0 = 97 * MiB, WS_WOUT1 = 99 * MiB, WS_FGU = 101 * MiB, WS_FD = 112 * MiB,
                 WS_PG0 = 117 * MiB + 512 * 1024, WS_PG1 = WS_PG0 + 2 * MiB, WS_PP0 = WS_PG1 + 2 * MiB, WS_PP1 = WS_PP0 + 512 * 1024;
constexpr size_t WS_XB0 = 123 * MiB, WS_XB1 = 155 * MiB, WS_VFIRST = 187 * MiB, WS_PB0 = 203 * MiB, WS_PB1 = 211 * MiB, WS_MISC = 219 * MiB, WS_CTL = 222 * MiB, CTL_BYTES = 1 * MiB;
constexpr size_t WS_R = 224 * MiB;
constexpr size_t WS_Z = WS_R, WS_MIX = WS_R + 104 * MiB, WS_PREP = WS_R + 136 * MiB, WS_PRELN = WS_R + 136 * MiB;
constexpr size_t WS_HD = WS_R, WS_HM = WS_R, WS_XG = WS_R + 119 * MiB, WS_Y1 = WS_R + 187 * MiB, WS_PPO = WS_R;
constexpr size_t WS_RWPACK = WS_XB0;
constexpr size_t WS_GLPACK = WS_PREP, WS_HGPACK = WS_PREP + 20 * MiB, WS_RAW = WS_PREP + 68 * MiB, WS_GOUT = WS_PREP + 116 * MiB, WS_VOUT = WS_PREP + 124 * MiB, WS_BC = WS_PREP + 132 * MiB;
constexpr size_t WS_SST = WS_PREP + 133 * MiB, WS_MT = WS_PREP + 145 * MiB;
constexpr size_t MS_HIST = 1280 * 1024;
constexpr size_t MS_DSC = 1536 * 1024;
constexpr size_t WS_END = 480 * MiB + 27 * MiB;
static_assert(WS_MT + 2 * MiB <= WS_END && MS_DSC + 131072 <= 3 * MiB, "scan map");
static_assert(WS_XB1 == WS_XB0 + 32 * MiB && WS_VFIRST == WS_XB1 + 32 * MiB && WS_BC + 1 * MiB <= WS_END, "mixer scratch map");
static_assert(WS_WIN1 + (size_t)ZLD * D * 2 <= WS_WOUT0 && WS_PP1 + 512 * 1024 <= WS_XB0, "weights map");
static_assert(WS_HM + (size_t)MOE_MAXROWS * DFH * 2 <= WS_XG && WS_XG + (size_t)MOE_MAXROWS * D * 2 <= WS_Y1 && WS_Y1 + (size_t)MOE_MAXROWS * D * 2 <= WS_END, "moe map");
static_assert(WS_PREP + 120 * MiB <= WS_END && WS_Z + (size_t)T * ZLD * 2 <= WS_MIX, "mixer map");
constexpr size_t MS_TOPE = 65536, MS_TOPG = MS_TOPE + 131072, MS_TOKROW = MS_TOPG + 131072, MS_ROWTOK = MS_TOKROW + 131072, MS_TILEE = MS_ROWTOK + 196608;
constexpr size_t MS_PARAMS = 1 * MiB;
constexpr int P_GKUP = 0, P_GKB = P_GKUP + 2 * 2048, P_GNW = P_GKB + 2 * 128, P_HLB = P_GNW + 2 * 64, P_HNW = P_HLB + 2 * 256, P_SINK = P_HNW + 2 * 64, P_MU = P_SINK + 8,
              P_W0 = P_MU + 2 * 832, P_WUP = P_W0 + 2 * 256, P_A0 = P_WUP + 2 * 4096, P_AUP = P_A0 + 2 * 256, P_GUP = P_AUP + 2 * 4096, P_KK = P_GUP + 2 * 8192, P_KA = P_KK + 2 * 256,
              P_RK = P_KA + 2 * 256, P_LNXW = P_RK + 2 * 256, P_LNXB = P_LNXW + 2 * 256, P_VMU = P_LNXB + 2 * 256, P_V0 = P_VMU + 8, P_VUP = P_V0 + 256, P_LN1G = P_VUP + 2048,
              P_LN1B = P_LN1G + 2048, P_LN2G = P_LN1B + 2048, P_LN2B = P_LN2G + 2048, P_ROUTER = P_LN2B + 2048, P_LBS = P_ROUTER + 8192, P_END = P_LBS + 512;
static_assert(P_END * 4 <= 1 * MiB, "params block");
constexpr int CW_BAR = 4096, CW_MOE = 16384;
constexpr int LDS_BYTES = 147456, RING_BYTES = 131072, MISC_OFF = RING_BYTES + 320;

#define GAS __attribute__((address_space(1)))
#define LAS __attribute__((address_space(3)))
typedef unsigned short bf16;
typedef unsigned v4u __attribute__((ext_vector_type(4)));
typedef unsigned v2u __attribute__((ext_vector_type(2)));
typedef float f32x4 __attribute__((ext_vector_type(4)));
typedef short bf16x8 __attribute__((ext_vector_type(8)));
typedef GAS unsigned gu32;
#define RLX_AGENT __ATOMIC_RELAXED, __HIP_MEMORY_SCOPE_AGENT
#define LDS_WAIT() asm volatile("s_waitcnt lgkmcnt(0)" ::: "memory")
#define VM_WAIT() asm volatile("s_waitcnt vmcnt(0)" ::: "memory")
__device__ __forceinline__ unsigned f2bf(float f) { unsigned u = __builtin_bit_cast(unsigned, f); return (u + 0x7fffu + ((u >> 16) & 1u)) >> 16; }
__device__ __forceinline__ unsigned pk2(float lo, float hi) { return f2bf(lo) | (f2bf(hi) << 16); }
__device__ __forceinline__ float bf2f(unsigned short b) { return __uint_as_float(((unsigned)b) << 16); }
__device__ __forceinline__ float rcpf_(float x) { return __builtin_amdgcn_rcpf(x); }
__device__ __forceinline__ float sigmoidf_(float x) { return rcpf_(1.f + __expf(-x)); }
__device__ __forceinline__ float siluf_(float x) { return x * rcpf_(1.f + __expf(-x)); }
__device__ __forceinline__ float softplusf_(float x) { return fmaxf(x, 0.f) + __logf(1.f + __expf(-fabsf(x))); }
__device__ __forceinline__ float logsigmoidf_(float x) { return -softplusf_(-x); }
__device__ __forceinline__ float tanhf_(float x) { return 1.f - 2.f * rcpf_(1.f + __expf(2.f * x)); }
template <int CTRL> __device__ __forceinline__ float dppf(float v) { return __builtin_bit_cast(float, __builtin_amdgcn_update_dpp(0, __builtin_bit_cast(int, v), CTRL, 0xf, 0xf, false)); }
__device__ __forceinline__ float wave_sum(float v) {
    v += dppf<0x128>(v); v += dppf<0x124>(v); v += dppf<0x122>(v); v += dppf<0x121>(v);
    { float a = v, b = v; asm("s_nop 1\n\tv_permlane16_swap_b32 %0, %1" : "+v"(a), "+v"(b)); v = a + b; }
    { float a = v, b = v; asm("s_nop 1\n\tv_permlane32_swap_b32 %0, %1" : "+v"(a), "+v"(b)); v = a + b; }
    return v;
}
__device__ __forceinline__ float wave_max(float v) {
    v = fmaxf(v, dppf<0x128>(v)); v = fmaxf(v, dppf<0x124>(v)); v = fmaxf(v, dppf<0x122>(v)); v = fmaxf(v, dppf<0x121>(v));
    { float a = v, b = v; asm("s_nop 1\n\tv_permlane16_swap_b32 %0, %1" : "+v"(a), "+v"(b)); v = fmaxf(a, b); }
    { float a = v, b = v; asm("s_nop 1\n\tv_permlane32_swap_b32 %0, %1" : "+v"(a), "+v"(b)); v = fmaxf(a, b); }
    return v;
}
#define XB_TMO      128
#define XB_XCNT(j)  (256  + 64 * (j))
#define XB_XSUB(j)  (1280 + 64 * (j))
#define XB_XGEN(j)  (2304 + 64 * (j))
#define XB_TOP      3328
#define XB_TOPGEN   3392
#define XCD_BAR_WORDS 3456
#define XB_SPIN_CAP (1u << 27)

__device__ __forceinline__ unsigned xb_ld(unsigned* p)              { return __hip_atomic_load(p, __ATOMIC_RELAXED, __HIP_MEMORY_SCOPE_AGENT); }
__device__ __forceinline__ unsigned xb_add(unsigned* p, unsigned v) { return __hip_atomic_fetch_add(p, v, __ATOMIC_RELAXED, __HIP_MEMORY_SCOPE_AGENT); }
__device__ __forceinline__ unsigned xb_xcc_id() { return (unsigned)__builtin_amdgcn_s_getreg((3 << 11) | 20) & 0xFu; }
#define XB_SPIN(cond, bar) do { unsigned _sp = 0; while (cond) { __builtin_amdgcn_s_sleep(1); \
    if ((++_sp & 255u) == 0u) { if (xb_ld(&(bar)[XB_TMO])) break; if (_sp > XB_SPIN_CAP) { atomicAdd(&(bar)[XB_TMO], 1u); break; } } } } while (0)

struct XcdBarrier {
    unsigned* bar; unsigned x;
    volatile LAS unsigned* st;
};

__device__ __forceinline__ XcdBarrier xcd_barrier_post(unsigned* bar, volatile LAS unsigned* st) {
    XcdBarrier b; b.bar = bar; b.x = xb_xcc_id(); b.st = st;
    if (threadIdx.x == 0) (void)xb_add(&bar[XB_XCNT(b.x)], 1u);
    return b;
}
__device__ __forceinline__ void xcd_barrier_complete(unsigned* bar, unsigned x, unsigned& nloc, unsigned& nx) {
    const unsigned G = gridDim.x * gridDim.y * gridDim.z;
    unsigned sum, cnt, mine, sp = 0u;
    for (;;) {
        sum = 0u; cnt = 0u; mine = 0u;
#pragma unroll
        for (unsigned j = 0; j < 16; ++j) { const unsigned c = xb_ld(&bar[XB_XCNT(j)]); sum += c; cnt += (c > 0u) ? 1u : 0u; }
        if (sum == G) break;
        __builtin_amdgcn_s_sleep(1);
        if ((++sp & 255u) == 0u) { if (xb_ld(&bar[XB_TMO])) break; if (sp > XB_SPIN_CAP) { atomicAdd(&bar[XB_TMO], 1u); break; } }
    }
    mine = xb_ld(&bar[XB_XCNT(x)]);
    nloc = mine > 0u ? mine : 1u; nx = cnt > 0u ? cnt : 1u;
}

__device__ __forceinline__ void xcd_barrier(const XcdBarrier& b) {
    asm volatile("s_waitcnt vmcnt(0)" ::: "memory");
    __syncthreads();
    if (threadIdx.x == 0) {
        unsigned* bar = b.bar;
        __builtin_amdgcn_s_waitcnt(0);
        unsigned nloc = b.st[0], nx = b.st[1];
        if (nloc == 0u) { xcd_barrier_complete(bar, b.x, nloc, nx); b.st[0] = nloc; b.st[1] = nx; }
        const unsigned old = xb_add(&bar[XB_XSUB(b.x)], 1u);
        const unsigned gen = old / nloc;
        if (old + 1u == (gen + 1u) * nloc) {
            __builtin_amdgcn_fence(__ATOMIC_RELEASE, "agent");
            asm volatile("s_waitcnt vmcnt(0)" ::: "memory");
            const unsigned og = xb_add(&bar[XB_TOP], 1u);
            const unsigned tg = og / nx;
            if (og + 1u == (tg + 1u) * nx) xb_add(&bar[XB_TOPGEN], 1u);
            else XB_SPIN(xb_ld(&bar[XB_TOPGEN]) == tg, bar);
            __builtin_amdgcn_fence(__ATOMIC_ACQUIRE, "agent");
            xb_add(&bar[XB_XGEN(b.x)], 1u);
            asm volatile("s_waitcnt vmcnt(0)" ::: "memory");
        } else {
            XB_SPIN(xb_ld(&bar[XB_XGEN(b.x)]) == gen, bar);
            __builtin_amdgcn_fence(__ATOMIC_ACQUIRE, "agent");
            asm volatile("s_waitcnt vmcnt(0)" ::: "memory");
        }
    }
    __syncthreads();
}

#ifndef SUBDUP
#define SUBDUP 0
#define SUBDUP_N 1
#endif
#define SUBREP(id) _Pragma("unroll 1") for (int srep_ = 0; srep_ < ((SUBDUP == (id)) ? SUBDUP_N : 1); ++srep_)
constexpr int RW_PACK = 14336;
constexpr int RW_AHAT = 0, RW_W2 = 2048, RW_S2A = 4096, RW_V = 8192, RW_R = 10240, RW_ARK = 12288, RW_P = 13312;
constexpr int RWL_BYTES = 21504;
typedef __bf16 bf16v2_t __attribute__((ext_vector_type(2)));
__device__ __forceinline__ unsigned cvt_pk(float lo, float hi) { bf16v2_t v; v[0] = (__bf16)lo; v[1] = (__bf16)hi; return __builtin_bit_cast(unsigned, v); }
__device__ __forceinline__ bf16x8 pack8(const f32x4& a, const f32x4& b) { v4u p; p.x = cvt_pk(a[0], a[1]); p.y = cvt_pk(a[2], a[3]); p.z = cvt_pk(b[0], b[1]); p.w = cvt_pk(b[2], b[3]); return __builtin_bit_cast(bf16x8, p); }
__device__ __forceinline__ bf16x8 pack8u(const f32x4& a, v2u vb) { v4u p; p.x = cvt_pk(a[0], a[1]); p.y = cvt_pk(a[2], a[3]); p.z = vb.x; p.w = vb.y; return __builtin_bit_cast(bf16x8, p); }
__device__ __forceinline__ bf16x8 frag2(v2u a, v2u b) { v4u p; p.x = a.x; p.y = a.y; p.z = b.x; p.w = b.y; return __builtin_bit_cast(bf16x8, p); }
#define MFMA16(a, b, c) __builtin_amdgcn_mfma_f32_16x16x32_bf16((a), (b), (c), 0, 0, 0)

struct RwkvPrepArgs { const bf16* z; const float* P; bf16* vfirst; unsigned char* pack; bf16* gout; bf16* vout; float* bcout; };
template <int L>
__device__ __forceinline__ void rwkv_prep_wave(const RwkvPrepArgs& A, int hd, int c0, int cstride, int cend, LAS unsigned char* wl, int lane) {
    const int col = hd * 64 + lane, lo = lane & 15, h = lane >> 4;
    const float* P = A.P;
    float wup[16], aup[16], vup[8];
#pragma unroll
    for (int i = 0; i < 16; ++i) { wup[i] = P[P_WUP + L * 4096 + i * 256 + col]; aup[i] = P[P_AUP + L * 4096 + i * 256 + col]; }
#pragma unroll
    for (int i = 0; i < 8; ++i) vup[i] = (L > 0) ? P[P_VUP + i * 256 + col] : 0.f;
    const float w0 = P[P_W0 + L * 256 + col], a0 = P[P_A0 + L * 256 + col], kkp = P[P_KK + L * 256 + col], kap = P[P_KA + L * 256 + col], rkp = P[P_RK + L * 256 + col];
    const float v0p = (L > 0) ? P[P_V0 + col] : 0.f;
    bf16x8 gupf[4];
#pragma unroll
    for (int n = 0; n < 4; ++n) { v4u w_;
#pragma unroll
        for (int j2 = 0; j2 < 4; ++j2) w_[j2] = pk2(P[P_GUP + L * 8192 + (8 * h + 2 * j2) * 256 + hd * 64 + 16 * n + lo], P[P_GUP + L * 8192 + (8 * h + 2 * j2 + 1) * 256 + hd * 64 + 16 * n + lo]);
        gupf[n] = __builtin_bit_cast(bf16x8, w_); }
    const float mur = P[P_MU + L * 832 + col], muk = P[P_MU + L * 832 + 256 + col], muv = P[P_MU + L * 832 + 512 + col];
    LAS bf16* atX = (LAS bf16*)(wl + 0); LAS bf16* rtX = (LAS bf16*)(wl + 2048); LAS bf16* btX = (LAS bf16*)(wl + 4096); LAS bf16* ktX = (LAS bf16*)(wl + 6144);
    LAS bf16* atT = (LAS bf16*)(wl + 8192); LAS bf16* pbT = (LAS bf16*)(wl + 10240); LAS bf16* pkT = (LAS bf16*)(wl + 12288); LAS bf16* vT = (LAS bf16*)(wl + 14336);
    LAS float* LR = (LAS float*)(wl + 16384); asm volatile("" : "+v"(LR));
    LAS float* Lm = (LAS float*)(wl + 16384); asm volatile("" : "+v"(Lm)); LAS bf16* Tb = (LAS bf16*)(wl + 17472);
    LAS bf16* Gak = (LAS bf16*)(wl + 17984); LAS bf16* Grb = (LAS bf16*)(wl + 18496); LAS bf16* Grk = (LAS bf16*)(wl + 19008);
    const f32x4 z4 = (f32x4){0.f, 0.f, 0.f, 0.f}; const bf16x8 z8 = (bf16x8){0, 0, 0, 0, 0, 0, 0, 0};
    const __amdgpu_buffer_rsrc_t zsrd = __builtin_amdgcn_make_buffer_rsrc((void*)A.z, 0, T * ZLD * 2, 0x00020000);
    const __amdgpu_buffer_rsrc_t vsrd = __builtin_amdgcn_make_buffer_rsrc((void*)A.vfirst, 0, T * 256 * 2, 0x00020000);
    const __amdgpu_buffer_rsrc_t gsrd = __builtin_amdgcn_make_buffer_rsrc((void*)A.gout, 0, T * 256 * 2, 0x00020000);
    LAS bf16* LRraw = (LAS bf16*)(wl + 10240);
    for (int c = c0; c < cend; c += cstride) {
        const int t0 = c * 16;
        int ln = lane; asm volatile("" : "+v"(ln));
        const unsigned zo = (unsigned)((t0 - 1) * ZLD + Z_RZ + col) * 2u;
        SUBREP(1) {
        {
            bf16 rawv[20];
#pragma unroll
            for (int q = 0; q < 20; ++q) { const int e = ln + 64 * q; const int t = e / 72, i = e - t * 72;
                const int zc = (i < 64) ? (Z_RZ + 768 + i) : (Z_VD + i - 64);
                const unsigned bo = (e < 17 * 72 && (i < 64 || L > 0)) ? (unsigned)((t0 + t - 1) * ZLD + zc) * 2u : 0xfffffff0u;
                rawv[q] = (bf16)__builtin_amdgcn_raw_buffer_load_b16(zsrd, bo, 0, 0); }
#pragma unroll
            for (int q = 0; q < 20; ++q) { const int e = ln + 64 * q; if (e < 17 * 72) LRraw[e] = rawv[q]; }
        }
        LDS_WAIT(); asm volatile("" ::: "memory");
#pragma unroll 2
        for (int q = 0; q < 18; ++q) {
            const int e = ln + 64 * q, t = e / 72, i = e - t * 72;
            const float cur = bf2f(LRraw[e + 72]), prev = bf2f(LRraw[e]);
            const float m = (i < 64) ? P[P_MU + L * 832 + 768 + i] : P[P_VMU + i - 64];
            float val = cur + (prev - cur) * m;
            if (i < 16) val = tanhf_(val); else if (i >= 32 && i < 64) val = sigmoidf_(val);
            LR[e] = val;
        }
        LDS_WAIT(); asm volatile("" ::: "memory");
        }
        SUBREP(2) {
            const LAS float* lg = LR + lo * 72 + 32 + 8 * h;
            v4u aw; aw.x = pk2(lg[0], lg[1]); aw.y = pk2(lg[2], lg[3]); aw.z = pk2(lg[4], lg[5]); aw.w = pk2(lg[6], lg[7]);
            const bf16x8 ga = __builtin_bit_cast(bf16x8, aw);
#pragma unroll
            for (int n = 0; n < 4; ++n) { const f32x4 gc = MFMA16(ga, gupf[n], z4);
#pragma unroll
                for (int r2 = 0; r2 < 4; ++r2) A.gout[(size_t)(t0 + 4 * h + r2) * 256 + hd * 64 + 16 * n + lo] = (bf16)f2bf(gc[r2]); }
        }
        float cum = 0.f, bcv = 0.f;
        const size_t ob = (size_t)t0 * 256 + col;
#define RW_LD3(dst, tt) do { const unsigned o_ = zo + (unsigned)(tt) * (ZLD * 2); dst[0] = (bf16)__builtin_amdgcn_raw_buffer_load_b16(zsrd, o_, 0, 0); dst[1] = (bf16)__builtin_amdgcn_raw_buffer_load_b16(zsrd, o_ + 512, 0, 0); \
            dst[2] = (bf16)__builtin_amdgcn_raw_buffer_load_b16(zsrd, o_ + 1024, 0, 0); dst[3] = (L > 0) ? (bf16)__builtin_amdgcn_raw_buffer_load_b16(vsrd, (unsigned)((t0 + (tt) - 1) * 256 + col) * 2u, 0, 0) : (bf16)0; } while (0)
        bf16 Zr[17][4];
#pragma unroll
        for (int tt = 0; tt < 17; ++tt) RW_LD3(Zr[tt], tt);
#pragma unroll
        for (int tt = 0; tt < 17; ++tt) asm volatile("" : "+v"(Zr[tt][0]), "+v"(Zr[tt][1]), "+v"(Zr[tt][2]), "+v"(Zr[tt][3]));
        float prr, prk, prv;
        SUBREP(3) { cum = 0.f; prr = bf2f(Zr[0][0]); prk = bf2f(Zr[0][1]); prv = bf2f(Zr[0][2]);
#pragma unroll
        for (int tg = 0; tg < 16; tg += 4) {
#pragma unroll
          for (int ti = 0; ti < 4; ++ti) {
            const int t = tg + ti;
            const float cr = bf2f(Zr[t + 1][0]), ck = bf2f(Zr[t + 1][1]), cv = bf2f(Zr[t + 1][2]), vfv = bf2f(Zr[t + 1][3]);
            const float rr = cr + (prr - cr) * mur, kk0 = ck + (prk - ck) * muk; float vv = cv + (prv - cv) * muv;
            prr = cr; prk = ck; prv = cv;
            const LAS float* lr = LR + t * 72;
            float sw = w0, sa = a0;
#pragma unroll
            for (int i = 0; i < 16; ++i) { sw += lr[i] * wup[i]; sa += lr[16 + i] * aup[i]; }
            const float wlog = -softplusf_(-sw) - 0.5f;
            const float lw = -__expf(wlog);
            const float av = sigmoidf_(sa);
            if (L > 0) { float sv = v0p;
#pragma unroll
                for (int i = 0; i < 8; ++i) sv += lr[64 + i] * vup[i];
                vv = vv + (vfv - vv) * sigmoidf_(sv); }
            float kk = kk0 * kkp; const float ss = wave_sum(kk * kk); kk = kk * rsqrtf(fmaxf(ss, 1e-24f));
            const float k2 = kk0 * (1.f + (av - 1.f) * kap);
            const float bc = wave_sum(rr * k2 * rkp);
            bcv = (ln == t) ? bc : bcv;
            const float ea = __expf(cum); cum += lw; const float e = __expf(cum), ei = __expf(-cum);
            const float at = -kk * ea, bt = kk * av * ei, kt = k2 * ei, rt = rr * e;
            atX[t * 64 + lane] = (bf16)f2bf(at); rtX[t * 64 + lane] = (bf16)f2bf(rt); btX[t * 64 + lane] = (bf16)f2bf(bt); ktX[t * 64 + lane] = (bf16)f2bf(kt);
            atT[lane * 16 + t] = (bf16)f2bf(at); vT[lane * 16 + t] = (bf16)f2bf(vv);
          }
        }
        }
#undef RW_LD3
        if (ln < 16) A.bcout[(size_t)(t0 + ln) * 4 + hd] = bcv;
        const float PC = __expf(cum);
        LDS_WAIT(); asm volatile("" ::: "memory");
#pragma unroll 1
        for (int t = 0; t < 16; ++t) { const bf16 vb16 = vT[lane * 16 + t]; A.vout[ob + (size_t)t * 256] = vb16; if (L == 0) A.vfirst[ob + (size_t)t * 256] = vb16; }
#pragma unroll 4
        for (int t = 0; t < 16; ++t) { pbT[lane * 16 + t] = (bf16)f2bf(bf2f(btX[t * 64 + lane]) * PC); pkT[lane * 16 + t] = (bf16)f2bf(bf2f(ktX[t * 64 + lane]) * PC); }
        unsigned char* pk_ = A.pack + ((size_t)c * 4 + hd) * RW_PACK;
        *(float*)(pk_ + RW_P + lane * 4) = PC;
        LDS_WAIT(); asm volatile("" ::: "memory");
        SUBREP(4) {
        f32x4 Gab, Gak_, Grb_, Grk_;
        {
            bf16x8 af[2], rf[2], bq[2], kq[2];
#pragma unroll
            for (int s = 0; s < 2; ++s) { af[s] = *(const LAS bf16x8*)(atX + lo * 64 + 32 * s + 8 * h); rf[s] = *(const LAS bf16x8*)(rtX + lo * 64 + 32 * s + 8 * h);
                bq[s] = *(const LAS bf16x8*)(btX + lo * 64 + 32 * s + 8 * h); kq[s] = *(const LAS bf16x8*)(ktX + lo * 64 + 32 * s + 8 * h); }
            Gab = MFMA16(af[0], bq[0], z4); Gab = MFMA16(af[1], bq[1], Gab);
            Gak_ = MFMA16(af[0], kq[0], z4); Gak_ = MFMA16(af[1], kq[1], Gak_);
            Grb_ = MFMA16(rf[0], bq[0], z4); Grb_ = MFMA16(rf[1], bq[1], Grb_);
            Grk_ = MFMA16(rf[0], kq[0], z4); Grk_ = MFMA16(rf[1], kq[1], Grk_);
        }
#pragma unroll
        for (int r = 0; r < 4; ++r) { const int t = 4 * h + r; const bool sl = lo < t, sle = lo <= t;
            Lm[t * 17 + lo] = sl ? Gab[r] : 0.f; Gak[t * 16 + lo] = (bf16)f2bf(sl ? Gak_[r] : 0.f); Grb[t * 16 + lo] = (bf16)f2bf(sle ? Grb_[r] : 0.f); Grk[t * 16 + lo] = (bf16)f2bf(sle ? Grk_[r] : 0.f); }
        LDS_WAIT(); asm volatile("" ::: "memory");
        {
            float Tc[16];
            const int lo_i = ln & 15;
#pragma unroll
            for (int t = 0; t < 16; ++t) { float acc = (t == lo_i) ? 1.f : 0.f;
#pragma unroll
                for (int s = 0; s < t; ++s) acc += Lm[t * 17 + s] * Tc[s];
                Tc[t] = acc; }
#pragma unroll
            for (int t = 0; t < 16; ++t) Tb[t * 16 + lo] = (bf16)f2bf(Tc[t]);
        }
        LDS_WAIT(); asm volatile("" ::: "memory");
        {
            const bf16x8 Tfr = (h < 2) ? *(const LAS bf16x8*)(Tb + lo * 16 + 8 * h) : z8;
            f32x4 Cm[4];
#pragma unroll
            for (int m = 0; m < 4; ++m) { const bf16x8 Afr = (h < 2) ? *(const LAS bf16x8*)(atT + (16 * m + lo) * 16 + 8 * h) : z8;
                Cm[m] = MFMA16(Afr, Tfr, z4); }
            *(bf16x8*)(pk_ + RW_AHAT + 0 * 1024 + lane * 16) = pack8(Cm[0], Cm[1]);
            *(bf16x8*)(pk_ + RW_AHAT + 1 * 1024 + lane * 16) = pack8(Cm[2], Cm[3]);
        }
        {
            const bf16x8 Gfr = (h < 2) ? *(const LAS bf16x8*)(Gak + lo * 16 + 8 * h) : z8;
            const v2u t4 = *(const LAS v2u*)(Tb + lo * 16 + 4 * h); const bf16x8 T2 = frag2(t4, (v2u){0u, 0u});
#pragma unroll
            for (int vb = 0; vb < 4; ++vb) {
                const bf16x8 Vn = (h < 2) ? *(const LAS bf16x8*)(vT + (16 * vb + lo) * 16 + 8 * h) : z8;
                const f32x4 X = MFMA16(Gfr, Vn, z4);
                const f32x4 W2 = MFMA16(T2, pack8(X, z4), z4);
                { v2u w2p; w2p.x = cvt_pk(W2[0], W2[1]); w2p.y = cvt_pk(W2[2], W2[3]); *(v2u*)(pk_ + RW_W2 + vb * 512 + lane * 8) = w2p; }
                *(v2u*)(pk_ + RW_V + vb * 512 + lane * 8) = *(const LAS v2u*)(vT + (16 * vb + lo) * 16 + 4 * h);
            }
        }
#pragma unroll
        for (int m = 0; m < 4; ++m) *(bf16x8*)(pk_ + RW_S2A + m * 1024 + lane * 16) = frag2(*(const LAS v2u*)(pbT + (16 * m + lo) * 16 + 4 * h), *(const LAS v2u*)(pkT + (16 * m + lo) * 16 + 4 * h));
#pragma unroll
        for (int s = 0; s < 2; ++s) *(bf16x8*)(pk_ + RW_R + s * 1024 + lane * 16) = frag2(*(const LAS v2u*)(rtX + lo * 64 + 32 * s + 4 * h), *(const LAS v2u*)(rtX + lo * 64 + 32 * s + 16 + 4 * h));
        *(bf16x8*)(pk_ + RW_ARK + lane * 16) = frag2(*(const LAS v2u*)(Grb + lo * 16 + 4 * h), *(const LAS v2u*)(Grk + lo * 16 + 4 * h));
        }
        LDS_WAIT(); asm volatile("" ::: "memory");
    }
}

struct PostCtx { LAS float* xbuf; volatile LAS unsigned* cnt; unsigned step; const bf16* z; const float* P; const bf16* g; const bf16* v; const float* bc; bf16* mix; int layer; };
__device__ __forceinline__ void group_sync(PostCtx& pc) {
    LDS_WAIT(); asm volatile("" ::: "memory");
    if ((threadIdx.x & 63) == 0) __hip_atomic_fetch_add((LAS unsigned*)pc.cnt, 1u, __ATOMIC_RELAXED, __HIP_MEMORY_SCOPE_WORKGROUP);
    pc.step += 1; const unsigned want = 4u * pc.step;
    while (*pc.cnt < want) __builtin_amdgcn_s_sleep(0);
    asm volatile("" ::: "memory");
}
struct RwkvSeqArgs { const unsigned char* pack; };
struct RwkvOps { bf16x8 Ah0, Ah1, S2A[4], R0, R1, ARK; f32x4 W2, Pm[4]; v2u Vf; };
template <int MODE>
__device__ __forceinline__ void rwkv_load_ops(RwkvOps& o, const unsigned char* pk_, int vb, int lane) {
    const int h = lane >> 4;
    o.Ah0 = *(const bf16x8*)(pk_ + RW_AHAT + lane * 16); o.Ah1 = *(const bf16x8*)(pk_ + RW_AHAT + 1024 + lane * 16);
#pragma unroll
    for (int m = 0; m < 4; ++m) { o.S2A[m] = *(const bf16x8*)(pk_ + RW_S2A + m * 1024 + lane * 16); o.Pm[m] = *(const f32x4*)(pk_ + RW_P + (16 * m + 4 * h) * 4); }
    if (MODE != 1) { const v2u w2p = *(const v2u*)(pk_ + RW_W2 + vb * 512 + lane * 8); o.W2[0] = __uint_as_float(w2p.x << 16); o.W2[1] = __uint_as_float(w2p.x & 0xffff0000u); o.W2[2] = __uint_as_float(w2p.y << 16); o.W2[3] = __uint_as_float(w2p.y & 0xffff0000u);
        o.Vf = *(const v2u*)(pk_ + RW_V + vb * 512 + lane * 8); }
    if (MODE == 2) { o.R0 = *(const bf16x8*)(pk_ + RW_R + lane * 16); o.R1 = *(const bf16x8*)(pk_ + RW_R + 1024 + lane * 16); o.ARK = *(const bf16x8*)(pk_ + RW_ARK + lane * 16); }
}
template <int MODE>
__device__ __forceinline__ void rwkv_seq_wave(const RwkvSeqArgs& A, int hd, int vb, int cb, int ce, f32x4 (&St)[4], int lane, PostCtx* pc) {
    const int lo = lane & 15, h = lane >> 4; const f32x4 zz = (f32x4){0.f, 0.f, 0.f, 0.f};
    RwkvOps cur, nxt;
    rwkv_load_ops<MODE>(cur, A.pack + ((size_t)cb * 4 + hd) * RW_PACK, vb, lane);
    for (int c = cb; c < ce; ++c) {
        const int cn = (c + 1 < ce) ? c + 1 : c;
        rwkv_load_ops<MODE>(nxt, A.pack + ((size_t)cn * 4 + hd) * RW_PACK, vb, lane);
        float pg[4], pv[4], pb[4];
        if (MODE == 2) {
#pragma unroll
            for (int i = 0; i < 4; ++i) { const size_t t = (size_t)c * 16 + 4 * vb + i; pg[i] = bf2f(pc->g[t * 256 + hd * 64 + lane]); pv[i] = bf2f(pc->v[t * 256 + hd * 64 + lane]); pb[i] = pc->bc[t * 4 + hd]; }
        }
        const bf16x8 B0 = pack8(St[0], St[1]), B1 = pack8(St[2], St[3]);
        f32x4 U = MFMA16(cur.Ah0, B0, (MODE == 1) ? zz : cur.W2); U = MFMA16(cur.Ah1, B1, U);
        const bf16x8 BU = (MODE == 1) ? pack8(U, zz) : pack8u(U, cur.Vf);
        if (MODE == 2) {
            f32x4 y = MFMA16(cur.R0, B0, zz); y = MFMA16(cur.R1, B1, y); y = MFMA16(cur.ARK, BU, y);
            LAS float* xb = pc->xbuf + (pc->step & 1u) * 1024;
#pragma unroll
            for (int r = 0; r < 4; ++r) xb[(4 * h + r) * 64 + vb * 16 + lo] = y[r];
        }
#pragma unroll
        for (int m = 0; m < 4; ++m) St[m] = MFMA16(cur.S2A[m], BU, St[m] * cur.Pm[m]);
        if (MODE == 2) {
            const LAS float* xb = pc->xbuf + (pc->step & 1u) * 1024;
            group_sync(*pc);
            const int col = hd * 64 + lane; const float lw = pc->P[P_LNXW + pc->layer * 256 + col], lb = pc->P[P_LNXB + pc->layer * 256 + col];
#pragma unroll
            for (int i = 0; i < 4; ++i) { const int tt = 4 * vb + i; const float o = xb[tt * 64 + lane];
                const float mu = wave_sum(o) * (1.f / 64.f); const float d = o - mu; const float var = wave_sum(d * d) * (1.f / 64.f);
                const float yn = d * rsqrtf(var + GN_EPS) * lw + lb;
                pc->mix[((size_t)c * 16 + tt) * D + 768 + col] = (bf16)f2bf((yn + pb[i] * pv[i]) * pg[i]); }
        }
        cur = nxt;
    }
}
template <int MT> struct GLP { static constexpr int DK = MT ? 64 : 32, Q = 0, AV = DK / 32 * 1024, KH = AV + 512, V = KH + DK / 16 * 512, G = V + 2048, PACK = MT ? 7168 : 5120; };
constexpr int GLL_BYTES = 10240;
struct GlaPrepArgs { const bf16* z; const float* P; unsigned char* pack; };
template <int L, int MT>
__device__ __forceinline__ void gla_prep_wave(const GlaPrepArgs& A, int hd, int c0, int cstride, int cend, LAS unsigned char* wl, int lane) {
    constexpr int DK = MT ? 64 : 32;
    const int ch = lane & (DK - 1), lo = lane & 15, h = lane >> 4;
    const float* P = A.P;
    float gku[16]; float gkb = 0.f, lb = 0.f;
    if (MT == 0) {
#pragma unroll
        for (int i = 0; i < 16; ++i) gku[i] = P[P_GKUP + L * 2048 + i * 128 + hd * 32 + ch];
        gkb = P[P_GKB + L * 128 + hd * 32 + ch];
    } else lb = P[P_LBS + L * 256 + hd * 64 + ch];
    LAS bf16* qX = (LAS bf16*)(wl + 0); LAS bf16* ktX = (LAS bf16*)(wl + 2048); LAS bf16* khT = (LAS bf16*)(wl + 4096); LAS bf16* vT = (LAS bf16*)(wl + 6144);
    LAS bf16* Aimg = (LAS bf16*)(wl + 8192); LAS float* LR = (LAS float*)(wl + 8704); asm volatile("" : "+v"(LR));
    const f32x4 z4 = (f32x4){0.f, 0.f, 0.f, 0.f};
    const __amdgpu_buffer_rsrc_t zsrd = __builtin_amdgcn_make_buffer_rsrc((void*)A.z, 0, T * ZLD * 2, 0x00020000);
    for (int c = c0; c < cend; c += cstride) SUBREP(5 + MT) {
        const int t0 = c * 16;
        const unsigned qo = (unsigned)(t0 * ZLD + (MT ? Z_HQ + hd * 64 : Z_GQ + hd * 32) + ch) * 2u, ko = (unsigned)(t0 * ZLD + (MT ? Z_HF + hd * 64 : Z_GK + hd * 32) + ch) * 2u, vo = (unsigned)(t0 * ZLD + (MT ? Z_HI : Z_GV) + hd * 64 + lane) * 2u;
        if (MT == 0) {
#pragma unroll
            for (int q = 0; q < 4; ++q) { const int e = lane + 64 * q; LR[e] = bf2f(A.z[(size_t)(t0 + (e >> 4)) * ZLD + Z_GGK + (e & 15)]); }
            LDS_WAIT(); asm volatile("" ::: "memory");
        }
        float cum = 0.f;
#define GL_LD3(dst, tt) do { const unsigned s_ = (unsigned)(tt) * (ZLD * 2); dst[0] = (bf16)__builtin_amdgcn_raw_buffer_load_b16(zsrd, qo + s_, 0, 0); dst[1] = (bf16)__builtin_amdgcn_raw_buffer_load_b16(zsrd, ko + s_, 0, 0); \
            dst[2] = (bf16)__builtin_amdgcn_raw_buffer_load_b16(zsrd, vo + s_, 0, 0); } while (0)
        bf16 Zr[16][3];
#pragma unroll
        for (int tt = 0; tt < 16; ++tt) GL_LD3(Zr[tt], tt);
#pragma unroll
        for (int tt = 0; tt < 16; ++tt) asm volatile("" : "+v"(Zr[tt][0]), "+v"(Zr[tt][1]), "+v"(Zr[tt][2]));
#pragma unroll
        for (int tg = 0; tg < 16; tg += 4) {
#pragma unroll
          for (int ti = 0; ti < 4; ++ti) {
            const int t = tg + ti;
            const bf16 zq = Zr[t][0], zk2 = Zr[t][1], zvv = Zr[t][2];
            float q, k, lf;
            if (MT == 0) {
                q = bf2f(zq) * 0.17677669529663687f; k = bf2f(zk2);
                float s = gkb;
#pragma unroll
                for (int i = 0; i < 16; ++i) s += LR[t * 16 + i] * gku[i];
                lf = logsigmoidf_(s) * (1.f / 16.f);
            } else {
                const float fq = bf2f(zq), ff = bf2f(zk2);
                q = siluf_(fq); k = (1.f - lb) * sigmoidf_(-ff);
                lf = (lb == 0.f) ? logsigmoidf_(ff) : __logf(lb + (1.f - lb) * sigmoidf_(ff));
            }
            cum += lf;
            qX[t * 64 + ch] = (bf16)f2bf(q * __expf(cum)); ktX[t * 64 + ch] = (bf16)f2bf(k * __expf(-cum));
            vT[lane * 16 + t] = zvv;
          }
        }
#undef GL_LD3
        LDS_WAIT(); asm volatile("" ::: "memory");
        { const float gch = __expf(cum);
#pragma unroll 4
          for (int t = 0; t < 16; ++t) khT[ch * 16 + t] = (bf16)f2bf(bf2f(ktX[t * 64 + ch]) * gch); }
        unsigned char* pk_ = A.pack + ((size_t)c * 4 + hd) * GLP<MT>::PACK;
        if (lane < DK) *(float*)(pk_ + GLP<MT>::G + ch * 4) = __expf(cum);
        LDS_WAIT(); asm volatile("" ::: "memory");
        f32x4 Am = z4;
#pragma unroll
        for (int s = 0; s < DK / 32; ++s) Am = MFMA16(*(const LAS bf16x8*)(qX + lo * 64 + 32 * s + 8 * h), *(const LAS bf16x8*)(ktX + lo * 64 + 32 * s + 8 * h), Am);
#pragma unroll
        for (int r = 0; r < 4; ++r) { const int t = 4 * h + r; Aimg[t * 16 + lo] = (bf16)f2bf(lo <= t ? Am[r] : 0.f); }
        LDS_WAIT(); asm volatile("" ::: "memory");
#pragma unroll
        for (int s = 0; s < DK / 32; ++s) *(bf16x8*)(pk_ + GLP<MT>::Q + s * 1024 + lane * 16) = frag2(*(const LAS v2u*)(qX + lo * 64 + 32 * s + 4 * h), *(const LAS v2u*)(qX + lo * 64 + 32 * s + 16 + 4 * h));
        *(v2u*)(pk_ + GLP<MT>::AV + lane * 8) = *(const LAS v2u*)(Aimg + lo * 16 + 4 * h);
#pragma unroll
        for (int m = 0; m < DK / 16; ++m) *(v2u*)(pk_ + GLP<MT>::KH + m * 512 + lane * 8) = *(const LAS v2u*)(khT + (16 * m + lo) * 16 + 4 * h);
#pragma unroll
        for (int vb = 0; vb < 4; ++vb) *(v2u*)(pk_ + GLP<MT>::V + vb * 512 + lane * 8) = *(const LAS v2u*)(vT + (16 * vb + lo) * 16 + 4 * h);
        LDS_WAIT(); asm volatile("" ::: "memory");
    }
}
struct GlaSeqArgs { const unsigned char* pack; };
template <int MT> struct GlaOps { bf16x8 Q[2], AV, KH[4]; f32x4 Gm[4]; v2u Vf; };
template <int MT, bool OUT>
__device__ __forceinline__ void gla_load_ops(GlaOps<MT>& o, const unsigned char* pk_, int vb, int lane) {
    constexpr int DK = MT ? 64 : 32; const int h = lane >> 4;
#pragma unroll
    for (int m = 0; m < DK / 16; ++m) { o.KH[m] = frag2(*(const v2u*)(pk_ + GLP<MT>::KH + m * 512 + lane * 8), (v2u){0u, 0u}); o.Gm[m] = *(const f32x4*)(pk_ + GLP<MT>::G + (16 * m + 4 * h) * 4); }
    o.Vf = *(const v2u*)(pk_ + GLP<MT>::V + vb * 512 + lane * 8);
    if (OUT) {
#pragma unroll
        for (int s = 0; s < DK / 32; ++s) o.Q[s] = *(const bf16x8*)(pk_ + GLP<MT>::Q + s * 1024 + lane * 16);
        o.AV = frag2(*(const v2u*)(pk_ + GLP<MT>::AV + lane * 8), (v2u){0u, 0u});
    }
}
template <int MT, bool OUT>
__device__ __forceinline__ void gla_seq_wave(const GlaSeqArgs& A, int hd, int vb, int cb, int ce, f32x4 (&S)[4], f32x4 (&Dp)[4], int lane, PostCtx* pc) {
    constexpr int DK = MT ? 64 : 32;
    const int lo = lane & 15, h = lane >> 4; const f32x4 z4 = (f32x4){0.f, 0.f, 0.f, 0.f};
    GlaOps<MT> cur, nxt;
    gla_load_ops<MT, OUT>(cur, A.pack + ((size_t)cb * 4 + hd) * GLP<MT>::PACK, vb, lane);
    for (int c = cb; c < ce; ++c) {
        const int cn = (c + 1 < ce) ? c + 1 : c;
        gla_load_ops<MT, OUT>(nxt, A.pack + ((size_t)cn * 4 + hd) * GLP<MT>::PACK, vb, lane);
        float pg[4];
        if (OUT) {
#pragma unroll
            for (int i = 0; i < 4; ++i) pg[i] = bf2f(pc->z[((size_t)c * 16 + 4 * vb + i) * ZLD + (MT ? Z_HG : Z_GG) + hd * 64 + lane]);
        }
        const bf16x8 BV = frag2(cur.Vf, (v2u){0u, 0u});
        if (OUT) {
            f32x4 o = MFMA16(cur.AV, BV, z4);
#pragma unroll
            for (int s = 0; s < DK / 32; ++s) o = MFMA16(cur.Q[s], pack8(S[2 * s], S[2 * s + 1]), o);
            LAS float* xb = pc->xbuf + (pc->step & 1u) * 1024;
#pragma unroll
            for (int r = 0; r < 4; ++r) xb[(4 * h + r) * 64 + vb * 16 + lo] = o[r];
        }
#pragma unroll
        for (int m = 0; m < DK / 16; ++m) { S[m] = MFMA16(cur.KH[m], BV, S[m] * cur.Gm[m]); if (!OUT) Dp[m] = Dp[m] * cur.Gm[m]; }
        if (OUT) {
            const LAS float* xb = pc->xbuf + (pc->step & 1u) * 1024;
            group_sync(*pc);
            const float nw = pc->P[(MT ? P_HNW : P_GNW) + pc->layer * 64 + lane];
#pragma unroll
            for (int i = 0; i < 4; ++i) { const int tt = 4 * vb + i; const float o = xb[tt * 64 + lane];
                const float ms = wave_sum(o * o) * (1.f / 64.f);
                pc->mix[((size_t)c * 16 + tt) * D + MT * 256 + hd * 64 + lane] = (bf16)f2bf(o * rsqrtf(ms + RMS_EPS) * nw * siluf_(pg[i])); }
        }
        cur = nxt;
    }
}
constexpr int SW_KLD = 72, SW_VLD = 264, SW_PLD = 40;
constexpr int SW_K = 0, SW_V = 256 * SW_KLD * 2, SW_P = SW_V + 64 * SW_VLD * 2, SW_PW = 32 * SW_PLD * 2, SW_LDS = SW_P + 8 * SW_PW;
typedef float f32x16 __attribute__((ext_vector_type(16)));
#define MFMA32(a, b, c) __builtin_amdgcn_mfma_f32_32x32x16_bf16((a), (b), (c), 0, 0, 0)
__device__ __forceinline__ void swa_items(const bf16* z, const float* sinks, bf16* mix, int i0, int istride, LAS unsigned char* lds, int tid) {
    const int lane = tid & 63, wave = tid >> 6, l31 = lane & 31, hh = lane >> 5;
    LAS bf16* Ks = (LAS bf16*)(lds + SW_K); LAS bf16* Vt = (LAS bf16*)(lds + SW_V); LAS bf16* Pw = (LAS bf16*)(lds + SW_P + wave * SW_PW);
    for (int item = i0; item < (T / 128) * 2; item += istride) {
        const int nb = item >> 1, kvh = item & 1, tk0 = nb * 128 - 128;
        __syncthreads();
#pragma unroll
        for (int q = 0; q < 4; ++q) {
            const int e = tid + 512 * q, key = e >> 3, ch = e & 7; int tok = tk0 + key; tok = tok < 0 ? 0 : tok;
            const v4u kv = *(const GAS v4u*)(z + (size_t)tok * ZLD + Z_SK + kvh * 64 + ch * 8);
            *(LAS v4u*)(Ks + key * SW_KLD + ch * 8) = kv;
            const v4u vv = *(const GAS v4u*)(z + (size_t)tok * ZLD + Z_SV + kvh * 64 + ch * 8);
#pragma unroll
            for (int j = 0; j < 4; ++j) { Vt[(ch * 8 + 2 * j) * SW_VLD + key] = (bf16)(vv[j] & 0xffffu); Vt[(ch * 8 + 2 * j + 1) * SW_VLD + key] = (bf16)(vv[j] >> 16); }
        }
        __syncthreads();
        const int g = wave >> 2, qh = kvh * 2 + g, q0 = (wave & 3) * 32, kt0 = wave & 3;
        const float sink = sinks[qh];
        bf16x8 Qf[4];
        { const bf16* qp = z + (size_t)(nb * 128 + q0 + l31) * ZLD + Z_SQ + qh * 64 + 8 * hh;
#pragma unroll
          for (int s = 0; s < 4; ++s) Qf[s] = *(const GAS bf16x8*)(qp + 16 * s); }
        f32x16 Sc[5];
#pragma unroll
        for (int kt = 0; kt < 5; ++kt) {
            f32x16 acc;
#pragma unroll
            for (int i = 0; i < 16; ++i) acc[i] = 0.f;
            const LAS bf16* kp = Ks + ((kt0 + kt) * 32 + l31) * SW_KLD + 8 * hh;
#pragma unroll
            for (int s = 0; s < 4; ++s) acc = MFMA32(Qf[s], *(const LAS bf16x8*)(kp + 16 * s), acc);
            Sc[kt] = acc;
        }
        int l31o = l31, hho = hh; asm volatile("" : "+v"(l31o), "+v"(hho));
        float mx[16];
#pragma unroll
        for (int r = 0; r < 16; ++r) {
            const int ro = (r & 3) + 8 * (r >> 2) + 4 * hho;
            const bool lowv = l31o > ro;
            float m = -INFINITY;
#pragma unroll
            for (int kt = 0; kt < 5; ++kt) { bool vis = (kt == 0) ? lowv : ((kt == 4) ? !lowv : true); if (nb == 0 && kt0 + kt < 4) vis = false;
                const float sv = vis ? Sc[kt][r] * 0.125f : -INFINITY; Sc[kt][r] = sv; m = fmaxf(m, sv); }
#pragma unroll
            for (int o = 1; o < 32; o <<= 1) m = fmaxf(m, __shfl_xor(m, o));
            mx[r] = fmaxf(m, sink);
        }
        float inv[16];
#pragma unroll
        for (int r = 0; r < 16; ++r) {
            float s = 0.f;
#pragma unroll
            for (int kt = 0; kt < 5; ++kt) { const float p = __expf(Sc[kt][r] - mx[r]); Sc[kt][r] = p; s += p; }
#pragma unroll
            for (int o = 1; o < 32; o <<= 1) s += __shfl_xor(s, o);
            inv[r] = 1.f / (s + __expf(sink - mx[r]));
        }
        f32x16 O0, O1;
#pragma unroll
        for (int i = 0; i < 16; ++i) { O0[i] = 0.f; O1[i] = 0.f; }
#pragma unroll
        for (int kt = 0; kt < 5; ++kt) {
#pragma unroll
            for (int r = 0; r < 16; ++r) Pw[((r & 3) + 8 * (r >> 2) + 4 * hh) * SW_PLD + l31] = (bf16)f2bf(Sc[kt][r] * inv[r]);
            LDS_WAIT(); asm volatile("" ::: "memory");
#pragma unroll
            for (int s = 0; s < 2; ++s) {
                const bf16x8 Pf = *(const LAS bf16x8*)(Pw + l31 * SW_PLD + 16 * s + 8 * hh);
                const int kb = (kt0 + kt) * 32 + 16 * s + 8 * hh;
                O0 = MFMA32(Pf, *(const LAS bf16x8*)(Vt + l31 * SW_VLD + kb), O0);
                O1 = MFMA32(Pf, *(const LAS bf16x8*)(Vt + (32 + l31) * SW_VLD + kb), O1);
            }
            LDS_WAIT(); asm volatile("" ::: "memory");
        }
#pragma unroll
        for (int r = 0; r < 16; ++r) { const int qi = q0 + (r & 3) + 8 * (r >> 2) + 4 * hh; bf16* op = mix + (size_t)(nb * 128 + qi) * D + 512 + qh * 64 + l31;
            op[0] = (bf16)f2bf(O0[r]); op[32] = (bf16)f2bf(O1[r]); }
    }
}
__device__ __forceinline__ void tr_item(const float* src, int ldw, int nvalid, bf16* dst, int dld, LAS float* scr, int lane) {
    const int nl = lane & 31;
    float tv[32];
#pragma unroll
    for (int i = 0; i < 32; ++i) { const int kk = 2 * i + (lane >> 5); tv[i] = (nl < nvalid) ? src[(size_t)kk * ldw + nl] : 0.f; }
#pragma unroll
    for (int i = 0; i < 32; ++i) { const int kk = 2 * i + (lane >> 5); scr[kk * 33 + nl] = tv[i]; }
    LDS_WAIT(); asm volatile("" ::: "memory");
    const int c = lane & 7;
#pragma unroll
    for (int j = 0; j < 4; ++j) { const int n = (lane >> 3) + 8 * j; const LAS float* s = scr + (8 * c) * 33 + n;
        v4u o; o.x = pk2(s[0 * 33], s[1 * 33]); o.y = pk2(s[2 * 33], s[3 * 33]); o.z = pk2(s[4 * 33], s[5 * 33]); o.w = pk2(s[6 * 33], s[7 * 33]);
        if (n < nvalid) *(GAS v4u*)(dst + (size_t)n * dld + 8 * c) = o; }
    LDS_WAIT(); asm volatile("" ::: "memory");
}
__device__ __forceinline__ void tr_job(const float* src, int ldw, int nblocks, int ncols, bf16* dst, int dld, int il, int rowoff, int it, LAS float* scr, int lane) {
    const int kb = it / nblocks, nb = it - kb * nblocks, n0 = nb * 32; const int nv = (ncols - n0) < 32 ? (ncols - n0) : 32;
    const int row = il ? ((n0 >> 7) * 256 + (n0 & 127) + rowoff) : (n0 + rowoff);
    tr_item(src + (size_t)kb * 64 * ldw + n0, ldw, nv, dst + (size_t)row * dld + kb * 64, dld, scr, lane);
}
template <int PARTS> __device__ __forceinline__ void moe_weights_half(const float* wg, const float* wu, const float* wd, bf16* gu, bf16* dn, int hh, int gw, int NGW, LAS float* scr, int lane) {
    constexpr int PER = 896, NW = (PARTS == 3) ? 3 : (PARTS == 1 ? 2 : 1), PE = NW * PER;
    for (int it = gw; it < NE * PE; it += NGW) {
        const int e = it / PE, r = it - e * PE, w_ = r / PER, idx = r - w_ * PER, which = (PARTS == 2) ? 2 : w_;
        const float* src; int ldw, nblocks, ncols, dld, il, rowoff; bf16* dst;
        if (which == 0) { src = wg + (size_t)e * D * DFE + hh * DFH; ldw = DFE; nblocks = 56; ncols = DFH; dst = gu + (size_t)e * 3584 * D; dld = D; il = 1; rowoff = 0; }
        else if (which == 1) { src = wu + (size_t)e * D * DFE + hh * DFH; ldw = DFE; nblocks = 56; ncols = DFH; dst = gu + (size_t)e * 3584 * D; dld = D; il = 1; rowoff = 128; }
        else { src = wd + (size_t)e * DFE * D + (size_t)hh * DFH * D; ldw = D; nblocks = 32; ncols = D; dst = dn + (size_t)e * D * DFH; dld = DFH; il = 0; rowoff = 0; }
        tr_job(src, ldw, nblocks, ncols, dst, dld, il, rowoff, idx, scr, lane);
    }
}
__device__ __forceinline__ void cvt_rows(const float* src, bf16* dst, size_t n, size_t gtid, size_t nthreads) {
    for (size_t i = gtid * 8; i < n; i += nthreads * 8) { const f32x4 a = *(const GAS f32x4*)(src + i), b = *(const GAS f32x4*)(src + i + 4);
        v4u o; o.x = pk2(a[0], a[1]); o.y = pk2(a[2], a[3]); o.z = pk2(b[0], b[1]); o.w = pk2(b[2], b[3]); *(GAS v4u*)(dst + i) = o; }
}

struct LnArgs { const float* src; const float* gam; const float* bet; float* xout; bf16* xb; int mode; const bf16* Y1; const bf16* Y2; const int* tok_row; const float* top_g;
                int route; const float* router; int* top_e; float* top_gw; gu32* cnt; LAS unsigned* lhist; };
__device__ __forceinline__ void ln_rows(const LnArgs& a, int gw, int NGW, int lane) {
    for (int row = gw; row < T; row += NGW) {
        f32x4 v[4]; float s = 0.f;
        if (a.mode == 0) {
#pragma unroll
            for (int j = 0; j < 4; ++j) { const v2u w_ = *((const GAS v2u*)((const bf16*)a.src + (size_t)row * D) + lane + 64 * j);
                v[j][0] = __uint_as_float(w_.x << 16); v[j][1] = __uint_as_float(w_.x & 0xffff0000u); v[j][2] = __uint_as_float(w_.y << 16); v[j][3] = __uint_as_float(w_.y & 0xffff0000u); }
        } else {
            const int r0 = a.tok_row[row * 2], r1 = a.tok_row[row * 2 + 1]; const float g0 = a.top_g[row * 2], g1 = a.top_g[row * 2 + 1];
#pragma unroll
            for (int j = 0; j < 4; ++j) {
                const f32x4 xv = *((const GAS f32x4*)(a.xout + (size_t)row * D) + lane + 64 * j);
                const v2u a0 = *((const GAS v2u*)(a.Y1 + (size_t)r0 * D) + lane + 64 * j), b0 = *((const GAS v2u*)(a.Y2 + (size_t)r0 * D) + lane + 64 * j);
                const v2u a1 = *((const GAS v2u*)(a.Y1 + (size_t)r1 * D) + lane + 64 * j), b1 = *((const GAS v2u*)(a.Y2 + (size_t)r1 * D) + lane + 64 * j);
                f32x4 y0, y1;
                y0[0] = __uint_as_float(a0.x << 16) + __uint_as_float(b0.x << 16); y0[1] = __uint_as_float(a0.x & 0xffff0000u) + __uint_as_float(b0.x & 0xffff0000u);
                y0[2] = __uint_as_float(a0.y << 16) + __uint_as_float(b0.y << 16); y0[3] = __uint_as_float(a0.y & 0xffff0000u) + __uint_as_float(b0.y & 0xffff0000u);
                y1[0] = __uint_as_float(a1.x << 16) + __uint_as_float(b1.x << 16); y1[1] = __uint_as_float(a1.x & 0xffff0000u) + __uint_as_float(b1.x & 0xffff0000u);
                y1[2] = __uint_as_float(a1.y << 16) + __uint_as_float(b1.y << 16); y1[3] = __uint_as_float(a1.y & 0xffff0000u) + __uint_as_float(b1.y & 0xffff0000u);
                v[j] = xv * ALPHA + y0 * g0 + y1 * g1;
            }
        }
#pragma unroll
        for (int j = 0; j < 4; ++j) s += (v[j][0] + v[j][1]) + (v[j][2] + v[j][3]);
        const float mean = wave_sum(s) * (1.f / D); float q = 0.f;
#pragma unroll
        for (int j = 0; j < 4; ++j) { v[j] = v[j] - mean; q += (v[j][0] * v[j][0] + v[j][1] * v[j][1]) + (v[j][2] * v[j][2] + v[j][3] * v[j][3]); }
        const float rstd = rsqrtf(wave_sum(q) * (1.f / D) + LN_EPS);
#pragma unroll
        for (int j = 0; j < 4; ++j) {
            const f32x4 gg = *((const GAS f32x4*)a.gam + lane + 64 * j), bb = *((const GAS f32x4*)a.bet + lane + 64 * j);
            v[j] = v[j] * rstd * gg + bb;
            *((GAS f32x4*)(a.xout + (size_t)row * D) + lane + 64 * j) = v[j];
            v2u w; w.x = pk2(v[j][0], v[j][1]); w.y = pk2(v[j][2], v[j][3]);
            *((GAS v2u*)(a.xb + (size_t)row * D) + lane + 64 * j) = w;
        }
        if (a.route) {
            float lg[8];
#pragma unroll
            for (int e = 0; e < 8; ++e) lg[e] = 0.f;
#pragma unroll
            for (int j = 0; j < 4; ++j)
#pragma unroll
                for (int i = 0; i < 4; ++i) { const int d = 4 * lane + 256 * j + i; const f32x4 r0 = *(const GAS f32x4*)(a.router + d * 8), r1 = *(const GAS f32x4*)(a.router + d * 8 + 4); const float xv = v[j][i];
                    lg[0] += xv * r0[0]; lg[1] += xv * r0[1]; lg[2] += xv * r0[2]; lg[3] += xv * r0[3]; lg[4] += xv * r1[0]; lg[5] += xv * r1[1]; lg[6] += xv * r1[2]; lg[7] += xv * r1[3]; }
#pragma unroll
            for (int e = 0; e < 8; ++e) lg[e] = wave_sum(lg[e]);
            if (lane == 0) {
                int e0 = 0; float l0 = lg[0];
#pragma unroll
                for (int e = 1; e < 8; ++e) if (lg[e] > l0) { l0 = lg[e]; e0 = e; }
                int e1 = 0; float l1 = -INFINITY;
#pragma unroll
                for (int e = 0; e < 8; ++e) if (e != e0 && lg[e] > l1) { l1 = lg[e]; e1 = e; }
                const float g1 = __expf(l1 - l0), den = 1.f + g1;
                a.top_e[row * 2] = e0; a.top_e[row * 2 + 1] = e1; a.top_gw[row * 2] = 1.f / den; a.top_gw[row * 2 + 1] = g1 / den;
                __hip_atomic_fetch_add(a.lhist + e0, 1u, __ATOMIC_RELAXED, __HIP_MEMORY_SCOPE_WORKGROUP); __hip_atomic_fetch_add(a.lhist + e1, 1u, __ATOMIC_RELAXED, __HIP_MEMORY_SCOPE_WORKGROUP);
            }
        }
    }
}

struct Args { const float* in[38]; float* out; unsigned char* ws; };
template <int I> __device__ __forceinline__ const float* in_ptr() {
    unsigned long long v; auto kp = __builtin_amdgcn_kernarg_segment_ptr();
    asm volatile("s_load_dwordx2 %0, %1, %2\n\ts_waitcnt lgkmcnt(0)" : "=s"(v) : "s"(kp), "n"(I * 8));
    return (const float*)v;
}
#define IN(i) in_ptr<(i)>()
#ifndef DIAG_A
#define DIAG_A -1
#define DIAG_B -1
#define DIAG_DIV 100000.f
#endif
#define PHASE_IDS() int tid = threadIdx.x; asm volatile("" : "+v"(tid)); const int lane = tid & 63; (void)lane
#ifndef DUP_PHASE
#define DUP_PHASE -1
#define DUP_N 5
#endif
#define DUP_BEGIN(id) _Pragma("unroll") for (int rep_ = 0; rep_ < ((DUP_PHASE == (id)) ? DUP_N : 1); ++rep_) {
#define DUP_END() GRID_BAR(); }
#define DUP_END2() }
#define GRID_BAR() do { xcd_barrier(bar); if (DIAG_A >= -1 && DIAG_B >= 0) { if (bx == 0 && threadIdx.x == 0) ((GAS unsigned long long*)(args.ws + WS_CTL + 262144))[nst] = __builtin_amdgcn_s_memrealtime(); ++nst; } } while (0)
template <int L, bool DO_IN, bool DO_MIX, bool DO_POST>
__device__ __forceinline__ void layer_body(const Args& args, LAS unsigned char* lds, const XcdBarrier& bar, int tid0, int lane0, int wave, int G, int bx, int vcu, int gw, int NGW, int& nst) {
    (void)tid0; (void)lane0;
    unsigned char* ws = args.ws;
    gu32* ctl = (gu32*)(ws + WS_CTL);
    bf16* Wmoegu = (bf16*)(ws + WS_MOEGU); bf16* Wmoed = (bf16*)(ws + WS_MOED);
    bf16* vfirst = (bf16*)(ws + WS_VFIRST);
    bf16* zb = (bf16*)(ws + WS_Z); bf16* mix = (bf16*)(ws + WS_MIX); float* preln = (float*)(ws + WS_PRELN);
    float* gla_logf = (float*)(ws + WS_PREP); float* rwb = (float*)(ws + WS_PREP + 8 * MiB);
    const float* PB = (const float*)(ws + WS_MISC + MS_PARAMS); int* top_e = (int*)(ws + WS_MISC + MS_TOPE); float* top_g = (float*)(ws + WS_MISC + MS_TOPG);
    int* tok_row = (int*)(ws + WS_MISC + MS_TOKROW); int* row_tok = (int*)(ws + WS_MISC + MS_ROWTOK); int* tile_e = (int*)(ws + WS_MISC + MS_TILEE);
    float* xf = args.out;

        bf16* xb_in = (bf16*)(ws + (L == 0 ? WS_XB0 : WS_XB1)); bf16* xb_out = (bf16*)(ws + (L == 0 ? WS_XB1 : WS_XB0));
        const float* xres = (L == 0) ? IN(0) : xf;
        if constexpr (DO_IN) {
        DUP_BEGIN(L * 100 + 1)
        {
            pg8::Gemm g{xb_in, (const bf16*)(ws + (L == 0 ? WS_WIN0 : WS_WIN1)), T, ZLD, D}; pg8::StaticOrder S; S.init(T, ZLD, G, bx);
            pg8::EpiStoreBf16 E{zb, ZLD};
            pg8::gemm_phase<pg8::EpiStoreBf16, pg8::StaticOrder, PG8_ALIGN, PG8_SP2>(lds, g, S, E);
        }
        DUP_END();
        }
        if constexpr (DO_MIX) {
        float* sst = (float*)(ws + WS_SST); bf16* mtb = (bf16*)(ws + WS_MT); float* dsc = (float*)(ws + WS_MISC + MS_DSC);
        DUP_BEGIN(L * 100 + 3)
        DUP_BEGIN(L * 100 + 2)
        {
            PHASE_IDS(); const int lo = lane & 15, h = lane >> 4;
            const int j = vcu >> 2, hd = vcu & 3, cb = 16 * j, ce = cb + 16;
            DUP_BEGIN(L * 100 + 20)
            if (wave < 4) { RwkvPrepArgs rp; rp.z = zb; rp.P = PB; rp.vfirst = vfirst; rp.pack = ws + WS_RWPACK; rp.gout = (bf16*)(ws + WS_GOUT); rp.vout = (bf16*)(ws + WS_VOUT); rp.bcout = (float*)(ws + WS_BC);
                rwkv_prep_wave<L>(rp, hd, cb + wave, 4, ce, lds + wave * RWL_BYTES, lane); }
            else { GlaPrepArgs g0; g0.z = zb; g0.P = PB; g0.pack = ws + WS_GLPACK; GlaPrepArgs g1 = g0; g1.pack = ws + WS_HGPACK;
                gla_prep_wave<L, 0>(g0, hd, cb + wave - 4, 4, ce, lds + 4 * RWL_BYTES + (wave - 4) * GLL_BYTES, lane);
                gla_prep_wave<L, 1>(g1, hd, cb + wave - 4, 4, ce, lds + 4 * RWL_BYTES + (wave - 4) * GLL_BYTES, lane); }
            DUP_END2()
            VM_WAIT(); __syncthreads();
            DUP_BEGIN(L * 100 + 21)
            {
                RwkvSeqArgs sa; sa.pack = ws + WS_RWPACK; f32x4 St[4];
                if (wave < 4) {
#pragma unroll
                    for (int m = 0; m < 4; ++m) St[m] = (f32x4){0.f, 0.f, 0.f, 0.f};
                    rwkv_seq_wave<0>(sa, hd, wave, cb, ce, St, lane, nullptr);
                    float* o = sst + ((size_t)((8 + hd) * 64 + j)) * 4096 + (wave * 4 * 64 + lane) * 4;
#pragma unroll
                    for (int m = 0; m < 4; ++m) *(GAS f32x4*)(o + m * 256) = St[m];
                } else {
                    const int pb = wave - 4;
#pragma unroll
                    for (int m = 0; m < 4; ++m)
#pragma unroll
                        for (int r = 0; r < 4; ++r) St[m][r] = (16 * m + 4 * h + r == 16 * pb + lo) ? 1.f : 0.f;
                    rwkv_seq_wave<1>(sa, hd, pb, cb, ce, St, lane, nullptr);
                    bf16* o = mtb + ((size_t)(hd * 64 + j)) * 4096 + (lo & 3);
#pragma unroll
                    for (int m = 0; m < 4; ++m)
#pragma unroll
                        for (int r = 0; r < 4; ++r) o[(16 * m + 4 * h + r) * 64 + ((((16 * pb + lo) >> 2) ^ (4 * h + r)) << 2)] = (bf16)f2bf(St[m][r]);
                }
            }
            DUP_END2()
            DUP_BEGIN(L * 100 + 22)
            {
                f32x4 S[4], Dp[4];
#pragma unroll
                for (int m = 0; m < 4; ++m) { S[m] = (f32x4){0.f, 0.f, 0.f, 0.f}; Dp[m] = (f32x4){1.f, 1.f, 1.f, 1.f}; }
                const int vb = wave & 3, mt = wave >> 2, mh = mt * 4 + hd;
                GlaSeqArgs sa; sa.pack = ws + (mt ? WS_HGPACK : WS_GLPACK);
                if (mt == 0) gla_seq_wave<0, false>(sa, hd, vb, cb, ce, S, Dp, lane, nullptr); else gla_seq_wave<1, false>(sa, hd, vb, cb, ce, S, Dp, lane, nullptr);
                float* o = sst + ((size_t)(mh * 64 + j)) * 4096 + (vb * 4 * 64 + lane) * 4;
#pragma unroll
                for (int m = 0; m < 4; ++m) if (mt || m < 2) *(GAS f32x4*)(o + m * 256) = S[m];
                if (vb == 0 && lo == 0) {
#pragma unroll
                    for (int m = 0; m < 4; ++m) if (mt || m < 2) *(GAS f32x4*)(dsc + ((size_t)(mh * 64 + j)) * 64 + 16 * m + 4 * h) = Dp[m]; }
            }
            DUP_END2()
        }
        DUP_END();
        {
            PHASE_IDS(); const int lo = lane & 15, h = lane >> 4;
            if (bx < 48) {
                const int gt = bx * (NWAVES * 64) + tid; int mh, e, mm;
                if (gt < 8192) { mh = gt >> 11; e = gt & 2047; mm = (e >> 8) & 1; e = ((e >> 9) * 4 + mm) * 256 + (e & 255); }
                else { const int g2 = gt - 8192; mh = 4 + (g2 >> 12); e = g2 & 4095; mm = (e >> 8) & 3; }
                const int k = 16 * mm + 4 * ((e & 255) >> 6) + (e & 3);
                float* sp = sst + (size_t)mh * 64 * 4096 + e; const float* dp = dsc + (size_t)mh * 64 * 64 + k;
                float S = 0.f;
#pragma unroll 1
                for (int j0 = 0; j0 < 64; j0 += 8) {
                    float sl[8], dd[8];
#pragma unroll
                    for (int u = 0; u < 8; ++u) { sl[u] = sp[(size_t)(j0 + u) * 4096]; dd[u] = dp[(j0 + u) * 64]; }
#pragma unroll
                    for (int u = 0; u < 8; ++u) { sp[(size_t)(j0 + u) * 4096] = S; S = dd[u] * S + sl[u]; }
                }
            } else if (bx < 52) {
                const int hd = bx - 48, vb = wave & 3;
                f32x4 St[4], N0[4], N1[4], N2[4];
#pragma unroll
                for (int m = 0; m < 4; ++m) St[m] = (f32x4){0.f, 0.f, 0.f, 0.f};
                float* sp = sst + ((size_t)(8 + hd) * 64) * 4096 + (vb * 4 * 64 + lane) * 4;
                const unsigned char* mg = (const unsigned char*)(mtb + ((size_t)hd * 64) * 4096);
#define RW_NLOAD(N_, jj) do { _Pragma("unroll") for (int m = 0; m < 4; ++m) N_[m] = *(const GAS f32x4*)(sp + (size_t)(jj) * 4096 + m * 256); } while (0)
                if (wave < 4) { RW_NLOAD(N0, 0); RW_NLOAD(N1, 1); RW_NLOAD(N2, 2); }
#pragma unroll 1
                for (int rd = 0; rd < 4; ++rd) {
                    __syncthreads();
                    if (wave < 4) {
#pragma unroll 8
                        for (int i = 0; i < 32; ++i) { const int q = wave * 32 + i;
                            __builtin_amdgcn_global_load_lds((const unsigned*)(mg + (size_t)(16 * rd) * 8192 + (size_t)q * 1024 + lane * 16), (LAS unsigned*)(lds + q * 1024), 16, 0, 0); }
                    }
                    VM_WAIT(); __syncthreads();
                    if (wave < 4) {
#pragma unroll 1
                        for (int jj = 0; jj < 16; ++jj) {
                            const int j = 16 * rd + jj;
                            const LAS unsigned char* ms = lds + jj * 8192 + lo * 128;
                            bf16x8 Af[4][2];
#pragma unroll
                            for (int m = 0; m < 4; ++m)
#pragma unroll
                                for (int s2 = 0; s2 < 2; ++s2) Af[m][s2] = frag2(*(const LAS v2u*)(ms + m * 2048 + (((8 * s2 + h) ^ lo) << 3)), *(const LAS v2u*)(ms + m * 2048 + (((8 * s2 + 4 + h) ^ lo) << 3)));
                            const bf16x8 B0 = pack8(St[0], St[1]), B1 = pack8(St[2], St[3]);
#pragma unroll
                            for (int m = 0; m < 4; ++m) { *(GAS f32x4*)(sp + (size_t)j * 4096 + m * 256) = St[m]; }
#pragma unroll
                            for (int m = 0; m < 4; ++m) { f32x4 a = MFMA16(Af[m][0], B0, N0[m]); St[m] = MFMA16(Af[m][1], B1, a); }
#pragma unroll
                            for (int m = 0; m < 4; ++m) { N0[m] = N1[m]; N1[m] = N2[m]; }
                            { const int jn = (j + 3 < 64) ? j + 3 : 63; RW_NLOAD(N2, jn); }
                        }
                    }
                }
#undef RW_NLOAD
            } else swa_items(zb, PB + P_SINK + L * 4, mix, bx - 52, G - 52, lds, tid);
        }
        DUP_END();
        DUP_BEGIN(L * 100 + 4)
        {
            PHASE_IDS();
            const int j = vcu >> 2, hd = vcu & 3, cb = 16 * j, ce = cb + 16;
            if (tid < 2) ((LAS unsigned*)(lds + 16384))[tid * 16] = 0u;
            __syncthreads();
            PostCtx pc; pc.xbuf = (LAS float*)(lds + (wave >> 2) * 8192); pc.cnt = (volatile LAS unsigned*)(lds + 16384) + (wave >> 2) * 16; pc.step = 0u;
            pc.z = zb; pc.P = PB; pc.g = (const bf16*)(ws + WS_GOUT); pc.v = (const bf16*)(ws + WS_VOUT); pc.bc = (const float*)(ws + WS_BC); pc.mix = mix; pc.layer = L;
            if (wave < 4) {
                RwkvSeqArgs sa; sa.pack = ws + WS_RWPACK; f32x4 St[4];
                const float* o = sst + ((size_t)((8 + hd) * 64 + j)) * 4096 + (wave * 4 * 64 + lane) * 4;
#pragma unroll
                for (int m = 0; m < 4; ++m) St[m] = *(const GAS f32x4*)(o + m * 256);
                rwkv_seq_wave<2>(sa, hd, wave, cb, ce, St, lane, &pc);
            } else {
                const int vb = wave - 4; f32x4 S[4], Dp[4];
                {
                    GlaSeqArgs sa; sa.pack = ws + WS_GLPACK; const float* o = sst + ((size_t)(hd * 64 + j)) * 4096 + (vb * 4 * 64 + lane) * 4;
#pragma unroll
                    for (int m = 0; m < 4; ++m) { S[m] = (m < 2) ? *(const GAS f32x4*)(o + m * 256) : (f32x4){0.f, 0.f, 0.f, 0.f}; Dp[m] = S[m]; }
                    gla_seq_wave<0, true>(sa, hd, vb, cb, ce, S, Dp, lane, &pc);
                }
                {
                    GlaSeqArgs sa; sa.pack = ws + WS_HGPACK; const float* o = sst + ((size_t)((4 + hd) * 64 + j)) * 4096 + (vb * 4 * 64 + lane) * 4;
#pragma unroll
                    for (int m = 0; m < 4; ++m) { S[m] = *(const GAS f32x4*)(o + m * 256); Dp[m] = S[m]; }
                    gla_seq_wave<1, true>(sa, hd, vb, cb, ce, S, Dp, lane, &pc);
                }
            }
        }
        DUP_END();
        }
        if constexpr (DO_POST) {
        DUP_BEGIN(L * 100 + 99) if (rep_ == 0) continue; DUP_END();
        DUP_BEGIN(L * 100 + 6)
        {
            pg8::Gemm g{mix, (const bf16*)(ws + (L == 0 ? WS_WOUT0 : WS_WOUT1)), T, D, D}; pg8::StaticOrder S; S.init(T, D, G, bx);
            pg8::EpiResBf16 E{xres, (bf16*)preln, D, ALPHA};
            pg8::gemm_phase<pg8::EpiResBf16, pg8::StaticOrder, PG8_ALIGN, PG8_SP2>(lds, g, S, E);
        }
        DUP_END();
        DUP_BEGIN(L == 0 ? 7 : -77)
        {
            PHASE_IDS(); LnArgs la{}; la.src = preln; la.gam = PB + P_LN1G + L * D; la.bet = PB + P_LN1B + L * D; la.xout = xf; la.xb = xb_in; la.mode = 0;
            la.route = (L == 1); la.router = PB + P_ROUTER; la.top_e = top_e; la.top_gw = top_g; la.cnt = ctl + CW_MOE; la.lhist = (LAS unsigned*)lds;
            if (L == 1) { if (tid < 8) ((LAS unsigned*)lds)[tid] = 0u; __syncthreads(); }
            ln_rows(la, gw, NGW, lane);
            if (L == 1) { LDS_WAIT(); __syncthreads(); if (tid < 8) { const unsigned hv = ((LAS unsigned*)lds)[tid]; ((int*)(ws + WS_MISC + MS_HIST))[vcu * 8 + tid] = (int)hv; __hip_atomic_fetch_add(ctl + CW_MOE + tid, hv, RLX_AGENT); } }
        }
        DUP_END();
        if constexpr (L == 0) {
        DUP_BEGIN(L * 100 + 8)
            {
                pg8::Gemm g{xb_in, (const bf16*)(ws + WS_FGU), T, 2 * DFF, D}; pg8::StaticOrder S; S.init(T, 2 * DFF, G, bx);
                pg8::EpiSwiglu E{(bf16*)(ws + WS_HD), DFF};
                pg8::gemm_phase<pg8::EpiSwiglu, pg8::StaticOrder, PG8_ALIGN, PG8_SP2>(lds, g, S, E);
            }
            {
                constexpr int NHEAVY = (T / 256) * (2 * DFF / 256) - 5 * 256;
                pg8::Gemm g{(const bf16*)(ws + WS_PB0), (const bf16*)(ws + WS_PP0), T, D, 256}; pg8::StaticOrder S; S.init(T, D, G - NHEAVY, bx >= NHEAVY ? bx - NHEAVY : (1 << 20));
                pg8::EpiStoreBf16 E{(bf16*)(ws + WS_MIX), D};
                pg8::gemm_phase<pg8::EpiStoreBf16, pg8::StaticOrder, PG8_ALIGN, PG8_SP2>(lds, g, S, E);
            }
            DUP_END();
        DUP_BEGIN(L * 100 + 9)
            {
                pg8::Gemm g{(const bf16*)(ws + WS_HD), (const bf16*)(ws + WS_FD), T, D, DFF}; pg8::StaticOrder S; S.init(T, D, G, bx);
                pg8::EpiResBf16 E{xf, (bf16*)preln, D, ALPHA};
                pg8::gemm_phase<pg8::EpiResBf16, pg8::StaticOrder, PG8_ALIGN, PG8_SP2>(lds, g, S, E);
            }
            DUP_END();
            {
                PHASE_IDS(); LnArgs la{}; la.src = preln; la.gam = PB + P_LN2G + L * D; la.bet = PB + P_LN2B + L * D; la.xout = xf; la.xb = xb_in; la.mode = 0; la.route = 0;
                ln_rows(la, gw, NGW, lane);
            }
        } else {
            int start[NE + 1]; int nrt;
            {
                PHASE_IDS();
                int off = 0;
#pragma unroll
                for (int e = 0; e < NE; ++e) { start[e] = off; const int c = (int)__hip_atomic_load(ctl + CW_MOE + e, RLX_AGENT); off += (c + 255) / 256 * 256; }
                start[NE] = off; nrt = off / 256;
                if (bx == 0 && tid < MOE_MAXTILES) { int e = 0;
#pragma unroll
                    for (int q = 1; q < NE; ++q) if (tid * 256 >= start[q]) e = q;
                    tile_e[tid] = e; }
                LAS int* lofs = (LAS int*)lds;
                if (tid < 8) lofs[tid] = 0;
                __syncthreads();
                if (tid < vcu) { const int* hp = (const int*)(ws + WS_MISC + MS_HIST) + tid * 8;
#pragma unroll
                    for (int q = 0; q < NE; ++q) { const int hv = hp[q]; if (hv) __hip_atomic_fetch_add((LAS unsigned*)lofs + q, (unsigned)hv, __ATOMIC_RELAXED, __HIP_MEMORY_SCOPE_WORKGROUP); } }
                LDS_WAIT(); __syncthreads();
                if (wave == 0) {
                    int run[NE];
#pragma unroll
                    for (int q = 0; q < NE; ++q) run[q] = start[q] + lofs[q];
#pragma unroll
                    for (int hc = 0; hc < 2; ++hc) {
                        const int idx = lane + 64 * hc, tok = vcu * 8 + (idx >> 4) + 2048 * ((idx >> 1) & 7), i = tok * 2 + (idx & 1);
                        const int e = top_e[i]; int dest = 0;
#pragma unroll
                        for (int q = 0; q < NE; ++q) { const unsigned long long m = __ballot(e == q);
                            if (e == q) dest = run[q] + __builtin_popcountll(m & ((1ull << lane) - 1ull));
                            run[q] += __builtin_popcountll(m); }
                        row_tok[dest] = tok; tok_row[i] = dest;
                    }
                }
            }
            GRID_BAR();
            DUP_BEGIN(121)
            {
                PHASE_IDS(); bf16* xg = (bf16*)(ws + WS_XG);
                for (int row = gw; row < nrt * 256; row += NGW) { const int t = row_tok[row];
                    const v4u a = *((const GAS v4u*)(xb_in + (size_t)t * D) + lane), b = *((const GAS v4u*)(xb_in + (size_t)t * D) + 64 + lane);
                    *((GAS v4u*)(xg + (size_t)row * D) + lane) = a; *((GAS v4u*)(xg + (size_t)row * D) + 64 + lane) = b; }
            }
            DUP_END();
#pragma unroll
            for (int hh = 0; hh < 2; ++hh) {
                if (hh == 1) { DUP_BEGIN(125) PHASE_IDS(); moe_weights_half<2>(IN(33), IN(34), IN(35), Wmoegu, Wmoed, 1, gw, NGW, (LAS float*)(lds + wave * 16384), lane); DUP_END(); }
                DUP_BEGIN(122 + 4 * hh)
                {
                    pg8::Gemm g{(const bf16*)(ws + WS_XG), Wmoegu, MOE_MAXROWS, 0, D}; pg8::MoeOrder S{tile_e, nrt, 14, G, bx};
                    pg8::EpiSwiglu E{(bf16*)(ws + WS_HM), DFH};
                    pg8::gemm_phase<pg8::EpiSwiglu, pg8::MoeOrder, PG8_ALIGN, PG8_SP2>(lds, g, S, E);
                }
                if (hh == 0) {
                    const int nun = nrt * 14, nfull = nun / G, heavy = nun - nfull * G;
                    const int glight = G - heavy;
                    pg8::Gemm g{(const bf16*)(ws + WS_PB1), (const bf16*)(ws + WS_PP1), T, D, 256}; pg8::StaticOrder S; S.init(T, D, glight > 0 ? glight : 1, (bx >= heavy && glight > 0) ? bx - heavy : (1 << 20));
                    pg8::EpiStoreBf16 E{(bf16*)(ws + WS_XB0), D};
                    pg8::gemm_phase<pg8::EpiStoreBf16, pg8::StaticOrder, PG8_ALIGN, PG8_SP2>(lds, g, S, E);
                }
                DUP_END();
                DUP_BEGIN(123 + 4 * hh)
                {
                    pg8::Gemm g{(const bf16*)(ws + WS_HM), Wmoed, MOE_MAXROWS, 0, DFH}; pg8::MoeOrder S{tile_e, nrt, 4, G, bx};
                    pg8::EpiStoreBf16 E{(bf16*)(ws + (hh == 0 ? WS_Y1 : WS_XG)), D};
                    pg8::gemm_phase<pg8::EpiStoreBf16, pg8::MoeOrder, PG8_ALIGN, PG8_SP2>(lds, g, S, E);
                }
                if (hh == 0) {
                    PHASE_IDS();
                    const int nun = nrt * 4, nfull = nun / G, heavy = nun - nfull * G;
                    if (bx >= heavy) moe_weights_half<1>(IN(33), IN(34), IN(35), Wmoegu, Wmoed, 1, (bx - heavy) * NWAVES + wave, (G - heavy) * NWAVES, (LAS float*)(lds + wave * 16384), lane);
                }
                DUP_END();
            }
            {
                PHASE_IDS(); LnArgs la{}; la.gam = PB + P_LN2G + L * D; la.bet = PB + P_LN2B + L * D; la.xout = xf; la.xb = xb_in; la.mode = 1; la.Y1 = (const bf16*)(ws + WS_Y1); la.Y2 = (const bf16*)(ws + WS_XG);
                la.tok_row = tok_row; la.top_g = top_g; la.route = 0;
                ln_rows(la, gw, NGW, lane);
            }
        }
        GRID_BAR();
        {
            pg8::Gemm g{xb_in, (const bf16*)(ws + (L == 0 ? WS_PG0 : WS_PG1)), T, D, D}; pg8::StaticOrder S; S.init(T, D, G, bx);
            float osc = 1.f;
            if (DIAG_B >= 0 && L == 1) { const GAS unsigned long long* tsb = (const GAS unsigned long long*)(args.ws + WS_CTL + 262144); const unsigned long long ta = tsb[DIAG_A < 0 ? 63 : DIAG_A], tb = tsb[DIAG_B]; osc = 1.f + (float)(tb - ta) / DIAG_DIV; }
            pg8::EpiPle E{xf, (const bf16*)(ws + (L == 0 ? WS_MIX : WS_XB0)), (L == 0) ? xb_out : (bf16*)nullptr, D, osc};
            pg8::gemm_phase<pg8::EpiPle, pg8::StaticOrder, PG8_ALIGN, PG8_SP2>(lds, g, S, E);
        }
        }
}
__global__ void __launch_bounds__(NWAVES * 64, 2) mega_fwd(Args args, int seg) {
    extern __shared__ __attribute__((aligned(16))) unsigned char lds_raw[];
    LAS unsigned char* lds = (LAS unsigned char*)lds_raw;
    volatile LAS unsigned* MISC = (volatile LAS unsigned*)(lds + MISC_OFF);
    const int tid = threadIdx.x, lane = tid & 63, wave = __builtin_amdgcn_readfirstlane(tid >> 6);
    const int G = gridDim.x, bx = blockIdx.x; const int vcu = (G % 8 == 0) ? (bx % 8) * (G / 8) + bx / 8 : bx;
    const int gw = vcu * NWAVES + wave, NGW = G * NWAVES;
    unsigned char* ws = args.ws;
    gu32* ctl = (gu32*)(ws + WS_CTL);
    for (int u = tid; u < (LDS_BYTES - RING_BYTES) / 4; u += NWAVES * 64) ((LAS unsigned*)(lds + RING_BYTES))[u] = 0u;
    __syncthreads();
    int nst = 0; if (DIAG_B >= 0 && bx == 0 && tid == 0) ((GAS unsigned long long*)(args.ws + WS_CTL + 262144))[63] = __builtin_amdgcn_s_memrealtime();
    XcdBarrier bar = xcd_barrier_post((unsigned*)(ctl + CW_BAR) + (seg < 0 ? 0 : seg) * XCD_BAR_WORDS, MISC + 8);
    bf16* Wmoegu = (bf16*)(ws + WS_MOEGU); bf16* Wmoed = (bf16*)(ws + WS_MOED);
    bf16* vfirst = (bf16*)(ws + WS_VFIRST);
    bf16* zb = (bf16*)(ws + WS_Z); bf16* mix = (bf16*)(ws + WS_MIX); float* preln = (float*)(ws + WS_PRELN);
    float* gla_logf = (float*)(ws + WS_PREP); float* rwb = (float*)(ws + WS_PREP + 8 * MiB);
    const float* PB = (const float*)(ws + WS_MISC + MS_PARAMS); int* top_e = (int*)(ws + WS_MISC + MS_TOPE); float* top_g = (float*)(ws + WS_MISC + MS_TOPG);
    int* tok_row = (int*)(ws + WS_MISC + MS_TOKROW); int* row_tok = (int*)(ws + WS_MISC + MS_ROWTOK); int* tile_e = (int*)(ws + WS_MISC + MS_TILEE);
    float* xf = args.out;

    {
    DUP_BEGIN(0)
    {
        PHASE_IDS(); LAS float* scr = (LAS float*)(lds + wave * 16384);
        constexpr int I_WIN = 16 * 99, I_VD = 16, I_SQ = 16 * 32, I_FG = 16 * 88, I_FD = 44 * 32, I_PP = 4 * 32;
        constexpr int NIT = 2 * I_WIN + I_VD + 4 * I_SQ + 2 * I_FG + I_FD + 2 * I_PP;
        for (int it = gw; it < NIT; it += NGW) {
            int r = it; const float* src; int ldw, nblocks, ncols, dld, il = 0, rowoff = 0; bf16* dst;
            if (r < I_WIN) { src = IN(2); ldw = PIN; nblocks = 99; ncols = PIN; dst = (bf16*)(ws + WS_WIN0); dld = D; }
            else if ((r -= I_WIN) < I_WIN) { src = IN(2) + (size_t)D * PIN; ldw = PIN; nblocks = 99; ncols = PIN; dst = (bf16*)(ws + WS_WIN1); dld = D; }
            else if ((r -= I_WIN) < I_VD) { src = IN(21); ldw = 8; nblocks = 1; ncols = 8; dst = (bf16*)(ws + WS_WIN1); dld = D; rowoff = PIN; }
            else if ((r -= I_VD) < I_SQ) { src = IN(3); ldw = D; nblocks = 32; ncols = D; dst = (bf16*)(ws + WS_WOUT0); dld = D; }
            else if ((r -= I_SQ) < I_SQ) { src = IN(3) + (size_t)D * D; ldw = D; nblocks = 32; ncols = D; dst = (bf16*)(ws + WS_WOUT1); dld = D; }
            else if ((r -= I_SQ) < I_SQ) { src = IN(37); ldw = D; nblocks = 32; ncols = D; dst = (bf16*)(ws + WS_PG0); dld = D; }
            else if ((r -= I_SQ) < I_SQ) { src = IN(37) + (size_t)D * D; ldw = D; nblocks = 32; ncols = D; dst = (bf16*)(ws + WS_PG1); dld = D; }
            else if ((r -= I_SQ) < I_FG) { src = IN(29); ldw = DFF; nblocks = 88; ncols = DFF; dst = (bf16*)(ws + WS_FGU); dld = D; il = 1; }
            else if ((r -= I_FG) < I_FG) { src = IN(30); ldw = DFF; nblocks = 88; ncols = DFF; dst = (bf16*)(ws + WS_FGU); dld = D; il = 1; rowoff = 128; }
            else if ((r -= I_FG) < I_FD) { src = IN(31); ldw = D; nblocks = 32; ncols = D; dst = (bf16*)(ws + WS_FD); dld = DFF; }
            else if ((r -= I_FD) < I_PP) { src = IN(36); ldw = D; nblocks = 32; ncols = D; dst = (bf16*)(ws + WS_PP0); dld = 256; }
            else { r -= I_PP; src = IN(36) + (size_t)256 * D; ldw = D; nblocks = 32; ncols = D; dst = (bf16*)(ws + WS_PP1); dld = 256; }
            tr_job(src, ldw, nblocks, ncols, dst, dld, il, rowoff, r, scr, lane);
        }
        moe_weights_half<3>(IN(33), IN(34), IN(35), Wmoegu, Wmoed, 0, gw, NGW, scr, lane);
        const size_t gtid = (size_t)vcu * (NWAVES * 64) + tid, nth = (size_t)G * NWAVES * 64;
        for (size_t i = gtid * 8; i < (size_t)(ZLD - PIN) * D; i += nth * 8) *(GAS v4u*)((bf16*)(ws + WS_WIN0) + (size_t)PIN * D + i) = (v4u){0u, 0u, 0u, 0u};
        for (size_t i = gtid * 8; i < (size_t)(ZLD - PIN - 8) * D; i += nth * 8) *(GAS v4u*)((bf16*)(ws + WS_WIN1) + (size_t)(PIN + 8) * D + i) = (v4u){0u, 0u, 0u, 0u};
        cvt_rows(IN(0), (bf16*)(ws + WS_XB0), (size_t)T * D, gtid, nth);
        cvt_rows(IN(1), (bf16*)(ws + WS_PB0), (size_t)T * 256, gtid, nth);
        cvt_rows(IN(1) + (size_t)T * 256, (bf16*)(ws + WS_PB1), (size_t)T * 256, gtid, nth);
        {
            float* PW = (float*)(ws + WS_MISC + MS_PARAMS);
#define CPY(idx, off, n) do { const float* _s = IN(idx); for (int _i = (int)gtid; _i < (n); _i += (int)nth) PW[(off) + _i] = _s[_i]; } while (0)
            CPY(4, P_GKUP, 4096); CPY(5, P_GKB, 256); CPY(6, P_GNW, 128); CPY(7, P_HLB, 512); CPY(8, P_HNW, 128); CPY(9, P_SINK, 8); CPY(10, P_MU, 1664); CPY(11, P_W0, 512);
            CPY(12, P_WUP, 8192); CPY(13, P_A0, 512); CPY(14, P_AUP, 8192); CPY(15, P_GUP, 16384); CPY(16, P_KK, 512); CPY(17, P_KA, 512); CPY(18, P_RK, 512); CPY(19, P_LNXW, 512);
            CPY(20, P_LNXB, 512); CPY(22, P_VMU, 8); CPY(23, P_V0, 256); CPY(24, P_VUP, 2048); CPY(25, P_LN1G, 2048); CPY(26, P_LN1B, 2048); CPY(27, P_LN2G, 2048); CPY(28, P_LN2B, 2048);
            CPY(32, P_ROUTER, 8192);
#undef CPY
            if (bx == 0 && tid < 256) { const float* hl = IN(7); const float a = hl[tid], b = hl[256 + tid]; const float m = fmaxf(a, b); const float ea = __expf(a - m), eb = __expf(b - m); PW[P_LBS + tid] = 0.f; PW[P_LBS + 256 + tid] = eb / (ea + eb); }
        }
        for (int i = (int)gtid; i < MOE_MAXROWS; i += (int)nth) row_tok[i] = 0;
    }
    DUP_END();

    }
    layer_body<0, true, true, true>(args, lds, bar, tid, lane, wave, G, bx, vcu, gw, NGW, nst);
    GRID_BAR();
    layer_body<1, true, true, true>(args, lds, bar, tid, lane, wave, G, bx, vcu, gw, NGW, nst);
}
#undef IN


extern "C" void kernel_launch(void* const* d_in, const int* in_sizes, int n_in, void* d_out, int out_size, void* d_ws, size_t ws_size, hipStream_t stream) {
    static int grid = 0;
    if (grid == 0) {
        if (n_in != 38 || in_sizes[0] != T * D || out_size != T * D || ws_size < WS_END) { fprintf(stderr, "kernel_launch: unexpected problem (n_in %d, in0 %d, out %d, ws %zu < %zu)\n", n_in, n_in > 0 ? in_sizes[0] : -1, out_size, ws_size, (size_t)WS_END); grid = -1; return; }
        int dev = 0, cus = 0, per_cu = 0;
        if (hipGetDevice(&dev) != hipSuccess || hipDeviceGetAttribute(&cus, hipDeviceAttributeMultiprocessorCount, dev) != hipSuccess) { grid = -1; return; }
        if (hipFuncSetAttribute((const void*)mega_fwd, hipFuncAttributeMaxDynamicSharedMemorySize, LDS_BYTES) != hipSuccess) { fprintf(stderr, "kernel_launch: hipFuncSetAttribute failed\n"); grid = -1; return; }
        if (hipOccupancyMaxActiveBlocksPerMultiprocessor(&per_cu, (const void*)mega_fwd, NWAVES * 64, LDS_BYTES) != hipSuccess || per_cu < 1) { fprintf(stderr, "kernel_launch: occupancy query says %d\n", per_cu); per_cu = 1; }
        (void)hipGetLastError();
        grid = cus;
    }
    if (grid < 0) return;
    if (hipMemsetAsync((char*)d_ws + WS_CTL, 0, CTL_BYTES, stream) != hipSuccess) { fprintf(stderr, "kernel_launch: memset failed\n"); return; }
    Args a{};
    for (int i = 0; i < 38; ++i) a.in[i] = (const float*)d_in[i];
    a.out = (float*)d_out; a.ws = (unsigned char*)d_ws;
    int seg = -1; void* kargs[] = {&a, &seg};
    hipError_t e = hipLaunchCooperativeKernel((const void*)mega_fwd, dim3(grid), dim3(NWAVES * 64), kargs, LDS_BYTES, stream);
    if (e != hipSuccess) fprintf(stderr, "kernel_launch: cooperative launch failed: %s (grid %d)\n", hipGetErrorString(e), grid);
}
```

```cpp
#define SUBDUP 0
#define SUBDUP_N 1
#include <hip/hip_runtime.h>
#include <cstdio>
#include <cstdint>
namespace pg8 {
#define PG8_LAS __attribute__((address_space(3)))
typedef unsigned short bf16_t;
typedef short bf16x8 __attribute__((ext_vector_type(8)));
typedef float f32x4 __attribute__((ext_vector_type(4)));
typedef unsigned u32x4 __attribute__((ext_vector_type(4)));
constexpr int BM = 256, BK = 64, HALF = 128, HTB = HALF * BK * 2  , STAGE_BYTES = 8 * HTB, NXCD = 8, WGM = 8;

__host__ __device__ __forceinline__ int lds_byte(int r, int c) { const int st = (r >> 4) * 2 + (c >> 5), rr = r & 15, cc = c & 31, ob = rr * 64 + cc * 2; return st * 1024 + (ob ^ (((ob >> 9) & 1) << 5)); }
__host__ __device__ __forceinline__ void stage_rc(int b, int& R, int& C) { const int st = b / 1024, sb = b % 1024, swz = sb ^ (((sb >> 9) & 1) << 5); R = (st >> 1) * 16 + swz / 64; C = (st & 1) * 32 + (swz % 64) / 2; }
__host__ __device__ __forceinline__ int perm32(int rho) { const int n = rho >> 4, i = rho & 15; return 8 * (i >> 2) + 4 * n + (i & 3); }

struct Unit { int pm, pn, on; };
struct Gemm { const bf16_t* A; const bf16_t* Bt; int M, N, K; };

struct StaticOrder {
    int nM, nN, nwg, G, c;
    __host__ __device__ void init(int M, int N, int G_, int c_) { nM = M / BM; nN = N / BM; nwg = nM * nN; G = G_; c = c_; }
    __host__ __device__ bool next(int i, Unit& u) const {
        const long L = (long)i * G + c; if (L >= nwg) return false;
        int wgid = (int)L; { const int q = nwg / NXCD, r = nwg % NXCD, xcd = wgid % NXCD, off = wgid / NXCD; wgid = (xcd < r ? xcd * (q + 1) : r * (q + 1) + (xcd - r) * q) + off; }
        const int nig = WGM * nN, gid = wgid / nig, fm = gid * WGM, gsz = (nM - fm) < WGM ? (nM - fm) : WGM;
        u.pm = fm + ((wgid % nig) % gsz); u.pn = (wgid % nig) / gsz; u.on = u.pn; return true;
    }
    __device__ __forceinline__ void a_ready(const Unit&) const {}
    __device__ __forceinline__ void done(const Unit&) const {}
};

typedef __bf16 bf16v2_t __attribute__((ext_vector_type(2)));
__device__ __forceinline__ unsigned cvt_pk_bf16(float lo, float hi) { bf16v2_t v; v[0] = (__bf16)lo; v[1] = (__bf16)hi; return __builtin_bit_cast(unsigned, v); }
__device__ __forceinline__ float fast_sigmoid(float x) { return __builtin_amdgcn_rcpf(1.f + __expf(-x)); }
struct EpiStoreBf16 {
    static constexpr bool PERM = true, AFTER_DRAIN = false;
    bf16_t* O; int ldc;
    __device__ __forceinline__ void operator()(const f32x4 (&acc)[2][2][4][2], const Unit& u, int wr, int wc, int fr, int fq) const {
        const int row0 = u.pm * BM + wr * 64 + fr, col0 = u.on * BM + wc * 32 + 8 * fq;
#pragma unroll
        for (int ai = 0; ai < 2; ++ai)
#pragma unroll
            for (int m = 0; m < 4; ++m) { bf16_t* rowp = O + (size_t)(row0 + ai * HALF + m * 16) * ldc + col0;
#pragma unroll
                for (int bj = 0; bj < 2; ++bj) { const f32x4 v0 = acc[ai][bj][m][0], v1 = acc[ai][bj][m][1];
                    u32x4 w; w.x = cvt_pk_bf16(v0[0], v0[1]); w.y = cvt_pk_bf16(v0[2], v0[3]); w.z = cvt_pk_bf16(v1[0], v1[1]); w.w = cvt_pk_bf16(v1[2], v1[3]);
                    *(u32x4*)(rowp + bj * HALF) = w; } }
    }
};
struct EpiResF32 {
    static constexpr bool PERM = false, AFTER_DRAIN = false;
    const float* res; float* out; int ldc; float alpha;
    __device__ __forceinline__ void operator()(const f32x4 (&acc)[2][2][4][2], const Unit& u, int wr, int wc, int fr, int fq) const {
        const int row0 = u.pm * BM + wr * 64 + fr, col0 = u.on * BM + wc * 32 + 4 * fq;
#pragma unroll
        for (int ai = 0; ai < 2; ++ai)
#pragma unroll
            for (int m = 0; m < 4; ++m) { const size_t off = (size_t)(row0 + ai * HALF + m * 16) * ldc + col0;
#pragma unroll
                for (int bj = 0; bj < 2; ++bj)
#pragma unroll
                    for (int n = 0; n < 2; ++n) { const f32x4 r = *(const f32x4*)(res + off + bj * HALF + n * 16); *(f32x4*)(out + off + bj * HALF + n * 16) = r * alpha + acc[ai][bj][m][n]; }
                asm volatile("" ::: "memory"); }
    }
};
template <bool RB>
struct EpiResBf16T {
    static constexpr bool PERM = true, AFTER_DRAIN = false;
    const void* res; bf16_t* out; int ldc; float alpha;
    __device__ __forceinline__ void operator()(const f32x4 (&acc)[2][2][4][2], const Unit& u, int wr, int wc, int fr, int fq) const {
        const int row0 = u.pm * BM + wr * 64 + fr, col0 = u.on * BM + wc * 32 + 8 * fq;
#pragma unroll
        for (int ai = 0; ai < 2; ++ai)
#pragma unroll
            for (int m = 0; m < 4; ++m) { const size_t off = (size_t)(row0 + ai * HALF + m * 16) * ldc + col0;
#pragma unroll
                for (int bj = 0; bj < 2; ++bj) { f32x4 r0, r1;
                    if (RB) { const u32x4 rw = *(const u32x4*)((const bf16_t*)res + off + bj * HALF);
                        r0[0] = __uint_as_float(rw.x << 16); r0[1] = __uint_as_float(rw.x & 0xffff0000u); r0[2] = __uint_as_float(rw.y << 16); r0[3] = __uint_as_float(rw.y & 0xffff0000u);
                        r1[0] = __uint_as_float(rw.z << 16); r1[1] = __uint_as_float(rw.z & 0xffff0000u); r1[2] = __uint_as_float(rw.w << 16); r1[3] = __uint_as_float(rw.w & 0xffff0000u); }
                    else { r0 = *(const f32x4*)((const float*)res + off + bj * HALF); r1 = *(const f32x4*)((const float*)res + off + bj * HALF + 4); }
                    const f32x4 v0 = r0 * alpha + acc[ai][bj][m][0], v1 = r1 * alpha + acc[ai][bj][m][1];
                    u32x4 w; w.x = cvt_pk_bf16(v0[0], v0[1]); w.y = cvt_pk_bf16(v0[2], v0[3]); w.z = cvt_pk_bf16(v1[0], v1[1]); w.w = cvt_pk_bf16(v1[2], v1[3]);
                    *(u32x4*)(out + off + bj * HALF) = w; }
                asm volatile("" ::: "memory"); }
    }
};
struct EpiSwiglu {
    static constexpr bool PERM = true, AFTER_DRAIN = false;
    bf16_t* H; int ldc;
    __device__ __forceinline__ void operator()(const f32x4 (&acc)[2][2][4][2], const Unit& u, int wr, int wc, int fr, int fq) const {
        const int row0 = u.pm * BM + wr * 64 + fr, col0 = u.on * HALF + wc * 32 + 8 * fq;
#pragma unroll
        for (int ai = 0; ai < 2; ++ai)
#pragma unroll
            for (int m = 0; m < 4; ++m) {
                f32x4 h[2];
#pragma unroll
                for (int n = 0; n < 2; ++n) { const f32x4 g = acc[ai][0][m][n], up = acc[ai][1][m][n];
#pragma unroll
                    for (int i = 0; i < 4; ++i) h[n][i] = g[i] * fast_sigmoid(g[i]) * up[i]; }
                u32x4 w; w.x = cvt_pk_bf16(h[0][0], h[0][1]); w.y = cvt_pk_bf16(h[0][2], h[0][3]); w.z = cvt_pk_bf16(h[1][0], h[1][1]); w.w = cvt_pk_bf16(h[1][2], h[1][3]);
                *(u32x4*)(H + (size_t)(row0 + ai * HALF + m * 16) * ldc + col0) = w; }
    }
};
template <bool FINAL>
struct EpiPleT {
    static constexpr bool PERM = true, AFTER_DRAIN = false;
    const bf16_t* x; const bf16_t* pp; void* out; int ldc; float oscale;
    __device__ __forceinline__ void operator()(const f32x4 (&acc)[2][2][4][2], const Unit& u, int wr, int wc, int fr, int fq) const {
        const int row0 = u.pm * BM + wr * 64 + fr, col0 = u.on * BM + wc * 32 + 8 * fq;
#pragma unroll
        for (int ai = 0; ai < 2; ++ai)
#pragma unroll
            for (int m = 0; m < 4; ++m) { const size_t off = (size_t)(row0 + ai * HALF + m * 16) * ldc + col0;
#pragma unroll
                for (int bj = 0; bj < 2; ++bj) { const size_t o = off + bj * HALF;
                    const u32x4 xw = *(const u32x4*)(x + o), pw = *(const u32x4*)(pp + o);
                    f32x4 xn0, xn1;
#pragma unroll
                    for (int q = 0; q < 2; ++q) { const unsigned xa = q ? xw.y : xw.x, pa = q ? pw.y : pw.x, xb2 = q ? xw.w : xw.z, pb2 = q ? pw.w : pw.z;
                        xn0[2 * q] = (__uint_as_float(xa << 16) + fast_sigmoid(acc[ai][bj][m][0][2 * q]) * __uint_as_float(pa << 16)) * oscale;
                        xn0[2 * q + 1] = (__uint_as_float(xa & 0xffff0000u) + fast_sigmoid(acc[ai][bj][m][0][2 * q + 1]) * __uint_as_float(pa & 0xffff0000u)) * oscale;
                        xn1[2 * q] = (__uint_as_float(xb2 << 16) + fast_sigmoid(acc[ai][bj][m][1][2 * q]) * __uint_as_float(pb2 << 16)) * oscale;
                        xn1[2 * q + 1] = (__uint_as_float(xb2 & 0xffff0000u) + fast_sigmoid(acc[ai][bj][m][1][2 * q + 1]) * __uint_as_float(pb2 & 0xffff0000u)) * oscale; }
                    if (FINAL) { *(f32x4*)((float*)out + o) = xn0; *(f32x4*)((float*)out + o + 4) = xn1; }
                    else { u32x4 w; w.x = cvt_pk_bf16(xn0[0], xn0[1]); w.y = cvt_pk_bf16(xn0[2], xn0[3]); w.z = cvt_pk_bf16(xn1[0], xn1[1]); w.w = cvt_pk_bf16(xn1[2], xn1[3]); *(u32x4*)((bf16_t*)out + o) = w; } }
                asm volatile("" ::: "memory"); }
    }
};
struct MoeOrder {
    const int* tile_e; int nrt, ncol, G, c;
    __device__ __forceinline__ bool next(int i, Unit& u) const {
        const int L = i * G + c; if (L >= nrt * ncol) return false;
        const int rt = L / ncol, cn = L - rt * ncol; const int e = tile_e[rt];
        u.pm = rt; u.pn = e * ncol + cn; u.on = cn; return true;
    }
    __device__ __forceinline__ void a_ready(const Unit&) const {}
    __device__ __forceinline__ void done(const Unit&) const {}
};

template <class Epi, class Sched, bool ALIGN_EPI = false, bool SP2 = false>
__device__ __forceinline__ void gemm_phase(PG8_LAS unsigned char* lds, const Gemm g, const Sched& S, const Epi& E) {
    int tid_ = threadIdx.x; asm volatile("" : "+v"(tid_));
    const int tid = tid_, wid = __builtin_amdgcn_readfirstlane(tid >> 6), lane = tid & 63, wr = wid >> 2, wc = wid & 3, fr = lane & 15, fq = lane >> 4;
    const int K = g.K, nt = K / BK;
    unsigned voffA[2], voffB[2];
#pragma unroll
    for (int i = 0; i < 2; ++i) { int R, C; stage_rc(tid * 16 + i * 8192, R, C); const int Rb = Epi::PERM ? ((R & ~31) + perm32(R & 31)) : R;
        voffA[i] = (unsigned)(R * K + C) * 2u; voffB[i] = (unsigned)(Rb * K + C) * 2u; }
    const size_t kstep = (size_t)(BK * 2);
    const size_t hstep = (size_t)HALF * K * 2;
    const size_t tstep = 2 * hstep;
    const unsigned ldsw = (unsigned)wid * 1024u;
    const int aoff = lds_byte(wr * 64 + fr, fq * 8), boff = lds_byte(wc * 32 + fr, fq * 8);
#define PG8_SA(b, h) (((b) * 2 + (h)) * HTB)
#define PG8_SB(b, h) ((4 + (b) * 2 + (h)) * HTB)
#define PG8_STAGE(bufoff, gbase, voff) do { _Pragma("unroll") for (int _i = 0; _i < 2; ++_i) \
        __builtin_amdgcn_global_load_lds((const unsigned*)((const char*)(gbase) + (voff)[_i]), (PG8_LAS unsigned*)(lds + (bufoff) + ldsw + _i * 8192), 16, 0, 0); } while (0)
#define PG8_LDA(dst, b, h) do { _Pragma("unroll") for (int m = 0; m < 4; ++m) _Pragma("unroll") for (int k = 0; k < 2; ++k) dst[m][k] = *(const PG8_LAS bf16x8*)(lds + PG8_SA(b, h) + aoff + m * 2048 + k * 1024); } while (0)
#define PG8_LDB(dst, b, h) do { _Pragma("unroll") for (int n = 0; n < 2; ++n) _Pragma("unroll") for (int k = 0; k < 2; ++k) dst[n][k] = *(const PG8_LAS bf16x8*)(lds + PG8_SB(b, h) + boff + n * 2048 + k * 1024); } while (0)
#define PG8_MMA(ai, bj, At, Bt) do { __builtin_amdgcn_s_setprio(1); _Pragma("unroll") for (int m = 0; m < 4; ++m) _Pragma("unroll") for (int n = 0; n < 2; ++n) _Pragma("unroll") for (int k = 0; k < 2; ++k) \
        acc[ai][bj][m][n] = __builtin_amdgcn_mfma_f32_16x16x32_bf16(Bt[n][k], At[m][k], acc[ai][bj][m][n], 0, 0, 0); __builtin_amdgcn_s_setprio(0); } while (0)
#define PG8_WAIT_V(n) asm volatile("s_waitcnt vmcnt(" #n ")" ::: "memory")
#define PG8_WAIT_L(n) asm volatile("s_waitcnt lgkmcnt(" #n ")" ::: "memory")
#define PG8_BAR __builtin_amdgcn_s_barrier()
#define PG8_SCHED __builtin_amdgcn_sched_barrier(0)
    Unit cur, nxt; int ui = 0;
    if (!S.next(0, cur)) return;
    f32x4 acc[2][2][4][2];
#pragma unroll
    for (int a = 0; a < 2; ++a)
#pragma unroll
        for (int b = 0; b < 2; ++b)
#pragma unroll
            for (int m = 0; m < 4; ++m)
#pragma unroll
                for (int n = 0; n < 2; ++n) acc[a][b][m][n] = (f32x4){0.f, 0.f, 0.f, 0.f};
    bf16x8 At[4][2], B0[2][2], B1[2][2];
    const char* cA = (const char*)g.A + (size_t)cur.pm * tstep; const char* cB = (const char*)g.Bt + (size_t)cur.pn * tstep;
    S.a_ready(cur);
    if constexpr (SP2) {
        PG8_STAGE(PG8_SB(0, 0), cB, voffB); PG8_STAGE(PG8_SB(0, 1), cB + hstep, voffB); PG8_STAGE(PG8_SA(0, 0), cA, voffA); PG8_STAGE(PG8_SA(0, 1), cA + hstep, voffA);
        if (wr == 1) PG8_BAR;
        PG8_WAIT_V(2); PG8_BAR;
        PG8_STAGE(PG8_SB(1, 0), cB + kstep, voffB); PG8_STAGE(PG8_SA(1, 0), cA + kstep, voffA); PG8_STAGE(PG8_SB(1, 1), cB + hstep + kstep, voffB);
        PG8_WAIT_V(6); PG8_BAR;
    } else {
        PG8_STAGE(PG8_SB(0, 0), cB, voffB); PG8_STAGE(PG8_SA(0, 0), cA, voffA); PG8_STAGE(PG8_SB(0, 1), cB + hstep, voffB); PG8_STAGE(PG8_SA(0, 1), cA + hstep, voffA);
        if (wr == 1) PG8_BAR;
        PG8_WAIT_V(4); PG8_BAR;
        PG8_STAGE(PG8_SB(1, 0), cB + kstep, voffB); PG8_STAGE(PG8_SA(1, 0), cA + kstep, voffA); PG8_STAGE(PG8_SB(1, 1), cB + hstep + kstep, voffB);
        PG8_WAIT_V(6); PG8_BAR;
    }
    for (;;) {
        const bool has_next = S.next(ui + 1, nxt);
        const char* nA = has_next ? (const char*)g.A + (size_t)nxt.pm * tstep : cA; const char* nB = has_next ? (const char*)g.Bt + (size_t)nxt.pn * tstep : cB;
        for (int t = 0; t < nt; t += 2) {
            const bool last = (t == nt - 2);
            const char* a1 = cA + (size_t)(t + 1) * kstep;
            const char* a2 = last ? nA : cA + (size_t)(t + 2) * kstep; const char* b2 = last ? nB : cB + (size_t)(t + 2) * kstep;
            const char* a3 = a2 + kstep; const char* b3 = b2 + kstep;
            if (last && has_next) S.a_ready(nxt);
            if constexpr (SP2) {
            PG8_LDB(B0, 0, 0); PG8_LDB(B1, 0, 1); PG8_SCHED; PG8_LDA(At, 0, 0); PG8_STAGE(PG8_SA(1, 1), a1 + hstep, voffA);
            PG8_WAIT_V(8); PG8_WAIT_L(0); PG8_BAR; PG8_MMA(0, 0, At, B0); PG8_MMA(0, 1, At, B1); PG8_BAR; PG8_SCHED;
            PG8_LDA(At, 0, 1); PG8_STAGE(PG8_SB(0, 0), b2, voffB); PG8_STAGE(PG8_SB(0, 1), b2 + hstep, voffB); PG8_STAGE(PG8_SA(0, 0), a2, voffA);
            PG8_WAIT_V(8); PG8_WAIT_L(0); PG8_BAR; PG8_MMA(1, 0, At, B0); PG8_MMA(1, 1, At, B1); PG8_BAR; PG8_SCHED;
            PG8_LDB(B0, 1, 0); PG8_LDB(B1, 1, 1); PG8_SCHED; PG8_LDA(At, 1, 0); PG8_STAGE(PG8_SA(0, 1), a2 + hstep, voffA);
            PG8_WAIT_V(8); PG8_WAIT_L(0); PG8_BAR; PG8_MMA(0, 0, At, B0); PG8_MMA(0, 1, At, B1); PG8_BAR; PG8_SCHED;
            PG8_LDA(At, 1, 1); PG8_STAGE(PG8_SB(1, 0), b3, voffB); PG8_STAGE(PG8_SB(1, 1), b3 + hstep, voffB); PG8_STAGE(PG8_SA(1, 0), a3, voffA);
            PG8_WAIT_V(8); PG8_WAIT_L(0); PG8_BAR; PG8_MMA(1, 0, At, B0); PG8_MMA(1, 1, At, B1); PG8_BAR; PG8_SCHED;
            } else {
            PG8_LDB(B0, 0, 0); PG8_SCHED; PG8_LDA(At, 0, 0); PG8_STAGE(PG8_SA(1, 1), a1 + hstep, voffA);
            PG8_WAIT_L(8); PG8_BAR; PG8_WAIT_L(0); PG8_MMA(0, 0, At, B0); PG8_BAR; PG8_SCHED;
            PG8_LDB(B1, 0, 1); PG8_STAGE(PG8_SB(0, 0), b2, voffB);
            PG8_BAR; PG8_WAIT_L(0); PG8_MMA(0, 1, At, B1); PG8_BAR;
            PG8_LDA(At, 0, 1); PG8_STAGE(PG8_SA(0, 0), a2, voffA);
            PG8_BAR; PG8_WAIT_L(0); PG8_MMA(1, 0, At, B0); PG8_BAR; PG8_SCHED;
            PG8_STAGE(PG8_SB(0, 1), b2 + hstep, voffB);
            PG8_WAIT_V(6); PG8_BAR; PG8_MMA(1, 1, At, B1); PG8_BAR;
            PG8_LDB(B0, 1, 0); PG8_SCHED; PG8_LDA(At, 1, 0); PG8_STAGE(PG8_SA(0, 1), a2 + hstep, voffA);
            PG8_WAIT_L(8); PG8_BAR; PG8_WAIT_L(0); PG8_MMA(0, 0, At, B0); PG8_BAR; PG8_SCHED;
            PG8_LDB(B1, 1, 1); PG8_STAGE(PG8_SB(1, 0), b3, voffB);
            PG8_BAR; PG8_WAIT_L(0); PG8_MMA(0, 1, At, B1); PG8_BAR;
            PG8_LDA(At, 1, 1); PG8_STAGE(PG8_SA(1, 0), a3, voffA);
            PG8_BAR; PG8_WAIT_L(0); PG8_MMA(1, 0, At, B0); PG8_BAR; PG8_SCHED;
            PG8_STAGE(PG8_SB(1, 1), b3 + hstep, voffB);
            PG8_WAIT_V(6); PG8_BAR; PG8_MMA(1, 1, At, B1); PG8_BAR;
            }
        }
        if constexpr (ALIGN_EPI) { if (wr == 0) PG8_BAR; }
        if constexpr (!Epi::AFTER_DRAIN) { E(acc, cur, wr, wc, fr, fq); S.done(cur); }
        if (!has_next) break;
#pragma unroll
        for (int a = 0; a < 2; ++a)
#pragma unroll
            for (int b = 0; b < 2; ++b)
#pragma unroll
                for (int m = 0; m < 4; ++m)
#pragma unroll
                    for (int n = 0; n < 2; ++n) acc[a][b][m][n] = (f32x4){0.f, 0.f, 0.f, 0.f};
        cur = nxt; cA = nA; cB = nB; ++ui;
        if constexpr (ALIGN_EPI) { if (wr == 1) PG8_BAR; }
    }
    PG8_WAIT_V(0);
    if constexpr (!ALIGN_EPI) { if (wr == 0) PG8_BAR; }
    PG8_BAR;
    if constexpr (Epi::AFTER_DRAIN) { E.fused(acc, cur, wr, wc, fr, fq, lds, wid, lane); S.done(cur); }
#undef PG8_SA
#undef PG8_SB
#undef PG8_STAGE
#undef PG8_LDA
#undef PG8_LDB
#undef PG8_MMA
#undef PG8_WAIT_V
#undef PG8_WAIT_L
#undef PG8_BAR
#undef PG8_SCHED
}
}

#ifndef MEGA_ALL
#define MEGA_ALL 0
#endif
#define PG8_SP2 true
#define PG8_ALIGN true
constexpr int NWAVES = 8;
constexpr int T = 16384, D = 1024, GW = 256, PIN = 3152, ZLD = 3328;
constexpr int DFF = 2816, NE = 8, DFE = 3584, DFH = 1792;
constexpr int MOE_MAXTILES = 136, MOE_MAXROWS = MOE_MAXTILES * 256;
constexpr float LN_EPS = 1e-5f, RMS_EPS = 1e-6f, GN_EPS = 64e-5f;
constexpr float ALPHA = 1.4142135623730951f;
constexpr int Z_GQ = 0, Z_GK = 128, Z_GV = 256, Z_GG = 512, Z_GGK = 768, Z_HQ = 784, Z_HF = 1040, Z_HI = 1296, Z_HG = 1552,
              Z_SQ = 1808, Z_SK = 2064, Z_SV = 2192, Z_RZ = 2320, Z_VD = 3152;
constexpr size_t MiB = 1u << 20;
constexpr size_t WS_MOEGU = 0, WS_MOED = 56 * MiB;
constexpr size_t WS_WIN0 = 84 * MiB, WS_WIN1 = WS_WIN0 + (size_t)ZLD * D * 2, WS_WOUT0 = 97 * MiB, WS_WOUT1 = 99 * MiB, WS_FGU = 101 * MiB, WS_FD = 112 * MiB,
                 WS_PG0 = 117 * MiB + 512 * 1024, WS_PG1 = WS_PG0 + 2 * MiB, WS_PP0 = WS_PG1 + 2 * MiB, WS_PP1 = WS_PP0 + 512 * 1024;
constexpr size_t WS_XB0 = 123 * MiB, WS_XB1 = 155 * MiB, WS_VFIRST = 187 * MiB, WS_PB0 = 203 * MiB, WS_PB1 = 211 * MiB, WS_MISC = 219 * MiB, WS_CTL = 222 * MiB, CTL_BYTES = 1 * MiB;
constexpr size_t WS_R = 224 * MiB;
constexpr size_t WS_Z = WS_R, WS_MIX = WS_R + 104 * MiB, WS_PREP = WS_R + 136 * MiB, WS_PRELN = WS_R + 136 * MiB;
constexpr size_t WS_HD = WS_R, WS_HM = WS_R, WS_XG = WS_R + 119 * MiB, WS_Y1 = WS_R + 187 * MiB, WS_PPO = WS_R;
constexpr size_t WS_RWPACK = WS_XB0;
constexpr size_t WS_GLPACK = WS_PREP, WS_HGPACK = WS_PREP + 20 * MiB, WS_RAW = WS_PREP + 68 * MiB, WS_GOUT = WS_PREP + 116 * MiB, WS_VOUT = WS_PREP + 124 * MiB, WS_BC = WS_PREP + 132 * MiB;
constexpr size_t WS_SST = WS_PREP + 133 * MiB, WS_MT = WS_PREP + 145 * MiB;
constexpr size_t MS_HIST = 1280 * 1024;
constexpr size_t MS_DSC = 1536 * 1024;
constexpr size_t MS_PFRAG = 2048 * 1024;
constexpr size_t WS_END = 480 * MiB + 27 * MiB;
static_assert(WS_MT + 2 * MiB <= WS_END && MS_DSC + 131072 <= 3 * MiB, "scan map");
static_assert(WS_XB1 == WS_XB0 + 32 * MiB && WS_VFIRST == WS_XB1 + 32 * MiB && WS_BC + 1 * MiB <= WS_END, "mixer scratch map");
static_assert(WS_WIN1 + (size_t)ZLD * D * 2 <= WS_WOUT0 && WS_PP1 + 512 * 1024 <= WS_XB0, "weights map");
static_assert(WS_HM + (size_t)MOE_MAXROWS * DFH * 2 <= WS_XG && WS_XG + (size_t)MOE_MAXROWS * D * 2 <= WS_Y1 && WS_Y1 + (size_t)MOE_MAXROWS * D * 2 <= WS_END, "moe map");
static_assert(WS_PREP + 120 * MiB <= WS_END && WS_Z + (size_t)T * ZLD * 2 <= WS_MIX, "mixer map");
constexpr size_t MS_TOPE = 65536, MS_TOPG = MS_TOPE + 131072, MS_TOKROW = MS_TOPG + 131072, MS_ROWTOK = MS_TOKROW + 131072, MS_TILEE = MS_ROWTOK + 196608;
constexpr size_t MS_PARAMS = 1 * MiB;
constexpr int P_GKUP = 0, P_GKB = P_GKUP + 2 * 2048, P_GNW = P_GKB + 2 * 128, P_HLB = P_GNW + 2 * 64, P_HNW = P_HLB + 2 * 256, P_SINK = P_HNW + 2 * 64, P_MU = P_SINK + 8,
              P_W0 = P_MU + 2 * 832, P_WUP = P_W0 + 2 * 256, P_A0 = P_WUP + 2 * 4096, P_AUP = P_A0 + 2 * 256, P_GUP = P_AUP + 2 * 4096, P_KK = P_GUP + 2 * 8192, P_KA = P_KK + 2 * 256,
              P_RK = P_KA + 2 * 256, P_LNXW = P_RK + 2 * 256, P_LNXB = P_LNXW + 2 * 256, P_VMU = P_LNXB + 2 * 256, P_V0 = P_VMU + 8, P_VUP = P_V0 + 256, P_LN1G = P_VUP + 2048,
              P_LN1B = P_LN1G + 2048, P_LN2G = P_LN1B + 2048, P_LN2B = P_LN2G + 2048, P_ROUTER = P_LN2B + 2048, P_LBS = P_ROUTER + 8192, P_END = P_LBS + 512;
static_assert(P_END * 4 <= 1 * MiB, "params block");
constexpr int CW_BAR = 4096, CW_MOE = 16384;
constexpr int LDS_BYTES = 147456, RING_BYTES = 131072, MISC_OFF = RING_BYTES + 320;

#define GAS __attribute__((address_space(1)))
#define LAS __attribute__((address_space(3)))
typedef unsigned short bf16;
typedef unsigned v4u __attribute__((ext_vector_type(4)));
typedef unsigned v2u __attribute__((ext_vector_type(2)));
typedef float f32x4 __attribute__((ext_vector_type(4)));
typedef short bf16x8 __attribute__((ext_vector_type(8)));
typedef GAS unsigned gu32;
#define RLX_AGENT __ATOMIC_RELAXED, __HIP_MEMORY_SCOPE_AGENT
#define LDS_WAIT() asm volatile("s_waitcnt lgkmcnt(0)" ::: "memory")
#define VM_WAIT() asm volatile("s_waitcnt vmcnt(0)" ::: "memory")
__device__ __forceinline__ unsigned f2bf(float f) { unsigned u = __builtin_bit_cast(unsigned, f); return (u + 0x7fffu + ((u >> 16) & 1u)) >> 16; }
__device__ __forceinline__ unsigned pk2(float lo, float hi) { return f2bf(lo) | (f2bf(hi) << 16); }
__device__ __forceinline__ float bf2f(unsigned short b) { return __uint_as_float(((unsigned)b) << 16); }
__device__ __forceinline__ float rcpf_(float x) { return __builtin_amdgcn_rcpf(x); }
__device__ __forceinline__ float sigmoidf_(float x) { return rcpf_(1.f + __expf(-x)); }
__device__ __forceinline__ float siluf_(float x) { return x * rcpf_(1.f + __expf(-x)); }
__device__ __forceinline__ float softplusf_(float x) { return fmaxf(x, 0.f) + __logf(1.f + __expf(-fabsf(x))); }
__device__ __forceinline__ float logsigmoidf_(float x) { return -softplusf_(-x); }
__device__ __forceinline__ float tanhf_(float x) { return 1.f - 2.f * rcpf_(1.f + __expf(2.f * x)); }
template <int CTRL> __device__ __forceinline__ float dppf(float v) { return __builtin_bit_cast(float, __builtin_amdgcn_update_dpp(0, __builtin_bit_cast(int, v), CTRL, 0xf, 0xf, false)); }
__device__ __forceinline__ float wave_sum(float v) {
    v += dppf<0x128>(v); v += dppf<0x124>(v); v += dppf<0x122>(v); v += dppf<0x121>(v);
    { float a = v, b = v; asm("s_nop 1\n\tv_permlane16_swap_b32 %0, %1" : "+v"(a), "+v"(b)); v = a + b; }
    { float a = v, b = v; asm("s_nop 1\n\tv_permlane32_swap_b32 %0, %1" : "+v"(a), "+v"(b)); v = a + b; }
    return v;
}
__device__ __forceinline__ float wave_max(float v) {
    v = fmaxf(v, dppf<0x128>(v)); v = fmaxf(v, dppf<0x124>(v)); v = fmaxf(v, dppf<0x122>(v)); v = fmaxf(v, dppf<0x121>(v));
    { float a = v, b = v; asm("s_nop 1\n\tv_permlane16_swap_b32 %0, %1" : "+v"(a), "+v"(b)); v = fmaxf(a, b); }
    { float a = v, b = v; asm("s_nop 1\n\tv_permlane32_swap_b32 %0, %1" : "+v"(a), "+v"(b)); v = fmaxf(a, b); }
    return v;
}
#define XB_TMO      128
#define XB_XCNT(j)  (256  + 64 * (j))
#define XB_XSUB(j)  (1280 + 64 * (j))
#define XB_XGEN(j)  (2304 + 64 * (j))
#define XB_TOP      3328
#define XB_TOPGEN   3392
#define XCD_BAR_WORDS 3456
#define XB_SPIN_CAP (1u << 27)

__device__ __forceinline__ unsigned xb_ld(unsigned* p)              { return __hip_atomic_load(p, __ATOMIC_RELAXED, __HIP_MEMORY_SCOPE_AGENT); }
__device__ __forceinline__ unsigned xb_add(unsigned* p, unsigned v) { return __hip_atomic_fetch_add(p, v, __ATOMIC_RELAXED, __HIP_MEMORY_SCOPE_AGENT); }
__device__ __forceinline__ unsigned xb_xcc_id() { return (unsigned)__builtin_amdgcn_s_getreg((3 << 11) | 20) & 0xFu; }
#define XB_SPIN(cond, bar) do { unsigned _sp = 0; while (cond) { __builtin_amdgcn_s_sleep(1); \
    if ((++_sp & 255u) == 0u) { if (xb_ld(&(bar)[XB_TMO])) break; if (_sp > XB_SPIN_CAP) { atomicAdd(&(bar)[XB_TMO], 1u); break; } } } } while (0)

struct XcdBarrier {
    unsigned* bar; unsigned x;
    volatile LAS unsigned* st;
};

__device__ __forceinline__ XcdBarrier xcd_barrier_post(unsigned* bar, volatile LAS unsigned* st) {
    XcdBarrier b; b.bar = bar; b.x = xb_xcc_id(); b.st = st;
    if (threadIdx.x == 0) (void)xb_add(&bar[XB_XCNT(b.x)], 1u);
    return b;
}
__device__ __forceinline__ void xcd_barrier_complete(unsigned* bar, unsigned x, unsigned& nloc, unsigned& nx) {
    const unsigned G = gridDim.x * gridDim.y * gridDim.z;
    unsigned sum, cnt, mine, sp = 0u;
    for (;;) {
        sum = 0u; cnt = 0u; mine = 0u;
#pragma unroll
        for (unsigned j = 0; j < 16; ++j) { const unsigned c = xb_ld(&bar[XB_XCNT(j)]); sum += c; cnt += (c > 0u) ? 1u : 0u; }
        if (sum == G) break;
        __builtin_amdgcn_s_sleep(1);
        if ((++sp & 255u) == 0u) { if (xb_ld(&bar[XB_TMO])) break; if (sp > XB_SPIN_CAP) { atomicAdd(&bar[XB_TMO], 1u); break; } }
    }
    mine = xb_ld(&bar[XB_XCNT(x)]);
    nloc = mine > 0u ? mine : 1u; nx = cnt > 0u ? cnt : 1u;
}

__device__ __forceinline__ void xcd_barrier(const XcdBarrier& b) {
    asm volatile("s_waitcnt vmcnt(0)" ::: "memory");
    __syncthreads();
    if (threadIdx.x == 0) {
        unsigned* bar = b.bar;
        __builtin_amdgcn_s_waitcnt(0);
        unsigned nloc = b.st[0], nx = b.st[1];
        if (nloc == 0u) { xcd_barrier_complete(bar, b.x, nloc, nx); b.st[0] = nloc; b.st[1] = nx; }
        const unsigned old = xb_add(&bar[XB_XSUB(b.x)], 1u);
        const unsigned gen = old / nloc;
        if (old + 1u == (gen + 1u) * nloc) {
            __builtin_amdgcn_fence(__ATOMIC_RELEASE, "agent");
            asm volatile("s_waitcnt vmcnt(0)" ::: "memory");
            const unsigned og = xb_add(&bar[XB_TOP], 1u);
            const unsigned tg = og / nx;
            if (og + 1u == (tg + 1u) * nx) xb_add(&bar[XB_TOPGEN], 1u);
            else XB_SPIN(xb_ld(&bar[XB_TOPGEN]) == tg, bar);
            __builtin_amdgcn_fence(__ATOMIC_ACQUIRE, "agent");
            xb_add(&bar[XB_XGEN(b.x)], 1u);
            asm volatile("s_waitcnt vmcnt(0)" ::: "memory");
        } else {
            XB_SPIN(xb_ld(&bar[XB_XGEN(b.x)]) == gen, bar);
            __builtin_amdgcn_fence(__ATOMIC_ACQUIRE, "agent");
            asm volatile("s_waitcnt vmcnt(0)" ::: "memory");
        }
    }
    __syncthreads();
}

#ifndef SUBDUP
#define SUBDUP 0
#define SUBDUP_N 1
#endif
#define SUBREP(id) _Pragma("unroll 1") for (int srep_ = 0; srep_ < ((SUBDUP == (id)) ? SUBDUP_N : 1); ++srep_)
constexpr int RW_PACK = 14336;
constexpr int RW_AHAT = 0, RW_W2 = 2048, RW_S2A = 4096, RW_V = 8192, RW_R = 10240, RW_ARK = 12288, RW_P = 13312;
constexpr int RWL_BYTES = 21504;
typedef __bf16 bf16v2_t __attribute__((ext_vector_type(2)));
__device__ __forceinline__ unsigned cvt_pk(float lo, float hi) { bf16v2_t v; v[0] = (__bf16)lo; v[1] = (__bf16)hi; return __builtin_bit_cast(unsigned, v); }
__device__ __forceinline__ bf16x8 pack8(const f32x4& a, const f32x4& b) { v4u p; p.x = cvt_pk(a[0], a[1]); p.y = cvt_pk(a[2], a[3]); p.z = cvt_pk(b[0], b[1]); p.w = cvt_pk(b[2], b[3]); return __builtin_bit_cast(bf16x8, p); }
__device__ __forceinline__ bf16x8 pack8u(const f32x4& a, v2u vb) { v4u p; p.x = cvt_pk(a[0], a[1]); p.y = cvt_pk(a[2], a[3]); p.z = vb.x; p.w = vb.y; return __builtin_bit_cast(bf16x8, p); }
__device__ __forceinline__ bf16x8 frag2(v2u a, v2u b) { v4u p; p.x = a.x; p.y = a.y; p.z = b.x; p.w = b.y; return __builtin_bit_cast(bf16x8, p); }
#define MFMA16(a, b, c) __builtin_amdgcn_mfma_f32_16x16x32_bf16((a), (b), (c), 0, 0, 0)

struct RwkvPrepArgs { const bf16* z; const float* P; bf16* vfirst; unsigned char* pack; bf16* gout; bf16* vout; float* bcout; const unsigned char* pfrag; };
constexpr int PFRAG_BYTES = 16384;
__device__ __forceinline__ void rwkv_build_pfrag(unsigned char* dst, const float* wup, const float* aup, const float* gup, const float* vup  , int hd, int lane) {
    const int lo = lane & 15, h = lane >> 4;
#pragma unroll
    for (int n = 0; n < 4; ++n) { const int col = hd * 64 + 16 * n + lo; v4u fw, fa, fg, fv;
#pragma unroll
        for (int j2 = 0; j2 < 4; ++j2) { const int j = 2 * j2;
            fw[j2] = (h < 2) ? pk2(wup[(8 * h + j) * 256 + col], wup[(8 * h + j + 1) * 256 + col]) : 0u;
            fa[j2] = (h >= 2) ? pk2(aup[(8 * (h - 2) + j) * 256 + col], aup[(8 * (h - 2) + j + 1) * 256 + col]) : 0u;
            fg[j2] = pk2(gup[(8 * h + j) * 256 + col], gup[(8 * h + j + 1) * 256 + col]);
            fv[j2] = (vup && h == 0) ? pk2(vup[j * 256 + col], vup[(j + 1) * 256 + col]) : 0u; }
        *(v4u*)(dst + (0 + n) * 1024 + lane * 16) = fw; *(v4u*)(dst + (4 + n) * 1024 + lane * 16) = fa; *(v4u*)(dst + (8 + n) * 1024 + lane * 16) = fg; *(v4u*)(dst + (12 + n) * 1024 + lane * 16) = fv; }
}
__device__ __forceinline__ float bflo(unsigned w) { return __uint_as_float(w << 16); }
__device__ __forceinline__ float bfhi(unsigned w) { return __uint_as_float(w & 0xffff0000u); }
__device__ __forceinline__ float row_sum(float v) { v += dppf<0x128>(v); v += dppf<0x124>(v); v += dppf<0x122>(v); v += dppf<0x121>(v); return v; }
template <int L>
__device__ __forceinline__ void rwkv_prep_wave(const RwkvPrepArgs& A, int hd, int c0, int cstride, int cend, LAS unsigned char* wl, int lane) {
    const int lo = lane & 15, h = lane >> 4;
    const float* P = A.P;
    LAS bf16* atX = (LAS bf16*)(wl + 0); LAS bf16* rtX = (LAS bf16*)(wl + 2048); LAS bf16* btX = (LAS bf16*)(wl + 4096); LAS bf16* ktX = (LAS bf16*)(wl + 6144);
    LAS bf16* atT = (LAS bf16*)(wl + 8192); LAS bf16* pbT = (LAS bf16*)(wl + 10240); LAS bf16* pkT = (LAS bf16*)(wl + 12288); LAS bf16* vT = (LAS bf16*)(wl + 14336);
    LAS float* Lm = (LAS float*)(wl + 16384); asm volatile("" : "+v"(Lm));
    LAS bf16* Tb = (LAS bf16*)(wl + 17472); LAS bf16* Gak = (LAS bf16*)(wl + 17984); LAS bf16* Grb = (LAS bf16*)(wl + 18496); LAS bf16* Grk = (LAS bf16*)(wl + 19008);
    const f32x4 z4 = (f32x4){0.f, 0.f, 0.f, 0.f}; const bf16x8 z8 = (bf16x8){0, 0, 0, 0, 0, 0, 0, 0};
    const __amdgpu_buffer_rsrc_t zsrd = __builtin_amdgcn_make_buffer_rsrc((void*)A.z, 0, T * ZLD * 2, 0x00020000);
    const unsigned char* pf = A.pfrag + (size_t)(L * 4 + hd) * PFRAG_BYTES;
    for (int c = c0; c < cend; c += cstride) {
        const int t0 = c * 16;
        int ln = lane; asm volatile("" : "+v"(ln));
        const int lo_i = ln & 15, h_i = ln >> 4;
        bf16x8 Awa, Ag, Av = z8;
        {
            const unsigned zb0 = (unsigned)((t0 + lo_i) * ZLD + Z_RZ + 768 + 8 * h_i) * 2u;
            const v4u cw = __builtin_bit_cast(v4u, __builtin_amdgcn_raw_buffer_load_b128(zsrd, zb0, 0, 0)), pw = __builtin_bit_cast(v4u, __builtin_amdgcn_raw_buffer_load_b128(zsrd, zb0 - ZLD * 2, 0, 0));
            const v4u cg = __builtin_bit_cast(v4u, __builtin_amdgcn_raw_buffer_load_b128(zsrd, zb0 + 64, 0, 0)), pg = __builtin_bit_cast(v4u, __builtin_amdgcn_raw_buffer_load_b128(zsrd, zb0 + 64 - ZLD * 2, 0, 0));
            const f32x4 m0 = *(const GAS f32x4*)(P + P_MU + L * 832 + 768 + 8 * h_i), m1 = *(const GAS f32x4*)(P + P_MU + L * 832 + 768 + 8 * h_i + 4);
            const f32x4 g0 = *(const GAS f32x4*)(P + P_MU + L * 832 + 800 + 8 * h_i), g1 = *(const GAS f32x4*)(P + P_MU + L * 832 + 800 + 8 * h_i + 4);
            v4u ow, og;
#pragma unroll
            for (int q = 0; q < 4; ++q) {
                const float mlo = (q < 2) ? m0[2 * q] : m1[2 * q - 4], mhi = (q < 2) ? m0[2 * q + 1] : m1[2 * q - 3];
                float x0 = bflo(cw[q]) + (bflo(pw[q]) - bflo(cw[q])) * mlo, x1 = bfhi(cw[q]) + (bfhi(pw[q]) - bfhi(cw[q])) * mhi;
                if (h_i < 2) { x0 = tanhf_(x0); x1 = tanhf_(x1); }
                ow[q] = cvt_pk(x0, x1);
                const float glo = (q < 2) ? g0[2 * q] : g1[2 * q - 4], ghi = (q < 2) ? g0[2 * q + 1] : g1[2 * q - 3];
                const float y0 = bflo(cg[q]) + (bflo(pg[q]) - bflo(cg[q])) * glo, y1 = bfhi(cg[q]) + (bfhi(pg[q]) - bfhi(cg[q])) * ghi;
                og[q] = cvt_pk(sigmoidf_(y0), sigmoidf_(y1));
            }
            Awa = __builtin_bit_cast(bf16x8, ow); Ag = __builtin_bit_cast(bf16x8, og);
            if (L > 0) {
                const unsigned vb0 = (h_i == 0) ? (unsigned)((t0 + lo_i) * ZLD + Z_VD) * 2u : 0xfffffff0u;
                const v4u cv = __builtin_bit_cast(v4u, __builtin_amdgcn_raw_buffer_load_b128(zsrd, vb0, 0, 0)), pv = __builtin_bit_cast(v4u, __builtin_amdgcn_raw_buffer_load_b128(zsrd, vb0 - ZLD * 2, 0, 0));
                const f32x4 v0m = *(const GAS f32x4*)(P + P_VMU), v1m = *(const GAS f32x4*)(P + P_VMU + 4); v4u ov;
#pragma unroll
                for (int q = 0; q < 4; ++q) { const float mlo = (q < 2) ? v0m[2 * q] : v1m[2 * q - 4], mhi = (q < 2) ? v0m[2 * q + 1] : v1m[2 * q - 3];
                    ov[q] = cvt_pk(bflo(cv[q]) + (bflo(pv[q]) - bflo(cv[q])) * mlo, bfhi(cv[q]) + (bfhi(pv[q]) - bfhi(cv[q])) * mhi); }
                Av = __builtin_bit_cast(bf16x8, ov);
            }
        }
        f32x4 rr[4], kk[4], k2[4], vv[4], av[4], lw[4]; f32x4 ss = z4, bcs = z4;
        unsigned char* pk_ = A.pack + ((size_t)c * 4 + hd) * RW_PACK;
#pragma unroll
        for (int n = 0; n < 4; ++n) {
            const int col = hd * 64 + 16 * n + lo_i;
            const f32x4 sw = MFMA16(Awa, *(const GAS bf16x8*)(pf + (0 + n) * 1024 + ln * 16), z4), sa = MFMA16(Awa, *(const GAS bf16x8*)(pf + (4 + n) * 1024 + ln * 16), z4);
            const f32x4 sg = MFMA16(Ag, *(const GAS bf16x8*)(pf + (8 + n) * 1024 + ln * 16), z4);
            f32x4 sv = z4; if (L > 0) sv = MFMA16(Av, *(const GAS bf16x8*)(pf + (12 + n) * 1024 + ln * 16), z4);
            float zr[5], zk[5], zv[5];
            const unsigned zo = (unsigned)((t0 + 4 * h_i - 1) * ZLD + Z_RZ + col) * 2u;
#pragma unroll
            for (int q = 0; q < 5; ++q) { zr[q] = bf2f((bf16)__builtin_amdgcn_raw_buffer_load_b16(zsrd, zo + q * (ZLD * 2), 0, 0)); zk[q] = bf2f((bf16)__builtin_amdgcn_raw_buffer_load_b16(zsrd, zo + q * (ZLD * 2) + 512, 0, 0));
                zv[q] = bf2f((bf16)__builtin_amdgcn_raw_buffer_load_b16(zsrd, zo + q * (ZLD * 2) + 1024, 0, 0)); }
            const float mur = P[P_MU + L * 832 + col], muk = P[P_MU + L * 832 + 256 + col], muv = P[P_MU + L * 832 + 512 + col];
            const float w0 = P[P_W0 + L * 256 + col], a0 = P[P_A0 + L * 256 + col], kkp = P[P_KK + L * 256 + col], kap = P[P_KA + L * 256 + col], rkp = P[P_RK + L * 256 + col];
            const float v0p = (L > 0) ? P[P_V0 + col] : 0.f;
#pragma unroll
            for (int r2 = 0; r2 < 4; ++r2) {
                const float r_ = zr[r2 + 1] + (zr[r2] - zr[r2 + 1]) * mur, k_ = zk[r2 + 1] + (zk[r2] - zk[r2 + 1]) * muk; float v_ = zv[r2 + 1] + (zv[r2] - zv[r2 + 1]) * muv;
                const float wlog = -softplusf_(-(sw[r2] + w0)) - 0.5f; lw[n][r2] = -__expf(wlog);
                const float a_ = sigmoidf_(sa[r2] + a0); av[n][r2] = a_;
                if (L > 0) { const float vf = bf2f(A.vfirst[(size_t)(t0 + 4 * h_i + r2) * 256 + col]); v_ = v_ + (vf - v_) * sigmoidf_(sv[r2] + v0p); }
                const float kq = k_ * kkp; kk[n][r2] = kq; ss[r2] += kq * kq;
                const float k2_ = k_ * (1.f + (a_ - 1.f) * kap); k2[n][r2] = k2_; bcs[r2] += r_ * k2_ * rkp;
                rr[n][r2] = r_; vv[n][r2] = v_;
                const size_t go = (size_t)(t0 + 4 * h_i + r2) * 256 + col;
                A.gout[go] = (bf16)f2bf(sg[r2]); A.vout[go] = (bf16)f2bf(v_); if (L == 0) A.vfirst[go] = (bf16)f2bf(v_);
            }
        }
#pragma unroll
        for (int r2 = 0; r2 < 4; ++r2) { ss[r2] = rsqrtf(fmaxf(row_sum(ss[r2]), 1e-24f)); bcs[r2] = row_sum(bcs[r2]); }
        if (lo_i == 0) {
#pragma unroll
            for (int r2 = 0; r2 < 4; ++r2) A.bcout[(size_t)(t0 + 4 * h_i + r2) * 4 + hd] = bcs[r2];
        }
#pragma unroll
        for (int n = 0; n < 4; ++n) {
            f32x4 cu; cu[0] = lw[n][0]; cu[1] = cu[0] + lw[n][1]; cu[2] = cu[1] + lw[n][2]; cu[3] = cu[2] + lw[n][3];
            const float tot = cu[3];
            const float t1 = __shfl_up(tot, 16), t2 = __shfl_up(tot, 32), t3 = __shfl_up(tot, 48);
            const float off = (h_i >= 1 ? t1 : 0.f) + (h_i >= 2 ? t2 : 0.f) + (h_i >= 3 ? t3 : 0.f);
            const float cumC = __shfl(off + tot, 48 + lo_i);
            const float PC = __expf(cumC);
            if (h_i == 0) *(float*)(pk_ + RW_P + (16 * n + lo_i) * 4) = PC;
            f32x4 at, bt, kt, rt;
#pragma unroll
            for (int r2 = 0; r2 < 4; ++r2) { const float cm = off + cu[r2]; const float kn = kk[n][r2] * ss[r2];
                at[r2] = -kn * __expf(cm - lw[n][r2]); const float ei = __expf(-cm); bt[r2] = kn * av[n][r2] * ei; kt[r2] = k2[n][r2] * ei; rt[r2] = rr[n][r2] * __expf(cm); }
            const int ch = 16 * n + lo_i;
#pragma unroll
            for (int r2 = 0; r2 < 4; ++r2) { const int t = 4 * h_i + r2; atX[t * 64 + ch] = (bf16)f2bf(at[r2]); rtX[t * 64 + ch] = (bf16)f2bf(rt[r2]); btX[t * 64 + ch] = (bf16)f2bf(bt[r2]); ktX[t * 64 + ch] = (bf16)f2bf(kt[r2]); }
            { v2u w_; w_.x = cvt_pk(at[0], at[1]); w_.y = cvt_pk(at[2], at[3]); *(LAS v2u*)(atT + ch * 16 + 4 * h_i) = w_; }
            { v2u w_; w_.x = cvt_pk(bt[0] * PC, bt[1] * PC); w_.y = cvt_pk(bt[2] * PC, bt[3] * PC); *(LAS v2u*)(pbT + ch * 16 + 4 * h_i) = w_; }
            { v2u w_; w_.x = cvt_pk(kt[0] * PC, kt[1] * PC); w_.y = cvt_pk(kt[2] * PC, kt[3] * PC); *(LAS v2u*)(pkT + ch * 16 + 4 * h_i) = w_; }
            { v2u w_; w_.x = cvt_pk(vv[n][0], vv[n][1]); w_.y = cvt_pk(vv[n][2], vv[n][3]); *(LAS v2u*)(vT + ch * 16 + 4 * h_i) = w_; }
        }
        LDS_WAIT(); asm volatile("" ::: "memory");
        {
        f32x4 Gab, Gak_, Grb_, Grk_;
        {
            bf16x8 af[2], rf[2], bq[2], kq[2];
#pragma unroll
            for (int s = 0; s < 2; ++s) { af[s] = *(const LAS bf16x8*)(atX + lo * 64 + 32 * s + 8 * h); rf[s] = *(const LAS bf16x8*)(rtX + lo * 64 + 32 * s + 8 * h);
                bq[s] = *(const LAS bf16x8*)(btX + lo * 64 + 32 * s + 8 * h); kq[s] = *(const LAS bf16x8*)(ktX + lo * 64 + 32 * s + 8 * h); }
            Gab = MFMA16(af[0], bq[0], z4); Gab = MFMA16(af[1], bq[1], Gab);
            Gak_ = MFMA16(af[0], kq[0], z4); Gak_ = MFMA16(af[1], kq[1], Gak_);
            Grb_ = MFMA16(rf[0], bq[0], z4); Grb_ = MFMA16(rf[1], bq[1], Grb_);
            Grk_ = MFMA16(rf[0], kq[0], z4); Grk_ = MFMA16(rf[1], kq[1], Grk_);
        }
#pragma unroll
        for (int r = 0; r < 4; ++r) { const int t = 4 * h + r; const bool sl = lo < t, sle = lo <= t;
            Lm[t * 17 + lo] = sl ? Gab[r] : 0.f; Gak[t * 16 + lo] = (bf16)f2bf(sl ? Gak_[r] : 0.f); Grb[t * 16 + lo] = (bf16)f2bf(sle ? Grb_[r] : 0.f); Grk[t * 16 + lo] = (bf16)f2bf(sle ? Grk_[r] : 0.f); }
        LDS_WAIT(); asm volatile("" ::: "memory");
        {
            float Tc[16];
            const int lo_i = ln & 15;
#pragma unroll
            for (int t = 0; t < 16; ++t) { float acc = (t == lo_i) ? 1.f : 0.f;
#pragma unroll
                for (int s = 0; s < t; ++s) acc += Lm[t * 17 + s] * Tc[s];
                Tc[t] = acc; }
#pragma unroll
            for (int t = 0; t < 16; ++t) Tb[t * 16 + lo] = (bf16)f2bf(Tc[t]);
        }
        LDS_WAIT(); asm volatile("" ::: "memory");
        {
            const bf16x8 Tfr = (h < 2) ? *(const LAS bf16x8*)(Tb + lo * 16 + 8 * h) : z8;
            f32x4 Cm[4];
#pragma unroll
            for (int m = 0; m < 4; ++m) { const bf16x8 Afr = (h < 2) ? *(const LAS bf16x8*)(atT + (16 * m + lo) * 16 + 8 * h) : z8;
                Cm[m] = MFMA16(Afr, Tfr, z4); }
            *(bf16x8*)(pk_ + RW_AHAT + 0 * 1024 + lane * 16) = pack8(Cm[0], Cm[1]);
            *(bf16x8*)(pk_ + RW_AHAT + 1 * 1024 + lane * 16) = pack8(Cm[2], Cm[3]);
        }
        {
            const bf16x8 Gfr = (h < 2) ? *(const LAS bf16x8*)(Gak + lo * 16 + 8 * h) : z8;
            const v2u t4 = *(const LAS v2u*)(Tb + lo * 16 + 4 * h); const bf16x8 T2 = frag2(t4, (v2u){0u, 0u});
#pragma unroll
            for (int vb = 0; vb < 4; ++vb) {
                const bf16x8 Vn = (h < 2) ? *(const LAS bf16x8*)(vT + (16 * vb + lo) * 16 + 8 * h) : z8;
                const f32x4 X = MFMA16(Gfr, Vn, z4);
                const f32x4 W2 = MFMA16(T2, pack8(X, z4), z4);
                { v2u w2p; w2p.x = cvt_pk(W2[0], W2[1]); w2p.y = cvt_pk(W2[2], W2[3]); *(v2u*)(pk_ + RW_W2 + vb * 512 + lane * 8) = w2p; }
                *(v2u*)(pk_ + RW_V + vb * 512 + lane * 8) = *(const LAS v2u*)(vT + (16 * vb + lo) * 16 + 4 * h);
            }
        }
#pragma unroll
        for (int m = 0; m < 4; ++m) *(bf16x8*)(pk_ + RW_S2A + m * 1024 + lane * 16) = frag2(*(const LAS v2u*)(pbT + (16 * m + lo) * 16 + 4 * h), *(const LAS v2u*)(pkT + (16 * m + lo) * 16 + 4 * h));
#pragma unroll
        for (int s = 0; s < 2; ++s) *(bf16x8*)(pk_ + RW_R + s * 1024 + lane * 16) = frag2(*(const LAS v2u*)(rtX + lo * 64 + 32 * s + 4 * h), *(const LAS v2u*)(rtX + lo * 64 + 32 * s + 16 + 4 * h));
        *(bf16x8*)(pk_ + RW_ARK + lane * 16) = frag2(*(const LAS v2u*)(Grb + lo * 16 + 4 * h), *(const LAS v2u*)(Grk + lo * 16 + 4 * h));
        }
        LDS_WAIT(); asm volatile("" ::: "memory");
    }
}

struct PostCtx { LAS float* xbuf; volatile LAS unsigned* cnt; unsigned step; const bf16* z; const float* P; const bf16* g; const bf16* v; const float* bc; bf16* mix; int layer; };
__device__ __forceinline__ void group_sync(PostCtx& pc) {
    LDS_WAIT(); asm volatile("" ::: "memory");
    if ((threadIdx.x & 63) == 0) __hip_atomic_fetch_add((LAS unsigned*)pc.cnt, 1u, __ATOMIC_RELAXED, __HIP_MEMORY_SCOPE_WORKGROUP);
    pc.step += 1; const unsigned want = 4u * pc.step;
    while (*pc.cnt < want) __builtin_amdgcn_s_sleep(0);
    asm volatile("" ::: "memory");
}
struct RwkvSeqArgs { const unsigned char* pack; };
struct RwkvOps { bf16x8 Ah0, Ah1, S2A[4], R0, R1, ARK; f32x4 W2, Pm[4]; v2u Vf; };
template <int MODE>
__device__ __forceinline__ void rwkv_load_ops(RwkvOps& o, const unsigned char* pk_, int vb, int lane) {
    const int h = lane >> 4;
    o.Ah0 = *(const bf16x8*)(pk_ + RW_AHAT + lane * 16); o.Ah1 = *(const bf16x8*)(pk_ + RW_AHAT + 1024 + lane * 16);
#pragma unroll
    for (int m = 0; m < 4; ++m) { o.S2A[m] = *(const bf16x8*)(pk_ + RW_S2A + m * 1024 + lane * 16); o.Pm[m] = *(const f32x4*)(pk_ + RW_P + (16 * m + 4 * h) * 4); }
    if (MODE != 1) { const v2u w2p = *(const v2u*)(pk_ + RW_W2 + vb * 512 + lane * 8); o.W2[0] = __uint_as_float(w2p.x << 16); o.W2[1] = __uint_as_float(w2p.x & 0xffff0000u); o.W2[2] = __uint_as_float(w2p.y << 16); o.W2[3] = __uint_as_float(w2p.y & 0xffff0000u);
        o.Vf = *(const v2u*)(pk_ + RW_V + vb * 512 + lane * 8); }
    if (MODE == 2) { o.R0 = *(const bf16x8*)(pk_ + RW_R + lane * 16); o.R1 = *(const bf16x8*)(pk_ + RW_R + 1024 + lane * 16); o.ARK = *(const bf16x8*)(pk_ + RW_ARK + lane * 16); }
}
template <int MODE>
__device__ __forceinline__ void rwkv_seq_wave(const RwkvSeqArgs& A, int hd, int vb, int cb, int ce, f32x4 (&St)[4], int lane, PostCtx* pc) {
    const int lo = lane & 15, h = lane >> 4; const f32x4 zz = (f32x4){0.f, 0.f, 0.f, 0.f};
    RwkvOps cur, nxt;
    rwkv_load_ops<MODE>(cur, A.pack + ((size_t)cb * 4 + hd) * RW_PACK, vb, lane);
    for (int c = cb; c < ce; ++c) {
        const int cn = (c + 1 < ce) ? c + 1 : c;
        rwkv_load_ops<MODE>(nxt, A.pack + ((size_t)cn * 4 + hd) * RW_PACK, vb, lane);
        float pg[4], pv[4], pb[4];
        if (MODE == 2) {
#pragma unroll
            for (int i = 0; i < 4; ++i) { const size_t t = (size_t)c * 16 + 4 * vb + i; pg[i] = bf2f(pc->g[t * 256 + hd * 64 + lane]); pv[i] = bf2f(pc->v[t * 256 + hd * 64 + lane]); pb[i] = pc->bc[t * 4 + hd]; }
        }
        const bf16x8 B0 = pack8(St[0], St[1]), B1 = pack8(St[2], St[3]);
        f32x4 U = MFMA16(cur.Ah0, B0, (MODE == 1) ? zz : cur.W2); U = MFMA16(cur.Ah1, B1, U);
        const bf16x8 BU = (MODE == 1) ? pack8(U, zz) : pack8u(U, cur.Vf);
        if (MODE == 2) {
            f32x4 y = MFMA16(cur.R0, B0, zz); y = MFMA16(cur.R1, B1, y); y = MFMA16(cur.ARK, BU, y);
            LAS float* xb = pc->xbuf + (pc->step & 1u) * 1024;
#pragma unroll
            for (int r = 0; r < 4; ++r) xb[(4 * h + r) * 64 + vb * 16 + lo] = y[r];
        }
#pragma unroll
        for (int m = 0; m < 4; ++m) St[m] = MFMA16(cur.S2A[m], BU, St[m] * cur.Pm[m]);
        if (MODE == 2) {
            const LAS float* xb = pc->xbuf + (pc->step & 1u) * 1024;
            group_sync(*pc);
            const int col = hd * 64 + lane; const float lw = pc->P[P_LNXW + pc->layer * 256 + col], lb = pc->P[P_LNXB + pc->layer * 256 + col];
#pragma unroll
            for (int i = 0; i < 4; ++i) { const int tt = 4 * vb + i; const float o = xb[tt * 64 + lane];
                const float mu = wave_sum(o) * (1.f / 64.f); const float d = o - mu; const float var = wave_sum(d * d) * (1.f / 64.f);
                const float yn = d * rsqrtf(var + GN_EPS) * lw + lb;
                pc->mix[((size_t)c * 16 + tt) * D + 768 + col] = (bf16)f2bf((yn + pb[i] * pv[i]) * pg[i]); }
        }
        cur = nxt;
    }
}
template <int MT> struct GLP { static constexpr int DK = MT ? 64 : 32, Q = 0, AV = DK / 32 * 1024, KH = AV + 512, V = KH + DK / 16 * 512, G = V + 2048, PACK = MT ? 7168 : 5120; };
constexpr int GLL_BYTES = 10240;
struct GlaPrepArgs { const bf16* z; const float* P; unsigned char* pack; };
template <int L, int MT>
__device__ __forceinline__ void gla_prep_wave(const GlaPrepArgs& A, int hd, int c0, int cstride, int cend, LAS unsigned char* wl, int lane) {
    constexpr int DK = MT ? 64 : 32;
    const int ch = lane & (DK - 1), lo = lane & 15, h = lane >> 4;
    const float* P = A.P;
    float gku[16]; float gkb = 0.f, lb = 0.f;
    if (MT == 0) {
#pragma unroll
        for (int i = 0; i < 16; ++i) gku[i] = P[P_GKUP + L * 2048 + i * 128 + hd * 32 + ch];
        gkb = P[P_GKB + L * 128 + hd * 32 + ch];
    } else lb = P[P_LBS + L * 256 + hd * 64 + ch];
    LAS bf16* qX = (LAS bf16*)(wl + 0); LAS bf16* ktX = (LAS bf16*)(wl + 2048); LAS bf16* khT = (LAS bf16*)(wl + 4096); LAS bf16* vT = (LAS bf16*)(wl + 6144);
    LAS bf16* Aimg = (LAS bf16*)(wl + 8192); LAS float* LR = (LAS float*)(wl + 8704); asm volatile("" : "+v"(LR));
    const f32x4 z4 = (f32x4){0.f, 0.f, 0.f, 0.f};
    const __amdgpu_buffer_rsrc_t zsrd = __builtin_amdgcn_make_buffer_rsrc((void*)A.z, 0, T * ZLD * 2, 0x00020000);
    for (int c = c0; c < cend; c += cstride) SUBREP(5 + MT) {
        const int t0 = c * 16;
        const unsigned qo = (unsigned)(t0 * ZLD + (MT ? Z_HQ + hd * 64 : Z_GQ + hd * 32) + ch) * 2u, ko = (unsigned)(t0 * ZLD + (MT ? Z_HF + hd * 64 : Z_GK + hd * 32) + ch) * 2u, vo = (unsigned)(t0 * ZLD + (MT ? Z_HI : Z_GV) + hd * 64 + lane) * 2u;
        if (MT == 0) {
#pragma unroll
            for (int q = 0; q < 4; ++q) { const int e = lane + 64 * q; LR[e] = bf2f(A.z[(size_t)(t0 + (e >> 4)) * ZLD + Z_GGK + (e & 15)]); }
            LDS_WAIT(); asm volatile("" ::: "memory");
        }
        float cum = 0.f;
#define GL_LD3(dst, tt) do { const unsigned s_ = (unsigned)(tt) * (ZLD * 2); dst[0] = (bf16)__builtin_amdgcn_raw_buffer_load_b16(zsrd, qo + s_, 0, 0); dst[1] = (bf16)__builtin_amdgcn_raw_buffer_load_b16(zsrd, ko + s_, 0, 0); \
            dst[2] = (bf16)__builtin_amdgcn_raw_buffer_load_b16(zsrd, vo + s_, 0, 0); } while (0)
        bf16 Zr[16][3];
#pragma unroll
        for (int tt = 0; tt < 16; ++tt) GL_LD3(Zr[tt], tt);
#pragma unroll
        for (int tt = 0; tt < 16; ++tt) asm volatile("" : "+v"(Zr[tt][0]), "+v"(Zr[tt][1]), "+v"(Zr[tt][2]));
#pragma unroll
        for (int tg = 0; tg < 16; tg += 4) {
#pragma unroll
          for (int ti = 0; ti < 4; ++ti) {
            const int t = tg + ti;
            const bf16 zq = Zr[t][0], zk2 = Zr[t][1], zvv = Zr[t][2];
            float q, k, lf;
            if (MT == 0) {
                q = bf2f(zq) * 0.17677669529663687f; k = bf2f(zk2);
                float s = gkb;
#pragma unroll
                for (int i = 0; i < 16; ++i) s += LR[t * 16 + i] * gku[i];
                lf = logsigmoidf_(s) * (1.f / 16.f);
            } else {
                const float fq = bf2f(zq), ff = bf2f(zk2);
                q = siluf_(fq); k = (1.f - lb) * sigmoidf_(-ff);
                lf = (lb == 0.f) ? logsigmoidf_(ff) : __logf(lb + (1.f - lb) * sigmoidf_(ff));
            }
            cum += lf;
            qX[t * 64 + ch] = (bf16)f2bf(q * __expf(cum)); ktX[t * 64 + ch] = (bf16)f2bf(k * __expf(-cum));
            vT[lane * 16 + t] = zvv;
          }
        }
#undef GL_LD3
        LDS_WAIT(); asm volatile("" ::: "memory");
        { const float gch = __expf(cum);
#pragma unroll 4
          for (int t = 0; t < 16; ++t) khT[ch * 16 + t] = (bf16)f2bf(bf2f(ktX[t * 64 + ch]) * gch); }
        unsigned char* pk_ = A.pack + ((size_t)c * 4 + hd) * GLP<MT>::PACK;
        if (lane < DK) *(float*)(pk_ + GLP<MT>::G + ch * 4) = __expf(cum);
        LDS_WAIT(); asm volatile("" ::: "memory");
        f32x4 Am = z4;
#pragma unroll
        for (int s = 0; s < DK / 32; ++s) Am = MFMA16(*(const LAS bf16x8*)(qX + lo * 64 + 32 * s + 8 * h), *(const LAS bf16x8*)(ktX + lo * 64 + 32 * s + 8 * h), Am);
#pragma unroll
        for (int r = 0; r < 4; ++r) { const int t = 4 * h + r; Aimg[t * 16 + lo] = (bf16)f2bf(lo <= t ? Am[r] : 0.f); }
        LDS_WAIT(); asm volatile("" ::: "memory");
#pragma unroll
        for (int s = 0; s < DK / 32; ++s) *(bf16x8*)(pk_ + GLP<MT>::Q + s * 1024 + lane * 16) = frag2(*(const LAS v2u*)(qX + lo * 64 + 32 * s + 4 * h), *(const LAS v2u*)(qX + lo * 64 + 32 * s + 16 + 4 * h));
        *(v2u*)(pk_ + GLP<MT>::AV + lane * 8) = *(const LAS v2u*)(Aimg + lo * 16 + 4 * h);
#pragma unroll
        for (int m = 0; m < DK / 16; ++m) *(v2u*)(pk_ + GLP<MT>::KH + m * 512 + lane * 8) = *(const LAS v2u*)(khT + (16 * m + lo) * 16 + 4 * h);
#pragma unroll
        for (int vb = 0; vb < 4; ++vb) *(v2u*)(pk_ + GLP<MT>::V + vb * 512 + lane * 8) = *(const LAS v2u*)(vT + (16 * vb + lo) * 16 + 4 * h);
        LDS_WAIT(); asm volatile("" ::: "memory");
    }
}
struct GlaSeqArgs { const unsigned char* pack; };
template <int MT> struct GlaOps { bf16x8 Q[2], AV, KH[4]; f32x4 Gm[4]; v2u Vf; };
template <int MT, bool OUT>
__device__ __forceinline__ void gla_load_ops(GlaOps<MT>& o, const unsigned char* pk_, int vb, int lane) {
    constexpr int DK = MT ? 64 : 32; const int h = lane >> 4;
#pragma unroll
    for (int m = 0; m < DK / 16; ++m) { o.KH[m] = frag2(*(const v2u*)(pk_ + GLP<MT>::KH + m * 512 + lane * 8), (v2u){0u, 0u}); o.Gm[m] = *(const f32x4*)(pk_ + GLP<MT>::G + (16 * m + 4 * h) * 4); }
    o.Vf = *(const v2u*)(pk_ + GLP<MT>::V + vb * 512 + lane * 8);
    if (OUT) {
#pragma unroll
        for (int s = 0; s < DK / 32; ++s) o.Q[s] = *(const bf16x8*)(pk_ + GLP<MT>::Q + s * 1024 + lane * 16);
        o.AV = frag2(*(const v2u*)(pk_ + GLP<MT>::AV + lane * 8), (v2u){0u, 0u});
    }
}
template <int MT, bool OUT>
__device__ __forceinline__ void gla_seq_wave(const GlaSeqArgs& A, int hd, int vb, int cb, int ce, f32x4 (&S)[4], f32x4 (&Dp)[4], int lane, PostCtx* pc) {
    constexpr int DK = MT ? 64 : 32;
    const int lo = lane & 15, h = lane >> 4; const f32x4 z4 = (f32x4){0.f, 0.f, 0.f, 0.f};
    GlaOps<MT> cur, nxt;
    gla_load_ops<MT, OUT>(cur, A.pack + ((size_t)cb * 4 + hd) * GLP<MT>::PACK, vb, lane);
    for (int c = cb; c < ce; ++c) {
        const int cn = (c + 1 < ce) ? c + 1 : c;
        gla_load_ops<MT, OUT>(nxt, A.pack + ((size_t)cn * 4 + hd) * GLP<MT>::PACK, vb, lane);
        float pg[4];
        if (OUT) {
#pragma unroll
            for (int i = 0; i < 4; ++i) pg[i] = bf2f(pc->z[((size_t)c * 16 + 4 * vb + i) * ZLD + (MT ? Z_HG : Z_GG) + hd * 64 + lane]);
        }
        const bf16x8 BV = frag2(cur.Vf, (v2u){0u, 0u});
        if (OUT) {
            f32x4 o = MFMA16(cur.AV, BV, z4);
#pragma unroll
            for (int s = 0; s < DK / 32; ++s) o = MFMA16(cur.Q[s], pack8(S[2 * s], S[2 * s + 1]), o);
            LAS float* xb = pc->xbuf + (pc->step & 1u) * 1024;
#pragma unroll
            for (int r = 0; r < 4; ++r) xb[(4 * h + r) * 64 + vb * 16 + lo] = o[r];
        }
#pragma unroll
        for (int m = 0; m < DK / 16; ++m) { S[m] = MFMA16(cur.KH[m], BV, S[m] * cur.Gm[m]); if (!OUT) Dp[m] = Dp[m] * cur.Gm[m]; }
        if (OUT) {
            const LAS float* xb = pc->xbuf + (pc->step & 1u) * 1024;
            group_sync(*pc);
            const float nw = pc->P[(MT ? P_HNW : P_GNW) + pc->layer * 64 + lane];
#pragma unroll
            for (int i = 0; i < 4; ++i) { const int tt = 4 * vb + i; const float o = xb[tt * 64 + lane];
                const float ms = wave_sum(o * o) * (1.f / 64.f);
                pc->mix[((size_t)c * 16 + tt) * D + MT * 256 + hd * 64 + lane] = (bf16)f2bf(o * rsqrtf(ms + RMS_EPS) * nw * siluf_(pg[i])); }
        }
        cur = nxt;
    }
}
__device__ __forceinline__ void gla_hgrn_final(const unsigned char* gpack, const unsigned char* hpack, int hd, int vb, int cb, int ce, f32x4 (&Sg)[4], f32x4 (&Sh)[4], int lane, PostCtx* pc) {
    const int lo = lane & 15, h = lane >> 4; const f32x4 z4 = (f32x4){0.f, 0.f, 0.f, 0.f};
    GlaOps<0> cg, ng; GlaOps<1> ch, nh;
    gla_load_ops<0, true>(cg, gpack + ((size_t)cb * 4 + hd) * GLP<0>::PACK, vb, lane);
    gla_load_ops<1, true>(ch, hpack + ((size_t)cb * 4 + hd) * GLP<1>::PACK, vb, lane);
    for (int c = cb; c < ce; ++c) {
        const int cn = (c + 1 < ce) ? c + 1 : c;
        gla_load_ops<0, true>(ng, gpack + ((size_t)cn * 4 + hd) * GLP<0>::PACK, vb, lane);
        gla_load_ops<1, true>(nh, hpack + ((size_t)cn * 4 + hd) * GLP<1>::PACK, vb, lane);
        float pgg[4], pgh[4];
#pragma unroll
        for (int i = 0; i < 4; ++i) { const bf16* zt = pc->z + ((size_t)c * 16 + 4 * vb + i) * ZLD; pgg[i] = bf2f(zt[Z_GG + hd * 64 + lane]); pgh[i] = bf2f(zt[Z_HG + hd * 64 + lane]); }
        LAS float* xb = pc->xbuf + (pc->step & 1u) * 2048;
        {
            const bf16x8 BV = frag2(cg.Vf, (v2u){0u, 0u});
            f32x4 o = MFMA16(cg.AV, BV, z4); o = MFMA16(cg.Q[0], pack8(Sg[0], Sg[1]), o);
#pragma unroll
            for (int r = 0; r < 4; ++r) xb[(4 * h + r) * 64 + vb * 16 + lo] = o[r];
#pragma unroll
            for (int m = 0; m < 2; ++m) Sg[m] = MFMA16(cg.KH[m], BV, Sg[m] * cg.Gm[m]);
        }
        {
            const bf16x8 BV = frag2(ch.Vf, (v2u){0u, 0u});
            f32x4 o = MFMA16(ch.AV, BV, z4); o = MFMA16(ch.Q[0], pack8(Sh[0], Sh[1]), o); o = MFMA16(ch.Q[1], pack8(Sh[2], Sh[3]), o);
#pragma unroll
            for (int r = 0; r < 4; ++r) xb[1024 + (4 * h + r) * 64 + vb * 16 + lo] = o[r];
#pragma unroll
            for (int m = 0; m < 4; ++m) Sh[m] = MFMA16(ch.KH[m], BV, Sh[m] * ch.Gm[m]);
        }
        group_sync(*pc);
        const float nwg = pc->P[P_GNW + pc->layer * 64 + lane], nwh = pc->P[P_HNW + pc->layer * 64 + lane];
#pragma unroll
        for (int i = 0; i < 4; ++i) { const int tt = 4 * vb + i; const float og = xb[tt * 64 + lane], oh = xb[1024 + tt * 64 + lane];
            const float msg = wave_sum(og * og) * (1.f / 64.f), msh = wave_sum(oh * oh) * (1.f / 64.f);
            bf16* mp = pc->mix + ((size_t)c * 16 + tt) * D + hd * 64 + lane;
            mp[0] = (bf16)f2bf(og * rsqrtf(msg + RMS_EPS) * nwg * siluf_(pgg[i])); mp[256] = (bf16)f2bf(oh * rsqrtf(msh + RMS_EPS) * nwh * siluf_(pgh[i])); }
        cg = ng; ch = nh;
    }
}
constexpr int SW_KLD = 72, SW_VLD = 264, SW_PLD = 40;
constexpr int SW_K = 0, SW_V = 256 * SW_KLD * 2, SW_P = SW_V + 64 * SW_VLD * 2, SW_PW = 32 * SW_PLD * 2, SW_LDS = SW_P + 8 * SW_PW;
typedef float f32x16 __attribute__((ext_vector_type(16)));
#define MFMA32(a, b, c) __builtin_amdgcn_mfma_f32_32x32x16_bf16((a), (b), (c), 0, 0, 0)
__device__ __forceinline__ void swa_items(const bf16* z, const float* sinks, bf16* mix, int i0, int istride, LAS unsigned char* lds, int tid) {
    const int lane = tid & 63, wave = tid >> 6, l31 = lane & 31, hh = lane >> 5;
    LAS bf16* Ks = (LAS bf16*)(lds + SW_K); LAS bf16* Vt = (LAS bf16*)(lds + SW_V); LAS bf16* Pw = (LAS bf16*)(lds + SW_P + wave * SW_PW);
    for (int item = i0; item < (T / 128) * 2; item += istride) {
        const int nb = item >> 1, kvh = item & 1, tk0 = nb * 128 - 128;
        __syncthreads();
#pragma unroll
        for (int q = 0; q < 4; ++q) {
            const int e = tid + 512 * q, key = e >> 3, ch = e & 7; int tok = tk0 + key; tok = tok < 0 ? 0 : tok;
            const v4u kv = *(const GAS v4u*)(z + (size_t)tok * ZLD + Z_SK + kvh * 64 + ch * 8);
            *(LAS v4u*)(Ks + key * SW_KLD + ch * 8) = kv;
            const v4u vv = *(const GAS v4u*)(z + (size_t)tok * ZLD + Z_SV + kvh * 64 + ch * 8);
#pragma unroll
            for (int j = 0; j < 4; ++j) { Vt[(ch * 8 + 2 * j) * SW_VLD + key] = (bf16)(vv[j] & 0xffffu); Vt[(ch * 8 + 2 * j + 1) * SW_VLD + key] = (bf16)(vv[j] >> 16); }
        }
        __syncthreads();
        const int g = wave >> 2, qh = kvh * 2 + g, q0 = (wave & 3) * 32, kt0 = wave & 3;
        const float sink = sinks[qh];
        bf16x8 Qf[4];
        { const bf16* qp = z + (size_t)(nb * 128 + q0 + l31) * ZLD + Z_SQ + qh * 64 + 8 * hh;
#pragma unroll
          for (int s = 0; s < 4; ++s) Qf[s] = *(const GAS bf16x8*)(qp + 16 * s); }
        f32x16 Sc[5];
#pragma unroll
        for (int kt = 0; kt < 5; ++kt) {
            f32x16 acc;
#pragma unroll
            for (int i = 0; i < 16; ++i) acc[i] = 0.f;
            const LAS bf16* kp = Ks + ((kt0 + kt) * 32 + l31) * SW_KLD + 8 * hh;
#pragma unroll
            for (int s = 0; s < 4; ++s) acc = MFMA32(Qf[s], *(const LAS bf16x8*)(kp + 16 * s), acc);
            Sc[kt] = acc;
        }
        int l31o = l31, hho = hh; asm volatile("" : "+v"(l31o), "+v"(hho));
        float mx[16];
#pragma unroll
        for (int r = 0; r < 16; ++r) {
            const int ro = (r & 3) + 8 * (r >> 2) + 4 * hho;
            const bool lowv = l31o > ro;
            float m = -INFINITY;
#pragma unroll
            for (int kt = 0; kt < 5; ++kt) { bool vis = (kt == 0) ? lowv : ((kt == 4) ? !lowv : true); if (nb == 0 && kt0 + kt < 4) vis = false;
                const float sv = vis ? Sc[kt][r] * 0.125f : -INFINITY; Sc[kt][r] = sv; m = fmaxf(m, sv); }
#pragma unroll
            for (int o = 1; o < 32; o <<= 1) m = fmaxf(m, __shfl_xor(m, o));
            mx[r] = fmaxf(m, sink);
        }
        float inv[16];
#pragma unroll
        for (int r = 0; r < 16; ++r) {
            float s = 0.f;
#pragma unroll
            for (int kt = 0; kt < 5; ++kt) { const float p = __expf(Sc[kt][r] - mx[r]); Sc[kt][r] = p; s += p; }
#pragma unroll
            for (int o = 1; o < 32; o <<= 1) s += __shfl_xor(s, o);
            inv[r] = 1.f / (s + __expf(sink - mx[r]));
        }
        f32x16 O0, O1;
#pragma unroll
        for (int i = 0; i < 16; ++i) { O0[i] = 0.f; O1[i] = 0.f; }
#pragma unroll
        for (int kt = 0; kt < 5; ++kt) {
#pragma unroll
            for (int r = 0; r < 16; ++r) Pw[((r & 3) + 8 * (r >> 2) + 4 * hh) * SW_PLD + l31] = (bf16)f2bf(Sc[kt][r] * inv[r]);
            LDS_WAIT(); asm volatile("" ::: "memory");
#pragma unroll
            for (int s = 0; s < 2; ++s) {
                const bf16x8 Pf = *(const LAS bf16x8*)(Pw + l31 * SW_PLD + 16 * s + 8 * hh);
                const int kb = (kt0 + kt) * 32 + 16 * s + 8 * hh;
                O0 = MFMA32(Pf, *(const LAS bf16x8*)(Vt + l31 * SW_VLD + kb), O0);
                O1 = MFMA32(Pf, *(const LAS bf16x8*)(Vt + (32 + l31) * SW_VLD + kb), O1);
            }
            LDS_WAIT(); asm volatile("" ::: "memory");
        }
#pragma unroll
        for (int r = 0; r < 16; ++r) { const int qi = q0 + (r & 3) + 8 * (r >> 2) + 4 * hh; bf16* op = mix + (size_t)(nb * 128 + qi) * D + 512 + qh * 64 + l31;
            op[0] = (bf16)f2bf(O0[r]); op[32] = (bf16)f2bf(O1[r]); }
    }
}
__device__ __forceinline__ void tr_item(const float* src, int ldw, int nvalid, bf16* dst, int dld, LAS float* scr, int lane) {
    const int nl = lane & 31;
    float tv[32];
#pragma unroll
    for (int i = 0; i < 32; ++i) { const int kk = 2 * i + (lane >> 5); tv[i] = (nl < nvalid) ? src[(size_t)kk * ldw + nl] : 0.f; }
#pragma unroll
    for (int i = 0; i < 32; ++i) { const int kk = 2 * i + (lane >> 5); scr[kk * 33 + nl] = tv[i]; }
    LDS_WAIT(); asm volatile("" ::: "memory");
    const int c = lane & 7;
#pragma unroll
    for (int j = 0; j < 4; ++j) { const int n = (lane >> 3) + 8 * j; const LAS float* s = scr + (8 * c) * 33 + n;
        v4u o; o.x = pk2(s[0 * 33], s[1 * 33]); o.y = pk2(s[2 * 33], s[3 * 33]); o.z = pk2(s[4 * 33], s[5 * 33]); o.w = pk2(s[6 * 33], s[7 * 33]);
        if (n < nvalid) *(GAS v4u*)(dst + (size_t)n * dld + 8 * c) = o; }
    LDS_WAIT(); asm volatile("" ::: "memory");
}
__device__ __forceinline__ void tr_job(const float* src, int ldw, int nblocks, int ncols, bf16* dst, int dld, int il, int rowoff, int it, LAS float* scr, int lane) {
    const int kb = it / nblocks, nb = it - kb * nblocks, n0 = nb * 32; const int nv = (ncols - n0) < 32 ? (ncols - n0) : 32;
    const int row = il ? ((n0 >> 7) * 256 + (n0 & 127) + rowoff) : (n0 + rowoff);
    tr_item(src + (size_t)kb * 64 * ldw + n0, ldw, nv, dst + (size_t)row * dld + kb * 64, dld, scr, lane);
}
template <int PARTS> __device__ __forceinline__ void moe_weights_half(const float* wg, const float* wu, const float* wd, bf16* gu, bf16* dn, int hh, int gw, int NGW, LAS float* scr, int lane) {
    constexpr int PER = 896, NW = (PARTS == 3) ? 3 : (PARTS == 1 ? 2 : 1), PE = NW * PER;
    for (int it = gw; it < NE * PE; it += NGW) {
        const int e = it / PE, r = it - e * PE, w_ = r / PER, idx = r - w_ * PER, which = (PARTS == 2) ? 2 : w_;
        const float* src; int ldw, nblocks, ncols, dld, il, rowoff; bf16* dst;
        if (which == 0) { src = wg + (size_t)e * D * DFE + hh * DFH; ldw = DFE; nblocks = 56; ncols = DFH; dst = gu + (size_t)e * 3584 * D; dld = D; il = 1; rowoff = 0; }
        else if (which == 1) { src = wu + (size_t)e * D * DFE + hh * DFH; ldw = DFE; nblocks = 56; ncols = DFH; dst = gu + (size_t)e * 3584 * D; dld = D; il = 1; rowoff = 128; }
        else { src = wd + (size_t)e * DFE * D + (size_t)hh * DFH * D; ldw = D; nblocks = 32; ncols = D; dst = dn + (size_t)e * D * DFH; dld = DFH; il = 0; rowoff = 0; }
        tr_job(src, ldw, nblocks, ncols, dst, dld, il, rowoff, idx, scr, lane);
    }
}
__device__ __forceinline__ void cvt_rows(const float* src, bf16* dst, size_t n, size_t gtid, size_t nthreads) {
    for (size_t i = gtid * 8; i < n; i += nthreads * 8) { const f32x4 a = *(const GAS f32x4*)(src + i), b = *(const GAS f32x4*)(src + i + 4);
        v4u o; o.x = pk2(a[0], a[1]); o.y = pk2(a[2], a[3]); o.z = pk2(b[0], b[1]); o.w = pk2(b[2], b[3]); *(GAS v4u*)(dst + i) = o; }
}

struct LnArgs { const float* src; const float* gam; const float* bet; bf16* xb; int mode; const bf16* Y1; const bf16* Y2; const int* tok_row; const float* top_g;
                int route; const float* router; int* top_e; float* top_gw; gu32* cnt; LAS unsigned* lhist; };
__device__ __forceinline__ void ln_rows(const LnArgs& a, int gw, int NGW, int lane) {
    for (int row = gw; row < T; row += NGW) {
        f32x4 v[4]; float s = 0.f;
        if (a.mode == 0) {
#pragma unroll
            for (int j = 0; j < 4; ++j) { const v2u w_ = *((const GAS v2u*)((const bf16*)a.src + (size_t)row * D) + lane + 64 * j);
                v[j][0] = __uint_as_float(w_.x << 16); v[j][1] = __uint_as_float(w_.x & 0xffff0000u); v[j][2] = __uint_as_float(w_.y << 16); v[j][3] = __uint_as_float(w_.y & 0xffff0000u); }
        } else {
            const int r0 = a.tok_row[row * 2], r1 = a.tok_row[row * 2 + 1]; const float g0 = a.top_g[row * 2], g1 = a.top_g[row * 2 + 1];
#pragma unroll
            for (int j = 0; j < 4; ++j) {
                const v2u xw = *((const GAS v2u*)(a.xb + (size_t)row * D) + lane + 64 * j); f32x4 xv;
                xv[0] = __uint_as_float(xw.x << 16); xv[1] = __uint_as_float(xw.x & 0xffff0000u); xv[2] = __uint_as_float(xw.y << 16); xv[3] = __uint_as_float(xw.y & 0xffff0000u);
                const v2u a0 = *((const GAS v2u*)(a.Y1 + (size_t)r0 * D) + lane + 64 * j), b0 = *((const GAS v2u*)(a.Y2 + (size_t)r0 * D) + lane + 64 * j);
                const v2u a1 = *((const GAS v2u*)(a.Y1 + (size_t)r1 * D) + lane + 64 * j), b1 = *((const GAS v2u*)(a.Y2 + (size_t)r1 * D) + lane + 64 * j);
                f32x4 y0, y1;
                y0[0] = __uint_as_float(a0.x << 16) + __uint_as_float(b0.x << 16); y0[1] = __uint_as_float(a0.x & 0xffff0000u) + __uint_as_float(b0.x & 0xffff0000u);
                y0[2] = __uint_as_float(a0.y << 16) + __uint_as_float(b0.y << 16); y0[3] = __uint_as_float(a0.y & 0xffff0000u) + __uint_as_float(b0.y & 0xffff0000u);
                y1[0] = __uint_as_float(a1.x << 16) + __uint_as_float(b1.x << 16); y1[1] = __uint_as_float(a1.x & 0xffff0000u) + __uint_as_float(b1.x & 0xffff0000u);
                y1[2] = __uint_as_float(a1.y << 16) + __uint_as_float(b1.y << 16); y1[3] = __uint_as_float(a1.y & 0xffff0000u) + __uint_as_float(b1.y & 0xffff0000u);
                v[j] = xv * ALPHA + y0 * g0 + y1 * g1;
            }
        }
#pragma unroll
        for (int j = 0; j < 4; ++j) s += (v[j][0] + v[j][1]) + (v[j][2] + v[j][3]);
        const float mean = wave_sum(s) * (1.f / D); float q = 0.f;
#pragma unroll
        for (int j = 0; j < 4; ++j) { v[j] = v[j] - mean; q += (v[j][0] * v[j][0] + v[j][1] * v[j][1]) + (v[j][2] * v[j][2] + v[j][3] * v[j][3]); }
        const float rstd = rsqrtf(wave_sum(q) * (1.f / D) + LN_EPS);
#pragma unroll
        for (int j = 0; j < 4; ++j) {
            const f32x4 gg = *((const GAS f32x4*)a.gam + lane + 64 * j), bb = *((const GAS f32x4*)a.bet + lane + 64 * j);
            v[j] = v[j] * rstd * gg + bb;
            v2u w; w.x = pk2(v[j][0], v[j][1]); w.y = pk2(v[j][2], v[j][3]);
            *((GAS v2u*)(a.xb + (size_t)row * D) + lane + 64 * j) = w;
        }
        if (a.route) {
            float lg[8];
#pragma unroll
            for (int e = 0; e < 8; ++e) lg[e] = 0.f;
#pragma unroll
            for (int j = 0; j < 4; ++j)
#pragma unroll
                for (int i = 0; i < 4; ++i) { const int d = 4 * lane + 256 * j + i; const f32x4 r0 = *(const GAS f32x4*)(a.router + d * 8), r1 = *(const GAS f32x4*)(a.router + d * 8 + 4); const float xv = v[j][i];
                    lg[0] += xv * r0[0]; lg[1] += xv * r0[1]; lg[2] += xv * r0[2]; lg[3] += xv * r0[3]; lg[4] += xv * r1[0]; lg[5] += xv * r1[1]; lg[6] += xv * r1[2]; lg[7] += xv * r1[3]; }
#pragma unroll
            for (int e = 0; e < 8; ++e) lg[e] = wave_sum(lg[e]);
            if (lane == 0) {
                int e0 = 0; float l0 = lg[0];
#pragma unroll
                for (int e = 1; e < 8; ++e) if (lg[e] > l0) { l0 = lg[e]; e0 = e; }
                int e1 = 0; float l1 = -INFINITY;
#pragma unroll
                for (int e = 0; e < 8; ++e) if (e != e0 && lg[e] > l1) { l1 = lg[e]; e1 = e; }
                const float g1 = __expf(l1 - l0), den = 1.f + g1;
                a.top_e[row * 2] = e0; a.top_e[row * 2 + 1] = e1; a.top_gw[row * 2] = 1.f / den; a.top_gw[row * 2 + 1] = g1 / den;
                __hip_atomic_fetch_add(a.lhist + e0, 1u, __ATOMIC_RELAXED, __HIP_MEMORY_SCOPE_WORKGROUP); __hip_atomic_fetch_add(a.lhist + e1, 1u, __ATOMIC_RELAXED, __HIP_MEMORY_SCOPE_WORKGROUP);
            }
        }
    }
}

struct Args { const float* in[38]; float* out; unsigned char* ws; };
template <int I> __device__ __forceinline__ const float* in_ptr() {
    unsigned long long v; auto kp = __builtin_amdgcn_kernarg_segment_ptr();
    asm volatile("s_load_dwordx2 %0, %1, %2\n\ts_waitcnt lgkmcnt(0)" : "=s"(v) : "s"(kp), "n"(I * 8));
    return (const float*)v;
}
#define IN(i) in_ptr<(i)>()
#ifndef DIAG_A
#define DIAG_A -1
#define DIAG_B -1
#define DIAG_DIV 100000.f
#endif
#define PHASE_IDS() int tid = threadIdx.x; asm volatile("" : "+v"(tid)); const int lane = tid & 63; (void)lane
#ifndef DUP_PHASE
#define DUP_PHASE -1
#define DUP_N 5
#endif
#define DUP_BEGIN(id) _Pragma("unroll") for (int rep_ = 0; rep_ < ((DUP_PHASE == (id)) ? DUP_N : 1); ++rep_) {
#define DUP_END() GRID_BAR(); }
#define DUP_END2() }
#define GRID_BAR() do { xcd_barrier(bar); if (DIAG_A >= -1 && DIAG_B >= 0) { if (bx == 0 && threadIdx.x == 0) ((GAS unsigned long long*)(args.ws + WS_CTL + 262144))[nst] = __builtin_amdgcn_s_memrealtime(); ++nst; } } while (0)
template <int L, bool DO_IN, bool DO_MIX, bool DO_POST>
__device__ __forceinline__ void layer_body(const Args& args, LAS unsigned char* lds, const XcdBarrier& bar, int tid0, int lane0, int wave, int G, int bx, int vcu, int gw, int NGW, int& nst) {
    (void)tid0; (void)lane0;
    unsigned char* ws = args.ws;
    gu32* ctl = (gu32*)(ws + WS_CTL);
    bf16* Wmoegu = (bf16*)(ws + WS_MOEGU); bf16* Wmoed = (bf16*)(ws + WS_MOED);
    bf16* vfirst = (bf16*)(ws + WS_VFIRST);
    bf16* zb = (bf16*)(ws + WS_Z); bf16* mix = (bf16*)(ws + WS_MIX); float* preln = (float*)(ws + WS_PRELN);
    float* gla_logf = (float*)(ws + WS_PREP); float* rwb = (float*)(ws + WS_PREP + 8 * MiB);
    const float* PB = (const float*)(ws + WS_MISC + MS_PARAMS); int* top_e = (int*)(ws + WS_MISC + MS_TOPE); float* top_g = (float*)(ws + WS_MISC + MS_TOPG);
    int* tok_row = (int*)(ws + WS_MISC + MS_TOKROW); int* row_tok = (int*)(ws + WS_MISC + MS_ROWTOK); int* tile_e = (int*)(ws + WS_MISC + MS_TILEE);

        bf16* xin = (L == 0) ? (bf16*)(ws + WS_XB0) : (bf16*)args.out; bf16* xb_in = (bf16*)(ws + (L == 0 ? WS_XB0 : WS_XB1)); bf16* xb_out = (bf16*)args.out;
        if constexpr (DO_IN) {
        DUP_BEGIN(L * 100 + 1)
        {
            pg8::Gemm g{xin, (const bf16*)(ws + (L == 0 ? WS_WIN0 : WS_WIN1)), T, ZLD, D}; pg8::StaticOrder S; S.init(T, ZLD, G, bx);
            pg8::EpiStoreBf16 E{zb, ZLD};
            pg8::gemm_phase<pg8::EpiStoreBf16, pg8::StaticOrder, PG8_ALIGN, PG8_SP2>(lds, g, S, E);
        }
        DUP_END();
        }
        if constexpr (DO_MIX) {
        float* sst = (float*)(ws + WS_SST); bf16* mtb = (bf16*)(ws + WS_MT); float* dsc = (float*)(ws + WS_MISC + MS_DSC);
        DUP_BEGIN(L * 100 + 3)
        DUP_BEGIN(L * 100 + 2)
        {
            PHASE_IDS(); const int lo = lane & 15, h = lane >> 4;
            const int j = vcu >> 2, hd = vcu & 3, cb = 16 * j, ce = cb + 16;
            DUP_BEGIN(L * 100 + 20)
            if (wave < 4) { RwkvPrepArgs rp; rp.z = zb; rp.P = PB; rp.vfirst = vfirst; rp.pack = ws + WS_RWPACK; rp.gout = (bf16*)(ws + WS_GOUT); rp.vout = (bf16*)(ws + WS_VOUT); rp.bcout = (float*)(ws + WS_BC); rp.pfrag = ws + WS_MISC + MS_PFRAG;
                rwkv_prep_wave<L>(rp, hd, cb + wave, 4, ce, lds + wave * RWL_BYTES, lane); }
            else { GlaPrepArgs g0; g0.z = zb; g0.P = PB; g0.pack = ws + WS_GLPACK; GlaPrepArgs g1 = g0; g1.pack = ws + WS_HGPACK;
                gla_prep_wave<L, 0>(g0, hd, cb + wave - 4, 4, ce, lds + 4 * RWL_BYTES + (wave - 4) * GLL_BYTES, lane);
                gla_prep_wave<L, 1>(g1, hd, cb + wave - 4, 4, ce, lds + 4 * RWL_BYTES + (wave - 4) * GLL_BYTES, lane); }
            DUP_END2()
            VM_WAIT(); __syncthreads();
            DUP_BEGIN(L * 100 + 21)
            {
                RwkvSeqArgs sa; sa.pack = ws + WS_RWPACK; f32x4 St[4];
                if (wave < 4) {
#pragma unroll
                    for (int m = 0; m < 4; ++m) St[m] = (f32x4){0.f, 0.f, 0.f, 0.f};
                    rwkv_seq_wave<0>(sa, hd, wave, cb, ce, St, lane, nullptr);
                    float* o = sst + ((size_t)((8 + hd) * 64 + j)) * 4096 + (wave * 4 * 64 + lane) * 4;
#pragma unroll
                    for (int m = 0; m < 4; ++m) *(GAS f32x4*)(o + m * 256) = St[m];
                } else {
                    const int pb = wave - 4;
#pragma unroll
                    for (int m = 0; m < 4; ++m)
#pragma unroll
                        for (int r = 0; r < 4; ++r) St[m][r] = (16 * m + 4 * h + r == 16 * pb + lo) ? 1.f : 0.f;
                    rwkv_seq_wave<1>(sa, hd, pb, cb, ce, St, lane, nullptr);
                    bf16* o = mtb + ((size_t)(hd * 64 + j)) * 4096 + (lo & 3);
#pragma unroll
                    for (int m = 0; m < 4; ++m)
#pragma unroll
                        for (int r = 0; r < 4; ++r) o[(16 * m + 4 * h + r) * 64 + ((((16 * pb + lo) >> 2) ^ (4 * h + r)) << 2)] = (bf16)f2bf(St[m][r]);
                }
            }
            DUP_END2()
            DUP_BEGIN(L * 100 + 22)
            {
                f32x4 S[4], Dp[4];
#pragma unroll
                for (int m = 0; m < 4; ++m) { S[m] = (f32x4){0.f, 0.f, 0.f, 0.f}; Dp[m] = (f32x4){1.f, 1.f, 1.f, 1.f}; }
                const int vb = wave & 3, mt = wave >> 2, mh = mt * 4 + hd;
                GlaSeqArgs sa; sa.pack = ws + (mt ? WS_HGPACK : WS_GLPACK);
                if (mt == 0) gla_seq_wave<0, false>(sa, hd, vb, cb, ce, S, Dp, lane, nullptr); else gla_seq_wave<1, false>(sa, hd, vb, cb, ce, S, Dp, lane, nullptr);
                float* o = sst + ((size_t)(mh * 64 + j)) * 4096 + (vb * 4 * 64 + lane) * 4;
#pragma unroll
                for (int m = 0; m < 4; ++m) if (mt || m < 2) *(GAS f32x4*)(o + m * 256) = S[m];
                if (vb == 0 && lo == 0) {
#pragma unroll
                    for (int m = 0; m < 4; ++m) if (mt || m < 2) *(GAS f32x4*)(dsc + ((size_t)(mh * 64 + j)) * 64 + 16 * m + 4 * h) = Dp[m]; }
            }
            DUP_END2()
        }
        DUP_END();
        {
            PHASE_IDS(); const int lo = lane & 15, h = lane >> 4;
            if (bx < 48) {
                const int gt = bx * (NWAVES * 64) + tid; int mh, e, mm;
                if (gt < 8192) { mh = gt >> 11; e = gt & 2047; mm = (e >> 8) & 1; e = ((e >> 9) * 4 + mm) * 256 + (e & 255); }
                else { const int g2 = gt - 8192; mh = 4 + (g2 >> 12); e = g2 & 4095; mm = (e >> 8) & 3; }
                const int k = 16 * mm + 4 * ((e & 255) >> 6) + (e & 3);
                float* sp = sst + (size_t)mh * 64 * 4096 + e; const float* dp = dsc + (size_t)mh * 64 * 64 + k;
                float S = 0.f;
#pragma unroll 1
                for (int j0 = 0; j0 < 64; j0 += 8) {
                    float sl[8], dd[8];
#pragma unroll
                    for (int u = 0; u < 8; ++u) { sl[u] = sp[(size_t)(j0 + u) * 4096]; dd[u] = dp[(j0 + u) * 64]; }
#pragma unroll
                    for (int u = 0; u < 8; ++u) { sp[(size_t)(j0 + u) * 4096] = S; S = dd[u] * S + sl[u]; }
                }
            } else if (bx < 52) {
                const int hd = bx - 48, vb = wave & 3;
                f32x4 St[4], N0[4], N1[4], N2[4];
#pragma unroll
                for (int m = 0; m < 4; ++m) St[m] = (f32x4){0.f, 0.f, 0.f, 0.f};
                float* sp = sst + ((size_t)(8 + hd) * 64) * 4096 + (vb * 4 * 64 + lane) * 4;
                const unsigned char* mg = (const unsigned char*)(mtb + ((size_t)hd * 64) * 4096);
#define RW_NLOAD(N_, jj) do { _Pragma("unroll") for (int m = 0; m < 4; ++m) N_[m] = *(const GAS f32x4*)(sp + (size_t)(jj) * 4096 + m * 256); } while (0)
                if (wave < 4) { RW_NLOAD(N0, 0); RW_NLOAD(N1, 1); RW_NLOAD(N2, 2); }
#pragma unroll 1
                for (int rd = 0; rd < 4; ++rd) {
                    __syncthreads();
                    if (wave < 4) {
#pragma unroll 8
                        for (int i = 0; i < 32; ++i) { const int q = wave * 32 + i;
                            __builtin_amdgcn_global_load_lds((const unsigned*)(mg + (size_t)(16 * rd) * 8192 + (size_t)q * 1024 + lane * 16), (LAS unsigned*)(lds + q * 1024), 16, 0, 0); }
                    }
                    VM_WAIT(); __syncthreads();
                    if (wave < 4) {
#pragma unroll 1
                        for (int jj = 0; jj < 16; ++jj) {
                            const int j = 16 * rd + jj;
                            const LAS unsigned char* ms = lds + jj * 8192 + lo * 128;
                            bf16x8 Af[4][2];
#pragma unroll
                            for (int m = 0; m < 4; ++m)
#pragma unroll
                                for (int s2 = 0; s2 < 2; ++s2) Af[m][s2] = frag2(*(const LAS v2u*)(ms + m * 2048 + (((8 * s2 + h) ^ lo) << 3)), *(const LAS v2u*)(ms + m * 2048 + (((8 * s2 + 4 + h) ^ lo) << 3)));
                            const bf16x8 B0 = pack8(St[0], St[1]), B1 = pack8(St[2], St[3]);
#pragma unroll
                            for (int m = 0; m < 4; ++m) { *(GAS f32x4*)(sp + (size_t)j * 4096 + m * 256) = St[m]; }
#pragma unroll
                            for (int m = 0; m < 4; ++m) { f32x4 a = MFMA16(Af[m][0], B0, N0[m]); St[m] = MFMA16(Af[m][1], B1, a); }
#pragma unroll
                            for (int m = 0; m < 4; ++m) { N0[m] = N1[m]; N1[m] = N2[m]; }
                            { const int jn = (j + 3 < 64) ? j + 3 : 63; RW_NLOAD(N2, jn); }
                        }
                    }
                }
#undef RW_NLOAD
            } else swa_items(zb, PB + P_SINK + L * 4, mix, bx - 52, G - 52, lds, tid);
        }
        DUP_END();
        DUP_BEGIN(L * 100 + 4)
        {
            PHASE_IDS();
            const int j = vcu >> 2, hd = vcu & 3, cb = 16 * j, ce = cb + 16;
            if (tid < 2) ((LAS unsigned*)(lds + 32768))[tid * 16] = 0u;
            __syncthreads();
            PostCtx pc; pc.xbuf = (LAS float*)(lds + (wave >> 2) * 8192); pc.cnt = (volatile LAS unsigned*)(lds + 32768) + (wave >> 2) * 16; pc.step = 0u;
            pc.z = zb; pc.P = PB; pc.g = (const bf16*)(ws + WS_GOUT); pc.v = (const bf16*)(ws + WS_VOUT); pc.bc = (const float*)(ws + WS_BC); pc.mix = mix; pc.layer = L;
            if (wave < 4) {
                RwkvSeqArgs sa; sa.pack = ws + WS_RWPACK; f32x4 St[4];
                const float* o = sst + ((size_t)((8 + hd) * 64 + j)) * 4096 + (wave * 4 * 64 + lane) * 4;
#pragma unroll
                for (int m = 0; m < 4; ++m) St[m] = *(const GAS f32x4*)(o + m * 256);
                rwkv_seq_wave<2>(sa, hd, wave, cb, ce, St, lane, &pc);
            } else {
                const int vb = wave - 4; f32x4 Sg[4], Sh[4];
                const float* og = sst + ((size_t)(hd * 64 + j)) * 4096 + (vb * 4 * 64 + lane) * 4; const float* oh = sst + ((size_t)((4 + hd) * 64 + j)) * 4096 + (vb * 4 * 64 + lane) * 4;
#pragma unroll
                for (int m = 0; m < 4; ++m) { Sg[m] = (m < 2) ? *(const GAS f32x4*)(og + m * 256) : (f32x4){0.f, 0.f, 0.f, 0.f}; Sh[m] = *(const GAS f32x4*)(oh + m * 256); }
                gla_hgrn_final(ws + WS_GLPACK, ws + WS_HGPACK, hd, vb, cb, ce, Sg, Sh, lane, &pc);
            }
        }
        DUP_END();
        }
        if constexpr (DO_POST) {
        DUP_BEGIN(L * 100 + 99) if (rep_ == 0) continue; DUP_END();
        DUP_BEGIN(L * 100 + 6)
        {
            pg8::Gemm g{mix, (const bf16*)(ws + (L == 0 ? WS_WOUT0 : WS_WOUT1)), T, D, D}; pg8::StaticOrder S; S.init(T, D, G, bx);
            pg8::EpiResBf16T<(L > 0)> E{(L == 0) ? (const void*)IN(0) : (const void*)xin, (bf16*)preln, D, ALPHA};
            pg8::gemm_phase<pg8::EpiResBf16T<(L > 0)>, pg8::StaticOrder, PG8_ALIGN, PG8_SP2>(lds, g, S, E);
        }
        DUP_END();
        DUP_BEGIN(L == 0 ? 7 : -77)
        {
            PHASE_IDS(); LnArgs la{}; la.src = preln; la.gam = PB + P_LN1G + L * D; la.bet = PB + P_LN1B + L * D; la.xb = xb_in; la.mode = 0;
            la.route = (L == 1); la.router = PB + P_ROUTER; la.top_e = top_e; la.top_gw = top_g; la.cnt = ctl + CW_MOE; la.lhist = (LAS unsigned*)lds;
            if (L == 1) { if (tid < 8) ((LAS unsigned*)lds)[tid] = 0u; __syncthreads(); }
            ln_rows(la, gw, NGW, lane);
            if (L == 1) { LDS_WAIT(); __syncthreads(); if (tid < 8) { const unsigned hv = ((LAS unsigned*)lds)[tid]; ((int*)(ws + WS_MISC + MS_HIST))[vcu * 8 + tid] = (int)hv; __hip_atomic_fetch_add(ctl + CW_MOE + tid, hv, RLX_AGENT); } }
        }
        DUP_END();
        if constexpr (L == 0) {
        DUP_BEGIN(L * 100 + 8)
            {
                pg8::Gemm g{xb_in, (const bf16*)(ws + WS_FGU), T, 2 * DFF, D}; pg8::StaticOrder S; S.init(T, 2 * DFF, G, bx);
                pg8::EpiSwiglu E{(bf16*)(ws + WS_HD), DFF};
                pg8::gemm_phase<pg8::EpiSwiglu, pg8::StaticOrder, PG8_ALIGN, PG8_SP2>(lds, g, S, E);
            }
            {
                constexpr int NHEAVY = (T / 256) * (2 * DFF / 256) - 5 * 256;
                pg8::Gemm g{(const bf16*)(ws + WS_PB0), (const bf16*)(ws + WS_PP0), T, D, 256}; pg8::StaticOrder S; S.init(T, D, G - NHEAVY, bx >= NHEAVY ? bx - NHEAVY : (1 << 20));
                pg8::EpiStoreBf16 E{(bf16*)(ws + WS_MIX), D};
                pg8::gemm_phase<pg8::EpiStoreBf16, pg8::StaticOrder, PG8_ALIGN, PG8_SP2>(lds, g, S, E);
            }
            DUP_END();
        DUP_BEGIN(L * 100 + 9)
            {
                pg8::Gemm g{(const bf16*)(ws + WS_HD), (const bf16*)(ws + WS_FD), T, D, DFF}; pg8::StaticOrder S; S.init(T, D, G, bx);
                pg8::EpiResBf16T<true> E{(const void*)xb_in, (bf16*)preln, D, ALPHA};
                pg8::gemm_phase<pg8::EpiResBf16T<true>, pg8::StaticOrder, PG8_ALIGN, PG8_SP2>(lds, g, S, E);
            }
            DUP_END();
            {
                PHASE_IDS(); LnArgs la{}; la.src = preln; la.gam = PB + P_LN2G + L * D; la.bet = PB + P_LN2B + L * D; la.xb = xb_in; la.mode = 0; la.route = 0;
                ln_rows(la, gw, NGW, lane);
            }
        } else {
            int start[NE + 1]; int nrt;
            {
                PHASE_IDS();
                int off = 0;
#pragma unroll
                for (int e = 0; e < NE; ++e) { start[e] = off; const int c = (int)__hip_atomic_load(ctl + CW_MOE + e, RLX_AGENT); off += (c + 255) / 256 * 256; }
                start[NE] = off; nrt = off / 256;
                if (bx == 0 && tid < MOE_MAXTILES) { int e = 0;
#pragma unroll
                    for (int q = 1; q < NE; ++q) if (tid * 256 >= start[q]) e = q;
                    tile_e[tid] = e; }
                LAS int* lofs = (LAS int*)lds;
                if (tid < 8) lofs[tid] = 0;
                __syncthreads();
                if (tid < vcu) { const int* hp = (const int*)(ws + WS_MISC + MS_HIST) + tid * 8;
#pragma unroll
                    for (int q = 0; q < NE; ++q) { const int hv = hp[q]; if (hv) __hip_atomic_fetch_add((LAS unsigned*)lofs + q, (unsigned)hv, __ATOMIC_RELAXED, __HIP_MEMORY_SCOPE_WORKGROUP); } }
                LDS_WAIT(); __syncthreads();
                if (wave == 0) {
                    int run[NE];
#pragma unroll
                    for (int q = 0; q < NE; ++q) run[q] = start[q] + lofs[q];
#pragma unroll
                    for (int hc = 0; hc < 2; ++hc) {
                        const int idx = lane + 64 * hc, tok = vcu * 8 + (idx >> 4) + 2048 * ((idx >> 1) & 7), i = tok * 2 + (idx & 1);
                        const int e = top_e[i]; int dest = 0;
#pragma unroll
                        for (int q = 0; q < NE; ++q) { const unsigned long long m = __ballot(e == q);
                            if (e == q) dest = run[q] + __builtin_popcountll(m & ((1ull << lane) - 1ull));
                            run[q] += __builtin_popcountll(m); }
                        row_tok[dest] = tok; tok_row[i] = dest;
                    }
                }
            }
            GRID_BAR();
            DUP_BEGIN(121)
            {
                PHASE_IDS(); bf16* xg = (bf16*)(ws + WS_XG);
                for (int row = gw; row < nrt * 256; row += NGW) { const int t = row_tok[row];
                    const v4u a = *((const GAS v4u*)(xb_in + (size_t)t * D) + lane), b = *((const GAS v4u*)(xb_in + (size_t)t * D) + 64 + lane);
                    *((GAS v4u*)(xg + (size_t)row * D) + lane) = a; *((GAS v4u*)(xg + (size_t)row * D) + 64 + lane) = b; }
            }
            DUP_END();
#pragma unroll
            for (int hh = 0; hh < 2; ++hh) {
                if (hh == 1) { DUP_BEGIN(125) PHASE_IDS(); moe_weights_half<2>(IN(33), IN(34), IN(35), Wmoegu, Wmoed, 1, gw, NGW, (LAS float*)(lds + wave * 16384), lane); DUP_END(); }
                DUP_BEGIN(122 + 4 * hh)
                {
                    pg8::Gemm g{(const bf16*)(ws + WS_XG), Wmoegu, MOE_MAXROWS, 0, D}; pg8::MoeOrder S{tile_e, nrt, 14, G, bx};
                    pg8::EpiSwiglu E{(bf16*)(ws + WS_HM), DFH};
                    pg8::gemm_phase<pg8::EpiSwiglu, pg8::MoeOrder, PG8_ALIGN, PG8_SP2>(lds, g, S, E);
                }
                if (hh == 0) {
                    const int nun = nrt * 14, nfull = nun / G, heavy = nun - nfull * G;
                    const int glight = G - heavy;
                    pg8::Gemm g{(const bf16*)(ws + WS_PB1), (const bf16*)(ws + WS_PP1), T, D, 256}; pg8::StaticOrder S; S.init(T, D, glight > 0 ? glight : 1, (bx >= heavy && glight > 0) ? bx - heavy : (1 << 20));
                    pg8::EpiStoreBf16 E{(bf16*)(ws + WS_XB0), D};
                    pg8::gemm_phase<pg8::EpiStoreBf16, pg8::StaticOrder, PG8_ALIGN, PG8_SP2>(lds, g, S, E);
                }
                DUP_END();
                DUP_BEGIN(123 + 4 * hh)
                {
                    pg8::Gemm g{(const bf16*)(ws + WS_HM), Wmoed, MOE_MAXROWS, 0, DFH}; pg8::MoeOrder S{tile_e, nrt, 4, G, bx};
                    pg8::EpiStoreBf16 E{(bf16*)(ws + (hh == 0 ? WS_Y1 : WS_XG)), D};
                    pg8::gemm_phase<pg8::EpiStoreBf16, pg8::MoeOrder, PG8_ALIGN, PG8_SP2>(lds, g, S, E);
                }
                if (hh == 0) {
                    PHASE_IDS();
                    const int nun = nrt * 4, nfull = nun / G, heavy = nun - nfull * G;
                    if (bx >= heavy) moe_weights_half<1>(IN(33), IN(34), IN(35), Wmoegu, Wmoed, 1, (bx - heavy) * NWAVES + wave, (G - heavy) * NWAVES, (LAS float*)(lds + wave * 16384), lane);
                }
                DUP_END();
            }
            {
                PHASE_IDS(); LnArgs la{}; la.gam = PB + P_LN2G + L * D; la.bet = PB + P_LN2B + L * D; la.xb = xb_in; la.mode = 1; la.Y1 = (const bf16*)(ws + WS_Y1); la.Y2 = (const bf16*)(ws + WS_XG);
                la.tok_row = tok_row; la.top_g = top_g; la.route = 0;
                ln_rows(la, gw, NGW, lane);
            }
        }
        GRID_BAR();
        {
            pg8::Gemm g{xb_in, (const bf16*)(ws + (L == 0 ? WS_PG0 : WS_PG1)), T, D, D}; pg8::StaticOrder S; S.init(T, D, G, bx);
            float osc = 1.f;
            if (DIAG_B >= 0 && L == 1) { const GAS unsigned long long* tsb = (const GAS unsigned long long*)(args.ws + WS_CTL + 262144); const unsigned long long ta = tsb[DIAG_A < 0 ? 63 : DIAG_A], tb = tsb[DIAG_B]; osc = 1.f + (float)(tb - ta) / DIAG_DIV; }
            pg8::EpiPleT<(L == 1)> E{xb_in, (const bf16*)(ws + (L == 0 ? WS_MIX : WS_XB0)), (L == 0) ? (void*)xb_out : (void*)args.out, D, osc};
            pg8::gemm_phase<pg8::EpiPleT<(L == 1)>, pg8::StaticOrder, PG8_ALIGN, PG8_SP2>(lds, g, S, E);
        }
        }
}
__global__ void __launch_bounds__(NWAVES * 64, 2) mega_fwd(Args args, int seg) {
    extern __shared__ __attribute__((aligned(16))) unsigned char lds_raw[];
    LAS unsigned char* lds = (LAS unsigned char*)lds_raw;
    volatile LAS unsigned* MISC = (volatile LAS unsigned*)(lds + MISC_OFF);
    const int tid = threadIdx.x, lane = tid & 63, wave = __builtin_amdgcn_readfirstlane(tid >> 6);
    const int G = gridDim.x, bx = blockIdx.x; const int vcu = (G % 8 == 0) ? (bx % 8) * (G / 8) + bx / 8 : bx;
    const int gw = vcu * NWAVES + wave, NGW = G * NWAVES;
    unsigned char* ws = args.ws;
    gu32* ctl = (gu32*)(ws + WS_CTL);
    for (int u = tid; u < (LDS_BYTES - RING_BYTES) / 4; u += NWAVES * 64) ((LAS unsigned*)(lds + RING_BYTES))[u] = 0u;
    __syncthreads();
    int nst = 0; if (DIAG_B >= 0 && bx == 0 && tid == 0) ((GAS unsigned long long*)(args.ws + WS_CTL + 262144))[63] = __builtin_amdgcn_s_memrealtime();
    XcdBarrier bar = xcd_barrier_post((unsigned*)(ctl + CW_BAR) + (seg < 0 ? 0 : seg) * XCD_BAR_WORDS, MISC + 8);
    bf16* Wmoegu = (bf16*)(ws + WS_MOEGU); bf16* Wmoed = (bf16*)(ws + WS_MOED);
    bf16* vfirst = (bf16*)(ws + WS_VFIRST);
    bf16* zb = (bf16*)(ws + WS_Z); bf16* mix = (bf16*)(ws + WS_MIX); float* preln = (float*)(ws + WS_PRELN);
    float* gla_logf = (float*)(ws + WS_PREP); float* rwb = (float*)(ws + WS_PREP + 8 * MiB);
    const float* PB = (const float*)(ws + WS_MISC + MS_PARAMS); int* top_e = (int*)(ws + WS_MISC + MS_TOPE); float* top_g = (float*)(ws + WS_MISC + MS_TOPG);
    int* tok_row = (int*)(ws + WS_MISC + MS_TOKROW); int* row_tok = (int*)(ws + WS_MISC + MS_ROWTOK); int* tile_e = (int*)(ws + WS_MISC + MS_TILEE);
    float* xf = args.out;

    {
    DUP_BEGIN(0)
    {
        PHASE_IDS(); LAS float* scr = (LAS float*)(lds + wave * 16384);
        constexpr int I_WIN = 16 * 99, I_VD = 16, I_SQ = 16 * 32, I_FG = 16 * 88, I_FD = 44 * 32, I_PP = 4 * 32;
        constexpr int NIT = 2 * I_WIN + I_VD + 4 * I_SQ + 2 * I_FG + I_FD + 2 * I_PP;
        for (int it = gw; it < NIT; it += NGW) {
            int r = it; const float* src; int ldw, nblocks, ncols, dld, il = 0, rowoff = 0; bf16* dst;
            if (r < I_WIN) { src = IN(2); ldw = PIN; nblocks = 99; ncols = PIN; dst = (bf16*)(ws + WS_WIN0); dld = D; }
            else if ((r -= I_WIN) < I_WIN) { src = IN(2) + (size_t)D * PIN; ldw = PIN; nblocks = 99; ncols = PIN; dst = (bf16*)(ws + WS_WIN1); dld = D; }
            else if ((r -= I_WIN) < I_VD) { src = IN(21); ldw = 8; nblocks = 1; ncols = 8; dst = (bf16*)(ws + WS_WIN1); dld = D; rowoff = PIN; }
            else if ((r -= I_VD) < I_SQ) { src = IN(3); ldw = D; nblocks = 32; ncols = D; dst = (bf16*)(ws + WS_WOUT0); dld = D; }
            else if ((r -= I_SQ) < I_SQ) { src = IN(3) + (size_t)D * D; ldw = D; nblocks = 32; ncols = D; dst = (bf16*)(ws + WS_WOUT1); dld = D; }
            else if ((r -= I_SQ) < I_SQ) { src = IN(37); ldw = D; nblocks = 32; ncols = D; dst = (bf16*)(ws + WS_PG0); dld = D; }
            else if ((r -= I_SQ) < I_SQ) { src = IN(37) + (size_t)D * D; ldw = D; nblocks = 32; ncols = D; dst = (bf16*)(ws + WS_PG1); dld = D; }
            else if ((r -= I_SQ) < I_FG) { src = IN(29); ldw = DFF; nblocks = 88; ncols = DFF; dst = (bf16*)(ws + WS_FGU); dld = D; il = 1; }
            else if ((r -= I_FG) < I_FG) { src = IN(30); ldw = DFF; nblocks = 88; ncols = DFF; dst = (bf16*)(ws + WS_FGU); dld = D; il = 1; rowoff = 128; }
            else if ((r -= I_FG) < I_FD) { src = IN(31); ldw = D; nblocks = 32; ncols = D; dst = (bf16*)(ws + WS_FD); dld = DFF; }
            else if ((r -= I_FD) < I_PP) { src = IN(36); ldw = D; nblocks = 32; ncols = D; dst = (bf16*)(ws + WS_PP0); dld = 256; }
            else { r -= I_PP; src = IN(36) + (size_t)256 * D; ldw = D; nblocks = 32; ncols = D; dst = (bf16*)(ws + WS_PP1); dld = 256; }
            tr_job(src, ldw, nblocks, ncols, dst, dld, il, rowoff, r, scr, lane);
        }
        moe_weights_half<3>(IN(33), IN(34), IN(35), Wmoegu, Wmoed, 0, gw, NGW, scr, lane);
        const size_t gtid = (size_t)vcu * (NWAVES * 64) + tid, nth = (size_t)G * NWAVES * 64;
        for (size_t i = gtid * 8; i < (size_t)(ZLD - PIN) * D; i += nth * 8) *(GAS v4u*)((bf16*)(ws + WS_WIN0) + (size_t)PIN * D + i) = (v4u){0u, 0u, 0u, 0u};
        for (size_t i = gtid * 8; i < (size_t)(ZLD - PIN - 8) * D; i += nth * 8) *(GAS v4u*)((bf16*)(ws + WS_WIN1) + (size_t)(PIN + 8) * D + i) = (v4u){0u, 0u, 0u, 0u};
        cvt_rows(IN(0), (bf16*)(ws + WS_XB0), (size_t)T * D, gtid, nth);
        cvt_rows(IN(1), (bf16*)(ws + WS_PB0), (size_t)T * 256, gtid, nth);
        cvt_rows(IN(1) + (size_t)T * 256, (bf16*)(ws + WS_PB1), (size_t)T * 256, gtid, nth);
        {
            float* PW = (float*)(ws + WS_MISC + MS_PARAMS);
#define CPY(idx, off, n) do { const float* _s = IN(idx); for (int _i = (int)gtid; _i < (n); _i += (int)nth) PW[(off) + _i] = _s[_i]; } while (0)
            CPY(4, P_GKUP, 4096); CPY(5, P_GKB, 256); CPY(6, P_GNW, 128); CPY(7, P_HLB, 512); CPY(8, P_HNW, 128); CPY(9, P_SINK, 8); CPY(10, P_MU, 1664); CPY(11, P_W0, 512);
            CPY(12, P_WUP, 8192); CPY(13, P_A0, 512); CPY(14, P_AUP, 8192); CPY(15, P_GUP, 16384); CPY(16, P_KK, 512); CPY(17, P_KA, 512); CPY(18, P_RK, 512); CPY(19, P_LNXW, 512);
            CPY(20, P_LNXB, 512); CPY(22, P_VMU, 8); CPY(23, P_V0, 256); CPY(24, P_VUP, 2048); CPY(25, P_LN1G, 2048); CPY(26, P_LN1B, 2048); CPY(27, P_LN2G, 2048); CPY(28, P_LN2B, 2048);
            CPY(32, P_ROUTER, 8192);
#undef CPY
            if (bx == 0 && tid < 256) { const float* hl = IN(7); const float a = hl[tid], b = hl[256 + tid]; const float m = fmaxf(a, b); const float ea = __expf(a - m), eb = __expf(b - m); PW[P_LBS + tid] = 0.f; PW[P_LBS + 256 + tid] = eb / (ea + eb); }
        }
        for (int i = (int)gtid; i < MOE_MAXROWS; i += (int)nth) row_tok[i] = 0;
        if (gw < 8) { if (gw < 4) rwkv_build_pfrag(ws + WS_MISC + MS_PFRAG + (size_t)gw * PFRAG_BYTES, IN(12), IN(14), IN(15), nullptr, gw & 3, lane);
                      else rwkv_build_pfrag(ws + WS_MISC + MS_PFRAG + (size_t)gw * PFRAG_BYTES, IN(12) + 4096, IN(14) + 4096, IN(15) + 8192, IN(24), gw & 3, lane); }
    }
    DUP_END();

    }
    layer_body<0, true, true, true>(args, lds, bar, tid, lane, wave, G, bx, vcu, gw, NGW, nst);
    GRID_BAR();
    layer_body<1, true, true, true>(args, lds, bar, tid, lane, wave, G, bx, vcu, gw, NGW, nst);
}
#undef IN


extern "C" void kernel_launch(void* const* d_in, const int* in_sizes, int n_in, void* d_out, int out_size, void* d_ws, size_t ws_size, hipStream_t stream) {
    static int grid = 0;
    if (grid == 0) {
        if (n_in != 38 || in_sizes[0] != T * D || out_size != T * D || ws_size < WS_END) { fprintf(stderr, "kernel_launch: unexpected problem (n_in %d, in0 %d, out %d, ws %zu < %zu)\n", n_in, n_in > 0 ? in_sizes[0] : -1, out_size, ws_size, (size_t)WS_END); grid = -1; return; }
        int dev = 0, cus = 0, per_cu = 0;
        if (hipGetDevice(&dev) != hipSuccess || hipDeviceGetAttribute(&cus, hipDeviceAttributeMultiprocessorCount, dev) != hipSuccess) { grid = -1; return; }
        if (hipFuncSetAttribute((const void*)mega_fwd, hipFuncAttributeMaxDynamicSharedMemorySize, LDS_BYTES) != hipSuccess) { fprintf(stderr, "kernel_launch: hipFuncSetAttribute failed\n"); grid = -1; return; }
        if (hipOccupancyMaxActiveBlocksPerMultiprocessor(&per_cu, (const void*)mega_fwd, NWAVES * 64, LDS_BYTES) != hipSuccess || per_cu < 1) { fprintf(stderr, "kernel_launch: occupancy query says %d\n", per_cu); per_cu = 1; }
        (void)hipGetLastError();
        grid = cus;
    }
    if (grid < 0) return;
    if (hipMemsetAsync((char*)d_ws + WS_CTL, 0, CTL_BYTES, stream) != hipSuccess) { fprintf(stderr, "kernel_launch: memset failed\n"); return; }
    Args a{};
    for (int i = 0; i < 38; ++i) a.in[i] = (const float*)d_in[i];
    a.out = (float*)d_out; a.ws = (unsigned char*)d_ws;
    int seg = -1; void* kargs[] = {&a, &seg};
    hipError_t e = hipLaunchCooperativeKernel((const void*)mega_fwd, dim3(grid), dim3(NWAVES * 64), kargs, LDS_BYTES, stream);
    if (e != hipSuccess) fprintf(stderr, "kernel_launch: cooperative launch failed: %s (grid %d)\n", hipGetErrorString(e), grid);
}
```
